# Optimizing an MI355X kernel written in HIP

```python
import math
import jax, jax.numpy as jnp
from jax import lax
import numpy as np

D_MODEL = 1024
BATCH = 16
SEQ = 256
DEPTH = 4
DEC_BATCH = 4
DEC_SEQ = 4096
PAST_LEN = 256

GRID_W = 64
N_DIR = 2
GDN_HEADS = 4
GDN_DK = 128
GDN_DV = 128
GDN_W = GDN_HEADS * GDN_DV
GDN_CONV = 5
GDN_CHUNK = 64
HY_W = D_MODEL - GDN_W
HY_CONV = 3
HY_EMB = 33
HY_FH = 64
HY_DECAY_TARGET = 1e-2
HY_FAST_PCT = 0.3
HY_SLOW_PCT = 1.5
D_FF = 4 * D_MODEL
EPS = 1e-6
OFF_G = 3 * GDN_W
OFF_A = 4 * GDN_W
OFF_B = OFF_A + N_DIR * GDN_HEADS
OFF_HY = OFF_B + N_DIR * GDN_HEADS
IN_COLS = OFF_HY + 3 * HY_W

kernel_name = "hybrid_gdn_hyena_diffusion_step"

F32 = jnp.float32


def rms_norm(x, g):
    xf = x.astype(F32)
    y = xf * lax.rsqrt(jnp.mean(xf * xf, axis=-1, keepdims=True) + EPS)
    return (y * g.astype(F32)).astype(x.dtype)


def l2norm(x):
    return x * lax.rsqrt(jnp.sum(x * x, axis=-1, keepdims=True) + EPS)


def short_conv(x, w, n_rows):
    b, l, ch = x.shape
    width = w.shape[0]
    pad = width // 2
    seg = l // n_rows
    w = w.astype(F32)
    xr = jnp.pad(x.reshape(b * n_rows, seg, ch), ((0, 0), (pad, pad), (0, 0)))
    y = sum(xr[:, j:j + seg] * w[j] for j in range(width))
    return y.reshape(b, l, ch)


def gdn_scan(q, k, v, g, beta, s0):
    b, l, h, dk = q.shape
    dv = v.shape[-1]
    c = GDN_CHUNK
    n = l // c

    def blk(t):
        return jnp.moveaxis(t.reshape((b, n, c) + t.shape[2:]), 3, 1)

    q_, k_, v_, g_, be_ = blk(q), blk(k), blk(v), blk(g), blk(beta)
    gc = jnp.cumsum(g_, axis=-1)
    incl = jnp.tril(jnp.ones((c, c), dtype=bool))
    strict = jnp.tril(jnp.ones((c, c), dtype=F32), -1)
    decay = jnp.exp(jnp.where(incl, gc[..., :, None] - gc[..., None, :], -jnp.inf))
    kb = k_ * be_[..., None]
    vb = v_ * be_[..., None]
    a_mat = jnp.einsum('bhnid,bhnjd->bhnij', kb, k_) * decay * strict
    m_mat = a_mat + jnp.eye(c, dtype=F32)
    u = lax.linalg.triangular_solve(m_mat, vb, left_side=True, lower=True, unit_diagonal=True)
    w = lax.linalg.triangular_solve(m_mat, kb * jnp.exp(gc)[..., None], left_side=True, lower=True,
                                    unit_diagonal=True)
    qk = jnp.einsum('bhnid,bhnjd->bhnij', q_, k_) * decay
    g_last = gc[..., -1]
    q_dec = q_ * jnp.exp(gc)[..., None]
    k_dec = k_ * jnp.exp(g_last[..., None] - gc)[..., None]
    xs = tuple(jnp.moveaxis(t, 2, 0) for t in (q_dec, k_dec, u, w, qk, g_last))

    def step(s, inp):
        qd, kd, uu, ww, qkk, gl = inp
        v_new = uu - jnp.einsum('bhcd,bhde->bhce', ww, s)
        o = jnp.einsum('bhcd,bhde->bhce', qd, s) + jnp.einsum('bhij,bhje->bhie', qkk, v_new)
        s = s * jnp.exp(gl)[..., None, None] + jnp.einsum('bhcd,bhce->bhde', kd, v_new)
        return s, o

    s_fin, o = lax.scan(step, s0, xs)
    o = jnp.moveaxis(o, 0, 2).transpose(0, 2, 3, 1, 4).reshape(b, l, h, dv)
    return o, s_fin


def hyena_filter(l, w1, b1, freq, w2, b2, w3, b3):
    t = jnp.linspace(0.0, 1.0, l, dtype=F32)[:, None]
    bands = (HY_EMB - 1) // 2
    f = jnp.linspace(1e-4, bands - 1, bands, dtype=F32)[None, :]
    wpos = (2.0 * math.pi) * jnp.arange(l, dtype=F32)[:, None] / l
    z = jnp.concatenate([t, jnp.cos(f * wpos), -jnp.sin(f * wpos)], axis=-1)
    freq = freq.astype(F32)
    h = jnp.sin(freq * (z @ w1.astype(F32) + b1.astype(F32)))
    h = jnp.sin(freq * (h @ w2.astype(F32) + b2.astype(F32)))
    h = (h @ w3.astype(F32) + b3.astype(F32)).reshape(l, N_DIR, HY_W)
    max_decay = math.log(HY_DECAY_TARGET) / HY_FAST_PCT
    min_decay = math.log(HY_DECAY_TARGET) / HY_SLOW_PCT
    deltas = jnp.abs(jnp.linspace(min_decay, max_decay, HY_W, dtype=F32))
    h = h * jnp.exp(-t[:, :, None] * deltas)
    filt = jnp.concatenate([h[:, 0], jnp.zeros((1, HY_W), F32), h[:0:-1, 1]], axis=0)
    return jnp.fft.rfft(filt, axis=0)


def trunk_layer(x, mod, s0, n_rows, p):
    b, l, _ = x.shape
    shift1, scale1, gate1, shift2, scale2, gate2 = jnp.split(mod, 6, axis=-1)
    hn = rms_norm(x, p['norm1_g']) * (1 + scale1[:, None]) + shift1[:, None]
    proj = (hn @ p['w_in']).astype(F32)

    qkv = jax.nn.silu(short_conv(proj[..., :OFF_G], p['gdn_conv_w'], n_rows))
    q, k, v = jnp.split(qkv, 3, axis=-1)
    q = l2norm(q.reshape(b, l, GDN_HEADS, GDN_DK)) * (GDN_DK ** -0.5)
    k = l2norm(k.reshape(b, l, GDN_HEADS, GDN_DK))
    v = v.reshape(b, l, GDN_HEADS, GDN_DV)
    a_logit = proj[..., OFF_A:OFF_B].reshape(b, l, N_DIR, GDN_HEADS)
    b_logit = proj[..., OFF_B:OFF_HY].reshape(b, l, N_DIR, GDN_HEADS)
    g = -jnp.exp(p['gdn_a_log'].astype(F32)) * jax.nn.softplus(a_logit + p['gdn_dt_bias'].astype(F32))
    beta = jax.nn.sigmoid(b_logit)
    s0 = s0.astype(F32)
    o_f, s_f = gdn_scan(q, k, v, g[:, :, 0], beta[:, :, 0], s0[:, 0])
    flip = lambda t: t[:, ::-1]
    o_b, s_b = gdn_scan(flip(q), flip(k), flip(v), flip(g[:, :, 1]), flip(beta[:, :, 1]), s0[:, 1])
    o = o_f + flip(o_b)
    gate_o = proj[..., OFF_G:OFF_A].reshape(b, l, GDN_HEADS, GDN_DV)
    o = (rms_norm(o, p['gdn_norm_g']) * jax.nn.silu(gate_o)).reshape(b, l, GDN_W)

    hy = short_conv(proj[..., OFF_HY:], p['hy_conv_w'], n_rows)
    x0, x1, hv = jnp.split(hy, 3, axis=-1)
    zz = x1 * hv
    spec = hyena_filter(l, p['hy_w1'], p['hy_b1'], p['hy_freq'], p['hy_w2'], p['hy_b2'],
                        p['hy_w3'], p['hy_b3'])
    zc = jnp.fft.irfft(jnp.fft.rfft(zz, n=2 * l, axis=1) * spec[None], n=2 * l, axis=1)[:, :l]
    y_h = x0 * (zc + zz * p['hy_skip'].astype(F32))

    mix = jnp.concatenate([o, y_h], axis=-1).astype(x.dtype) @ p['w_out']
    x = x + gate1[:, None] * mix

    h2 = rms_norm(x, p['norm2_g']) * (1 + scale2[:, None]) + shift2[:, None]
    x = x + gate2[:, None] * (jnp.square(jax.nn.relu(h2 @ p['w_mlp1'])) @ p['w_mlp2'])
    return x, jnp.stack([s_f, s_b], axis=1)


def setup_inputs(seed: int = 0) -> dict:
    key = jax.random.key(seed)
    ks = jax.random.split(key, 32)
    nrm = lambda k, shape, s: jax.random.normal(k, shape, F32) * s
    dt = jnp.exp(jax.random.uniform(ks[12], (DEPTH, N_DIR, GDN_HEADS), F32, math.log(1e-3), math.log(1e-1)))
    return {
        "x_prompt": nrm(ks[0], (BATCH, SEQ, D_MODEL), 1.0),
        "x_sample": nrm(ks[1], (DEC_BATCH, DEC_SEQ, D_MODEL), 1.0),
        "state_gdn": nrm(ks[2], (DEC_BATCH, DEPTH, N_DIR, GDN_HEADS, GDN_DK, GDN_DV), GDN_DK ** -0.5),
        "c": nrm(ks[3], (DEC_BATCH, D_MODEL), 1.0),
        "c_ctx": nrm(ks[4], (D_MODEL,), 1.0),
        "w_ada": nrm(ks[5], (DEPTH, D_MODEL, 6 * D_MODEL), 0.5 * D_MODEL ** -0.5),
        "b_ada": nrm(ks[6], (DEPTH, 6 * D_MODEL), 0.02),
        "norm1_g": 1.0 + nrm(ks[7], (DEPTH, D_MODEL), 0.02),
        "norm2_g": 1.0 + nrm(ks[8], (DEPTH, D_MODEL), 0.02),
        "w_in": nrm(ks[9], (DEPTH, D_MODEL, IN_COLS), D_MODEL ** -0.5),
        "gdn_conv_w": nrm(ks[10], (DEPTH, GDN_CONV, 3 * GDN_W), GDN_CONV ** -0.5),
        "gdn_a_log": jnp.log(jax.random.uniform(ks[11], (DEPTH, N_DIR, GDN_HEADS), F32, 1.0, 16.0)),
        "gdn_dt_bias": dt + jnp.log(-jnp.expm1(-dt)),
        "gdn_norm_g": 1.0 + nrm(ks[13], (DEPTH, GDN_DV), 0.02),
        "hy_conv_w": nrm(ks[14], (DEPTH, HY_CONV, 3 * HY_W), HY_CONV ** -0.5),
        "hy_w1": nrm(ks[15], (DEPTH, HY_EMB, HY_FH), HY_EMB ** -0.5),
        "hy_b1": nrm(ks[16], (DEPTH, HY_FH), 0.02),
        "hy_freq": 1.0 + nrm(ks[17], (DEPTH, HY_FH), 0.02),
        "hy_w2": nrm(ks[18], (DEPTH, HY_FH, HY_FH), HY_FH ** -0.5),
        "hy_b2": nrm(ks[19], (DEPTH, HY_FH), 0.02),
        "hy_w3": nrm(ks[20], (DEPTH, HY_FH, N_DIR * HY_W), 0.05 * HY_FH ** -0.5),
        "hy_b3": nrm(ks[21], (DEPTH, N_DIR * HY_W), 0.01),
        "hy_skip": nrm(ks[22], (DEPTH, HY_W), 0.5),
        "w_out": nrm(ks[23], (DEPTH, D_MODEL, D_MODEL), D_MODEL ** -0.5),
        "w_mlp1": nrm(ks[24], (DEPTH, D_MODEL, D_FF), D_MODEL ** -0.5),
        "w_mlp2": nrm(ks[25], (DEPTH, D_FF, D_MODEL), D_FF ** -0.5),
        "final_g": 1.0 + nrm(ks[26], (D_MODEL,), 0.02),
    }


def reference(x_prompt, x_sample, state_gdn, c, c_ctx, w_ada, b_ada, norm1_g, norm2_g, w_in,
              gdn_conv_w, gdn_a_log, gdn_dt_bias, gdn_norm_g, hy_conv_w, hy_w1, hy_b1, hy_freq,
              hy_w2, hy_b2, hy_w3, hy_b3, hy_skip, w_out, w_mlp1, w_mlp2, final_g):
    rows = x_sample.shape[1] // GRID_W

    def layer_params(l):
        return {"norm1_g": norm1_g[l], "norm2_g": norm2_g[l], "w_in": w_in[l],
                "gdn_conv_w": gdn_conv_w[l], "gdn_a_log": gdn_a_log[l], "gdn_dt_bias": gdn_dt_bias[l],
                "gdn_norm_g": gdn_norm_g[l], "hy_conv_w": hy_conv_w[l], "hy_w1": hy_w1[l],
                "hy_b1": hy_b1[l], "hy_freq": hy_freq[l], "hy_w2": hy_w2[l], "hy_b2": hy_b2[l],
                "hy_w3": hy_w3[l], "hy_b3": hy_b3[l], "hy_skip": hy_skip[l], "w_out": w_out[l],
                "w_mlp1": w_mlp1[l], "w_mlp2": w_mlp2[l]}

    x = x_prompt
    s_zero = jnp.zeros((x_prompt.shape[0], N_DIR, GDN_HEADS, GDN_DK, GDN_DV), F32)
    ctx_states = []
    for l in range(DEPTH):
        mod = (jax.nn.silu(c_ctx) @ w_ada[l] + b_ada[l])[None]
        x, s_l = trunk_layer(x, mod, s_zero, 1, layer_params(l))
        ctx_states.append(s_l)
    y_prompt = rms_norm(x, final_g)
    new_state_gdn = jnp.stack(ctx_states, axis=1).astype(x_prompt.dtype)

    x = x_sample
    for l in range(DEPTH):
        mod = jax.nn.silu(c) @ w_ada[l] + b_ada[l]
        x, _ = trunk_layer(x, mod, state_gdn[:, l], rows, layer_params(l))
    y_sample = rms_norm(x, final_g)

    return (y_prompt, y_sample, new_state_gdn)
```

```cpp
#include <hip/hip_runtime.h>
#include <cstdio>
#include <cstdint>

#define GAS __attribute__((address_space(1)))
#define LAS __attribute__((address_space(3)))
#define DI __device__ __forceinline__
typedef unsigned short bf16;
typedef float f32x4 __attribute__((ext_vector_type(4)));
typedef float f32x2 __attribute__((ext_vector_type(2)));
typedef unsigned u32x4 __attribute__((ext_vector_type(4)));
typedef unsigned u32x2 __attribute__((ext_vector_type(2)));
typedef short bf16x8v __attribute__((ext_vector_type(8)));
typedef float f32x16 __attribute__((ext_vector_type(16)));
typedef short s16x4v __attribute__((ext_vector_type(4)));

#ifndef DUP_MASK
#define DUP_MASK 0
#endif
#ifndef MK_MULTI
#define MK_MULTI 0
#endif

constexpr int D = 1024, FF = 4096, DEPTH = 4;
constexpr int NCTX = 4096, NTOK = 20480;
constexpr int NP = 3584;
constexpr int IN_COLS = 3600;
constexpr int NWAVES = 8, NTHR = 512;
constexpr float EPS = 1e-6f;
constexpr int NPH = 35;

constexpr size_t MiB = 1u << 20;
constexpr size_t WS_CTL = 0, CTL_ZERO_BYTES = 1 * MiB;
constexpr size_t WS_MOD = 1 * MiB;
constexpr size_t WS_SWIN = 1 * MiB + 512 * 1024;
constexpr size_t WS_SW1 = 2 * MiB;
constexpr size_t WS_RSS1 = 2 * MiB + 512 * 1024;
constexpr size_t WS_RSS2 = WS_RSS1 + 128 * 1024;
constexpr size_t WS_LOGIT = 3 * MiB;
constexpr size_t WS_GBG = 4 * MiB + 512 * 1024;
constexpr size_t WS_GBB = WS_GBG + 640 * 1024;
constexpr size_t WS_WT = 6 * MiB;
constexpr size_t WS_FILT = 32 * MiB;
constexpr size_t WS_A = 50 * MiB;
constexpr size_t WS_OF = WS_A, WS_OB = WS_A + 20 * MiB;
constexpr size_t WS_R1 = 90 * MiB;
constexpr size_t WS_ZZT = WS_R1 + 140 * MiB;
constexpr size_t WS_QKVN = 250 * MiB;
constexpr size_t WS_TMQK = 310 * MiB;
constexpr size_t WS_X0C = 350 * MiB;
constexpr size_t WS_RSSP1 = 370 * MiB;
constexpr size_t WS_RSSP2 = 372 * MiB;
constexpr size_t WS_END = 374 * MiB;

constexpr int LDS_BYTES = 147456;

DI float bf2f(bf16 h) { return __builtin_bit_cast(float, (unsigned)h << 16); }
DI bf16 f2bf(float f) { unsigned u = __builtin_bit_cast(unsigned, f); return (bf16)((u + 0x7fffu + ((u >> 16) & 1u)) >> 16); }
DI unsigned pk2(float lo, float hi) { return (unsigned)f2bf(lo) | ((unsigned)f2bf(hi) << 16); }
DI float shx(float v, int o, int lane) { return __builtin_bit_cast(float, __builtin_amdgcn_ds_bpermute((lane ^ o) << 2, __builtin_bit_cast(int, v))); }
DI float shi(float v, int src) { return __builtin_bit_cast(float, __builtin_amdgcn_ds_bpermute(src << 2, __builtin_bit_cast(int, v))); }
DI int fresh_lane() { unsigned z_ = 0u; asm volatile("" : "+s"(z_)); return (int)__builtin_amdgcn_mbcnt_hi(~0u, __builtin_amdgcn_mbcnt_lo(~0u, z_)); }
DI float wave_sum(float v, int lane) {
#pragma unroll
    for (int o = 1; o < 64; o <<= 1) v += shx(v, o, lane);
    return v;
}
DI float silu_f(float x) { return x / (1.f + __expf(-x)); }
DI float sigmoid_f(float x) { return 1.f / (1.f + __expf(-x)); }
DI float softplus_f(float x) { return x > 15.f ? x : __logf(1.f + __expf(x)); }
DI float sin_rev(float rev) { return __builtin_amdgcn_sinf(rev); }
DI float cos_rev(float rev) { return __builtin_amdgcn_cosf(rev); }
DI float rss_read(const float* P, int r) { const f32x4* p = (const f32x4*)(P + (size_t)r * 16); const f32x4 a = p[0], b = p[1], c2 = p[2], d = p[3]; const f32x4 t = (a + b) + (c2 + d); return (t.x + t.y) + (t.z + t.w); }
DI int mod_of_row(int r) { return r < NCTX ? 4 : ((r - NCTX) >> 12); }

struct KP {
    const float* in[27];
    float* out;
    unsigned char* ws;
    int ph_lo, ph_hi;
};

#define CAS __attribute__((address_space(4)))
typedef const KP CAS* KPc;
typedef const float* const CAS* InTab;
struct Ctx {
    InTab in;
    float* X;
    float* out;
    unsigned char* ws;
    LAS unsigned char* lds;
    int tid, lane, wave, bid, G;
};

DI void phase_mod(const Ctx& c) {
    const float* cin = c.in[3]; const float* cctx = c.in[4]; const float* w_ada = c.in[5]; const float* b_ada = c.in[6];
    LAS float* sc = (LAS float*)c.lds;
    LAS float* red = sc + 5 * 1024;
    for (int i = c.tid; i < 5 * 1024; i += NTHR) { const int m = i >> 10, k = i & 1023; const float v = (m < 4) ? cin[m * 1024 + k] : cctx[k]; sc[i] = silu_f(v); }
    __syncthreads();
    float* MOD = (float*)(c.ws + WS_MOD);
    const int jl = c.tid & 63, ks = c.tid >> 6;
    for (int task = c.bid; task < 4 * 96; task += c.G) {
        const int l = task / 96, cb = task % 96, j = cb * 64 + jl;
        float acc[5] = {0.f, 0.f, 0.f, 0.f, 0.f};
        const float* wp = w_ada + (size_t)l * 1024 * 6144 + j;
        for (int k = ks * 128; k < ks * 128 + 128; ++k) { const float w = wp[(size_t)k * 6144];
#pragma unroll
            for (int m = 0; m < 5; ++m) acc[m] += sc[m * 1024 + k] * w; }
#pragma unroll
        for (int m = 0; m < 5; ++m) red[(ks * 5 + m) * 64 + jl] = acc[m];
        __syncthreads();
        if (c.tid < 320) { const int m = c.tid >> 6; float s = 0.f;
#pragma unroll
            for (int q = 0; q < 8; ++q) s += red[(q * 5 + m) * 64 + jl];
            MOD[(size_t)(l * 5 + m) * 6144 + j] = s + b_ada[l * 6144 + j]; }
        __syncthreads();
    }
}

DI void phase_sw(const Ctx& c) {
    const float* MOD = (const float*)(c.ws + WS_MOD);
    LAS float* sc = (LAS float*)c.lds;
    LAS float* red = sc + 5 * 1024;
    float* SWIN = (float*)(c.ws + WS_SWIN); float* SW1 = (float*)(c.ws + WS_SW1);
    const int jl = c.tid & 63, ks = c.tid >> 6;
    constexpr int NB_IN = 57, NB_1 = 64, PER_L = NB_IN + NB_1;
    int cur_key = -1;
    for (int task = c.bid; task < 4 * PER_L; task += c.G) {
        const int l = task / PER_L, t = task % PER_L; const bool is1 = t >= NB_IN; const int cb = is1 ? t - NB_IN : t;
        const int key = l * 2 + (is1 ? 1 : 0);
        if (key != cur_key) {
            __syncthreads();
            for (int i = c.tid; i < 5 * 1024; i += NTHR) { const int m = i >> 10, k = i & 1023; sc[i] = MOD[(size_t)(l * 5 + m) * 6144 + (is1 ? 3 : 0) * 1024 + k]; }
            __syncthreads(); cur_key = key;
        }
        const int N = is1 ? FF : IN_COLS; const float* W = (is1 ? c.in[24] : c.in[9]) + (size_t)l * 1024 * N;
        const int j = cb * 64 + jl; const bool ok = j < N;
        float acc[5] = {0.f, 0.f, 0.f, 0.f, 0.f};
        if (ok) { const float* wp = W + j;
            for (int k = ks * 128; k < ks * 128 + 128; ++k) { const float w = wp[(size_t)k * N];
#pragma unroll
                for (int m = 0; m < 5; ++m) acc[m] += sc[m * 1024 + k] * w; } }
#pragma unroll
        for (int m = 0; m < 5; ++m) red[(ks * 5 + m) * 64 + jl] = acc[m];
        __syncthreads();
        if (c.tid < 320 && ok) { const int m = c.tid >> 6; float s = 0.f;
#pragma unroll
            for (int q = 0; q < 8; ++q) s += red[(q * 5 + m) * 64 + jl];
            (is1 ? SW1 : SWIN)[(size_t)(l * 5 + m) * N + j] = s; }
        __syncthreads();
    }
}

template <int WHICH, bool FIRST>
DI void phase_rowprep(const Ctx& c, int l) {
    const float* MOD = (const float*)(c.ws + WS_MOD);
    const float* ng = (WHICH == 1 ? c.in[7] : c.in[8]) + l * 1024;
    float* RSS = (float*)(c.ws + (WHICH == 1 ? WS_RSSP1 : WS_RSSP2));
    bf16* A = (bf16*)(c.ws + WS_A);
    float* LOGIT = (float*)(c.ws + WS_LOGIT);
    const float* w_in = c.in[9] + (size_t)l * 1024 * IN_COLS;
    const int gw = c.bid * NWAVES + c.wave, NGW = c.G * NWAVES;
    for (int r = gw; r < NTOK; r += NGW) {
        const int mb = mod_of_row(r);
        const float* mrow = MOD + (size_t)(l * 5 + mb) * 6144;
        const float* shift = mrow + (WHICH == 1 ? 0 : 3) * 1024; const float* scale = mrow + (WHICH == 1 ? 1 : 4) * 1024;
        const f32x4* xr = FIRST ? (const f32x4*)((r < NCTX ? c.in[0] : c.in[1] - (size_t)NCTX * D) + (size_t)r * D) : (const f32x4*)(c.X + (size_t)r * D);
        f32x4 v[4]; float ss = 0.f;
#pragma unroll
        for (int j = 0; j < 4; ++j) { v[j] = xr[c.lane + 64 * j]; ss += (v[j].x * v[j].x + v[j].y * v[j].y) + (v[j].z * v[j].z + v[j].w * v[j].w); }
        ss = wave_sum(ss, c.lane);
        if (!FIRST) ss = rss_read(RSS, r);
        if (FIRST && c.lane < 16) RSS[(size_t)r * 16 + c.lane] = c.lane == 0 ? ss : 0.f;
        const float rstd = rsqrtf(ss * (1.f / D) + EPS);
        if (FIRST)
#pragma unroll
        for (int j = 0; j < 4; ++j) {
            const int k0 = (c.lane + 64 * j) * 4;
            const f32x4 g4 = *(const f32x4*)(ng + k0), s4 = *(const f32x4*)(scale + k0);
            const f32x4 a = v[j] * (g4 * (s4 + 1.0f));
            u32x2 w; w.x = pk2(a.x, a.y); w.y = pk2(a.z, a.w);
            *(u32x2*)(A + (size_t)r * D + k0) = w;
        }
        float lg[16];
#pragma unroll
        for (int q = 0; q < 16; ++q) lg[q] = 0.f;
        if (WHICH == 1 && !FIRST) {
#pragma unroll 1
            for (int j = 0; j < 4; ++j) {
                const int k0 = (c.lane + 64 * j) * 4;
                const f32x4 xv = xr[c.lane + 64 * j];
                const f32x4 g4 = *(const f32x4*)(ng + k0), s4 = *(const f32x4*)(scale + k0), sh = *(const f32x4*)(shift + k0);
                const f32x4 hn = xv * (g4 * (s4 + 1.0f)) * rstd + sh;
#pragma unroll
                for (int e = 0; e < 4; ++e) { const float h = hn[e]; const f32x4* wp = (const f32x4*)(w_in + (size_t)(k0 + e) * IN_COLS + 2048);
#pragma unroll
                    for (int q = 0; q < 4; ++q) { const f32x4 w4 = wp[q]; lg[4 * q] += h * w4.x; lg[4 * q + 1] += h * w4.y; lg[4 * q + 2] += h * w4.z; lg[4 * q + 3] += h * w4.w; }
                    asm volatile("" ::: "memory"); }
            }
        }
        if (WHICH == 1 && !FIRST) {
#pragma unroll
            for (int q = 0; q < 16; ++q) { const float s = wave_sum(lg[q], c.lane); if (c.lane == q) LOGIT[(size_t)r * 16 + q] = s; }
        }
    }
}

constexpr size_t FILT_SLOT = 9 * MiB;
DI void filters_task(const Ctx& c, int l, int task) {
    const float* w1 = c.in[15] + l * 33 * 64; const float* b1 = c.in[16] + l * 64; const float* fr = c.in[17] + l * 64;
    const float* w2 = c.in[18] + l * 64 * 64; const float* b2 = c.in[19] + l * 64; const float* w3 = c.in[20] + (size_t)l * 64 * 1024; const float* b3 = c.in[21] + l * 1024;
    bf16* RL = (bf16*)(c.ws + WS_FILT + (l & 1) * FILT_SLOT);
    bf16* RC = RL + 8 * MiB / 2;
    const float* skip = c.in[22] + l * 512;
    LAS float* H2 = (LAS float*)c.lds;
    const float min_decay = -3.0701134573253945f, max_decay = -15.350567286626972f;
    {
        const bool isL = task < 64; const int L = isL ? 4096 : 256, tb = isL ? task * 64 : (task - 64) * 64;
        float w1c[33], w2c[64];
#pragma unroll
        for (int i = 0; i < 33; ++i) w1c[i] = w1[i * 64 + c.lane];
#pragma unroll
        for (int i = 0; i < 64; ++i) w2c[i] = w2[i * 64 + c.lane];
        const float b1v = b1[c.lane], b2v = b2[c.lane], frv = fr[c.lane] * 0.15915494309189535f;
        for (int k = 0; k < 8; ++k) {
            const int tl = c.wave * 8 + k, t = tb + tl;
            const float tn = (float)t / (float)(L - 1), trev = (float)t / (float)L;
            float z = 0.f;
            if (c.lane == 0) z = tn;
            else if (c.lane <= 32) { const int i = (c.lane - 1) & 15; const float f = 1e-4f + (float)i * ((15.0f - 1e-4f) / 15.0f); z = (c.lane <= 16) ? cos_rev(f * trev) : -sin_rev(f * trev); }
            float a = b1v;
#pragma unroll
            for (int i = 0; i < 33; ++i) a += shi(z, i) * w1c[i];
            const float h1 = sin_rev(frv * a);
            float a2 = b2v;
#pragma unroll
            for (int i = 0; i < 64; ++i) a2 += shi(h1, i) * w2c[i];
            H2[tl * 68 + c.lane] = sin_rev(frv * a2);
        }
        __syncthreads();
        const int n = c.lane & 31, hh = c.lane >> 5;
        for (int ot = 0; ot < 4; ++ot) {
            const int o0 = c.wave * 128 + ot * 32;
            f32x16 acc[2];
#pragma unroll
            for (int tt = 0; tt < 2; ++tt)
#pragma unroll
                for (int i = 0; i < 16; ++i) acc[tt][i] = 0.f;
#pragma unroll
            for (int ks = 0; ks < 4; ++ks) {
                float wv[8];
#pragma unroll
                for (int j = 0; j < 8; ++j) wv[j] = w3[(16 * ks + 8 * hh + j) * 1024 + o0 + n];
                u32x4 ah, al;
#pragma unroll
                for (int j = 0; j < 4; ++j) { const float x0 = wv[2 * j], x1 = wv[2 * j + 1]; const bf16 h0 = f2bf(x0), h1 = f2bf(x1);
                    ah[j] = (unsigned)h0 | ((unsigned)h1 << 16); al[j] = pk2(x0 - bf2f(h0), x1 - bf2f(h1)); }
#pragma unroll
                for (int tt = 0; tt < 2; ++tt) {
                    const LAS f32x4* hp = (const LAS f32x4*)(H2 + (32 * tt + n) * 68 + 16 * ks + 8 * hh); const f32x4 p0 = hp[0], p1 = hp[1];
                    const float hv[8] = {p0.x, p0.y, p0.z, p0.w, p1.x, p1.y, p1.z, p1.w};
                    u32x4 bh, bl;
#pragma unroll
                    for (int j = 0; j < 4; ++j) { const float x0 = hv[2 * j], x1 = hv[2 * j + 1]; const bf16 h0 = f2bf(x0), h1 = f2bf(x1);
                        bh[j] = (unsigned)h0 | ((unsigned)h1 << 16); bl[j] = pk2(x0 - bf2f(h0), x1 - bf2f(h1)); }
                    const bf16x8v Ah = __builtin_bit_cast(bf16x8v, ah), Al = __builtin_bit_cast(bf16x8v, al), Bh = __builtin_bit_cast(bf16x8v, bh), Bl = __builtin_bit_cast(bf16x8v, bl);
                    acc[tt] = __builtin_amdgcn_mfma_f32_32x32x16_bf16(Ah, Bh, acc[tt], 0, 0, 0);
                    acc[tt] = __builtin_amdgcn_mfma_f32_32x32x16_bf16(Ah, Bl, acc[tt], 0, 0, 0);
                    acc[tt] = __builtin_amdgcn_mfma_f32_32x32x16_bf16(Al, Bh, acc[tt], 0, 0, 0);
                }
            }
#pragma unroll
            for (int tt = 0; tt < 2; ++tt) { const int t = tb + 32 * tt + n; const float tn = (float)t / (float)(L - 1);
#pragma unroll
                for (int i = 0; i < 16; ++i) { const int oo = o0 + (i & 3) + 8 * (i >> 2) + 4 * hh, dir = oo >> 9, ch = oo & 511;
                    const float delta = fabsf(min_decay + (float)ch * ((max_decay - min_decay) / 511.0f));
                    float val = (acc[tt][i] + b3[oo]) * __expf(-tn * delta);
                    if (t == 0) val = dir == 0 ? val + skip[ch] : 0.f;
                    const int q = dir == 0 ? L - t : (t == 0 ? 0 : L + t);
                    if (isL) RL[(size_t)ch * 8192 + q] = f2bf(val); else RC[(size_t)ch * 512 + q] = f2bf(val); } }
        }
    }
}
DI void phase_filters(const Ctx& c, int l) {
    for (int task = c.bid; task < 68; task += c.G) { __syncthreads(); Ctx cf = c; { const int lq = fresh_lane(); cf.lane = lq; cf.tid = c.wave * 64 + lq; } filters_task(cf, l, task); }
    __syncthreads();
}

enum { EPI_PROJ = 0, EPI_RES1 = 1, EPI_H = 2, EPI_RES2 = 3 };
template <int EPI>
DI void phase_gemm_naive(const Ctx& c, int l) {
    const bf16* A; int lda, K, N, ldw; const float* W;
    if (EPI == EPI_PROJ) { A = (const bf16*)(c.ws + WS_A); lda = D; K = D; N = NP; ldw = IN_COLS; W = c.in[9] + (size_t)l * D * IN_COLS; }
    else if (EPI == EPI_RES1) { A = (const bf16*)(c.ws + WS_R1) + 2560; lda = NP; K = D; N = D; ldw = D; W = c.in[23] + (size_t)l * D * D; }
    else if (EPI == EPI_H) { A = (const bf16*)(c.ws + WS_A); lda = D; K = D; N = FF; ldw = FF; W = c.in[24] + (size_t)l * D * FF; }
    else { A = (const bf16*)(c.ws + WS_R1); lda = FF; K = FF; N = D; ldw = D; W = c.in[25] + (size_t)l * FF * D; }
    const float* MOD = (const float*)(c.ws + WS_MOD);
    const float* RSS1 = (const float*)(c.ws + WS_RSS1); const float* RSS2 = (const float*)(c.ws + WS_RSS2);
    const float* SWIN = (const float*)(c.ws + WS_SWIN); const float* SW1 = (const float*)(c.ws + WS_SW1);
    bf16* PROJ = (bf16*)(c.ws + WS_R1); bf16* Hb = (bf16*)(c.ws + WS_R1);
    LAS float* As = (LAS float*)c.lds;
    LAS float* Bs = As + 16 * 68;
    const int ty = c.tid >> 5, tx = c.tid & 31;
    const int nMt = NTOK / 64, nNt = N / 128;
    for (int tile = c.bid; tile < nMt * nNt; tile += c.G) {
        const int tm = tile / nNt, tn = tile % nNt, row0 = tm * 64, col0 = tn * 128;
        float acc[4][4];
#pragma unroll
        for (int i = 0; i < 4; ++i)
#pragma unroll
            for (int j = 0; j < 4; ++j) acc[i][j] = 0.f;
        for (int k0 = 0; k0 < K; k0 += 16) {
            { const int ar = c.tid >> 3, kp = (c.tid & 7) * 2; const unsigned u = *(const unsigned*)(A + (size_t)(row0 + ar) * lda + k0 + kp);
              As[kp * 68 + ar] = bf2f((bf16)(u & 0xffffu)); As[(kp + 1) * 68 + ar] = bf2f((bf16)(u >> 16)); }
            { const int kr = c.tid >> 5, c4 = (c.tid & 31) * 4; int col = col0 + c4; if (EPI == EPI_PROJ && col >= 2048) col += 16;
              const f32x4 w = *(const f32x4*)(W + (size_t)(k0 + kr) * ldw + col); *(LAS f32x4*)(Bs + kr * 128 + c4) = w; }
            __syncthreads();
#pragma unroll
            for (int kk = 0; kk < 16; ++kk) { const f32x4 a = *(const LAS f32x4*)(As + kk * 68 + ty * 4); const f32x4 b = *(const LAS f32x4*)(Bs + kk * 128 + tx * 4);
#pragma unroll
                for (int i = 0; i < 4; ++i)
#pragma unroll
                    for (int j = 0; j < 4; ++j) acc[i][j] += a[i] * b[j]; }
            __syncthreads();
        }
#pragma unroll
        for (int i = 0; i < 4; ++i) {
            const int r = row0 + ty * 4 + i, mb = mod_of_row(r), n = col0 + tx * 4;
            if (EPI == EPI_PROJ) {
                const float rstd = rsqrtf(RSS1[r] * (1.f / D) + EPS); const int oc = n >= 2048 ? n + 16 : n;
                const f32x4 sw = *(const f32x4*)(SWIN + (size_t)(l * 5 + mb) * IN_COLS + oc);
                u32x2 w; w.x = pk2(acc[i][0] * rstd + sw.x, acc[i][1] * rstd + sw.y); w.y = pk2(acc[i][2] * rstd + sw.z, acc[i][3] * rstd + sw.w);
                *(u32x2*)(PROJ + (size_t)r * NP + n) = w;
            } else if (EPI == EPI_H) {
                const float rstd = rsqrtf(RSS2[r] * (1.f / D) + EPS);
                const f32x4 sw = *(const f32x4*)(SW1 + (size_t)(l * 5 + mb) * FF + n);
                float v[4];
#pragma unroll
                for (int j = 0; j < 4; ++j) { float t = acc[i][j] * rstd + sw[j]; t = t > 0.f ? t : 0.f; v[j] = t * t; }
                u32x2 w; w.x = pk2(v[0], v[1]); w.y = pk2(v[2], v[3]);
                *(u32x2*)(Hb + (size_t)r * FF + n) = w;
            } else {
                const f32x4 gate = *(const f32x4*)(MOD + (size_t)(l * 5 + mb) * 6144 + (EPI == EPI_RES1 ? 2 : 5) * 1024 + n);
                f32x4* xp = (f32x4*)(c.X + (size_t)r * D + n); f32x4 x = *xp;
                x.x += gate.x * acc[i][0]; x.y += gate.y * acc[i][1]; x.z += gate.z * acc[i][2]; x.w += gate.w * acc[i][3];
                *xp = x;
            }
        }
    }
}


namespace pg8 {
#define PG8_LAS __attribute__((address_space(3)))
typedef unsigned short bf16_t;
typedef short bf16x8 __attribute__((ext_vector_type(8)));
typedef float f32x4 __attribute__((ext_vector_type(4)));
typedef unsigned u32x4 __attribute__((ext_vector_type(4)));
constexpr int BM = 256, BK = 64, HALF = 128, HTB = HALF * BK * 2  , STAGE_BYTES = 8 * HTB, NXCD = 8, WGM = 8;

__host__ __device__ __forceinline__ int lds_byte(int r, int c) { const int st = (r >> 4) * 2 + (c >> 5), rr = r & 15, cc = c & 31, ob = rr * 64 + cc * 2; return st * 1024 + (ob ^ (((ob >> 9) & 1) << 5)); }
__host__ __device__ __forceinline__ void stage_rc(int b, int& R, int& C) { const int st = b / 1024, sb = b % 1024, swz = sb ^ (((sb >> 9) & 1) << 5); R = (st >> 1) * 16 + swz / 64; C = (st & 1) * 32 + (swz % 64) / 2; }
__host__ __device__ __forceinline__ int perm32(int rho) { const int n = rho >> 4, i = rho & 15; return 8 * (i >> 2) + 4 * n + (i & 3); }

struct Unit { int pm, pn; };
struct Gemm { const bf16_t* A; const bf16_t* Bt; int M, N, K, lda; };

struct StaticOrder {
    int nM, nN, nwg, G, c;
    __host__ __device__ void init(int M, int N, int G_, int c_) { nM = M / BM; nN = N / BM; nwg = nM * nN; G = G_; c = c_; }
    __host__ __device__ bool next(int i, Unit& u) const {
        const long L = (long)i * G + c; if (L >= nwg) return false;
        int wgid = (int)L; { const int q = nwg / NXCD, r = nwg % NXCD, xcd = wgid % NXCD, off = wgid / NXCD; wgid = (xcd < r ? xcd * (q + 1) : r * (q + 1) + (xcd - r) * q) + off; }
        const int nig = WGM * nN, gid = wgid / nig, fm = gid * WGM, gsz = (nM - fm) < WGM ? (nM - fm) : WGM;
        u.pm = fm + ((wgid % nig) % gsz); u.pn = (wgid % nig) / gsz; return true;
    }
    __device__ __forceinline__ void a_ready(const Unit&) const {}
    __device__ __forceinline__ void done(const Unit&) const {}
};

template <int N_, int K_, int LDA_, int LDB_ = K_> struct GemmT { const bf16_t* A; const bf16_t* Bt; static constexpr int M = 20480, N = N_, K = K_, lda = LDA_, ldb = LDB_; };
template <int N_> struct StaticOrderT {
    static constexpr int nM = 20480 / BM, nN = N_ / BM, nwg = nM * nN; int G, c;
    __device__ __forceinline__ bool next(int i, Unit& u) const {
        const int L = i * G + c; if (L >= nwg) return false;
        int wgid = L; { constexpr int q = nwg / NXCD, r = nwg % NXCD; const int xcd = wgid % NXCD, off = wgid / NXCD; wgid = (xcd < r ? xcd * (q + 1) : r * (q + 1) + (xcd - r) * q) + off; }
        constexpr int nig = WGM * nN; const int gid = wgid / nig, fm = gid * WGM, gsz = (nM - fm) < WGM ? (nM - fm) : WGM;
        u.pm = fm + ((wgid % nig) % gsz); u.pn = (wgid % nig) / gsz; return true;
    }
    __device__ __forceinline__ void a_ready(const Unit&) const {}
    __device__ __forceinline__ void done(const Unit&) const {}
};
template <class Epi, class Sched, class GemmX, bool ALIGN_EPI = false, bool SP2 = false>
__device__ __forceinline__ void gemm_phase(PG8_LAS unsigned char* lds, const GemmX g, const Sched& S, const Epi& E, const int tid) {
    const int wid = __builtin_amdgcn_readfirstlane(tid >> 6), lane = tid & 63, wr = wid >> 2, wc = wid & 3, fr = lane & 15, fq = lane >> 4;
    constexpr int K = GemmX::K, nt = K / BK;
    unsigned voffA[2], voffB[2];
#pragma unroll
    for (int i = 0; i < 2; ++i) { int R, C; stage_rc(tid * 16 + i * 8192, R, C); const int Rb = Epi::PERM ? ((R & ~31) + perm32(R & 31)) : R;
        voffA[i] = (unsigned)(R * GemmX::lda + C) * 2u; voffB[i] = (unsigned)(Rb * GemmX::ldb + C) * 2u; }
    constexpr size_t kstep = (size_t)(BK * 2);
    constexpr size_t hstepA = (size_t)HALF * GemmX::lda * 2, hstepB = (size_t)HALF * GemmX::ldb * 2;
    constexpr size_t tstepA = 2 * hstepA, tstepB = 2 * hstepB;
    const unsigned ldsw = (unsigned)wid * 1024u;
    const int aoff = lds_byte(wr * 64 + fr, fq * 8), boff = lds_byte(wc * 32 + fr, fq * 8);
#define PG8_SA(b, h) (((b) * 2 + (h)) * HTB)
#define PG8_SB(b, h) ((4 + (b) * 2 + (h)) * HTB)
#define PG8_STAGE(bufoff, gbase, voff) do { _Pragma("unroll") for (int _i = 0; _i < 2; ++_i) \
        __builtin_amdgcn_global_load_lds((const unsigned*)((const char*)(gbase) + (voff)[_i]), (PG8_LAS unsigned*)(lds + (bufoff) + ldsw + _i * 8192), 16, 0, 0); } while (0)
#define PG8_LDA(dst, b, h) do { _Pragma("unroll") for (int m = 0; m < 4; ++m) _Pragma("unroll") for (int k = 0; k < 2; ++k) dst[m][k] = *(const PG8_LAS bf16x8*)(lds + PG8_SA(b, h) + aoff + m * 2048 + k * 1024); } while (0)
#define PG8_LDB(dst, b, h) do { _Pragma("unroll") for (int n = 0; n < 2; ++n) _Pragma("unroll") for (int k = 0; k < 2; ++k) dst[n][k] = *(const PG8_LAS bf16x8*)(lds + PG8_SB(b, h) + boff + n * 2048 + k * 1024); } while (0)
#define PG8_MMA(ai, bj, At, Bt) do { __builtin_amdgcn_s_setprio(1); _Pragma("unroll") for (int m = 0; m < 4; ++m) _Pragma("unroll") for (int n = 0; n < 2; ++n) _Pragma("unroll") for (int k = 0; k < 2; ++k) \
        acc[ai][bj][m][n] = __builtin_amdgcn_mfma_f32_16x16x32_bf16(Bt[n][k], At[m][k], acc[ai][bj][m][n], 0, 0, 0); __builtin_amdgcn_s_setprio(0); } while (0)
#define PG8_WAIT_V(n) asm volatile("s_waitcnt vmcnt(" #n ")" ::: "memory")
#define PG8_WAIT_L(n) asm volatile("s_waitcnt lgkmcnt(" #n ")" ::: "memory")
#define PG8_BAR __builtin_amdgcn_s_barrier()
#define PG8_SCHED __builtin_amdgcn_sched_barrier(0)
    Unit cur, nxt; int ui = 0;
    if (!S.next(0, cur)) return;
    f32x4 acc[2][2][4][2];
#pragma unroll
    for (int a = 0; a < 2; ++a)
#pragma unroll
        for (int b = 0; b < 2; ++b)
#pragma unroll
            for (int m = 0; m < 4; ++m)
#pragma unroll
                for (int n = 0; n < 2; ++n) acc[a][b][m][n] = (f32x4){0.f, 0.f, 0.f, 0.f};
    bf16x8 At[4][2], B0[2][2], B1[2][2];
    const char* cA = (const char*)g.A + (size_t)cur.pm * tstepA; const char* cB = (const char*)g.Bt + (size_t)cur.pn * tstepB;
    S.a_ready(cur);
    if constexpr (SP2) {
        PG8_STAGE(PG8_SB(0, 0), cB, voffB); PG8_STAGE(PG8_SB(0, 1), cB + hstepB, voffB); PG8_STAGE(PG8_SA(0, 0), cA, voffA); PG8_STAGE(PG8_SA(0, 1), cA + hstepA, voffA);
        if (wr == 1) PG8_BAR;
        PG8_WAIT_V(2); PG8_BAR;
        PG8_STAGE(PG8_SB(1, 0), cB + kstep, voffB); PG8_STAGE(PG8_SA(1, 0), cA + kstep, voffA); PG8_STAGE(PG8_SB(1, 1), cB + hstepB + kstep, voffB);
        PG8_WAIT_V(6); PG8_BAR;
    } else {
        PG8_STAGE(PG8_SB(0, 0), cB, voffB); PG8_STAGE(PG8_SA(0, 0), cA, voffA); PG8_STAGE(PG8_SB(0, 1), cB + hstepB, voffB); PG8_STAGE(PG8_SA(0, 1), cA + hstepA, voffA);
        if (wr == 1) PG8_BAR;
        PG8_WAIT_V(4); PG8_BAR;
        PG8_STAGE(PG8_SB(1, 0), cB + kstep, voffB); PG8_STAGE(PG8_SA(1, 0), cA + kstep, voffA); PG8_STAGE(PG8_SB(1, 1), cB + hstepB + kstep, voffB);
        PG8_WAIT_V(6); PG8_BAR;
    }
    for (;;) {
        const bool has_next = S.next(ui + 1, nxt);
        const char* nA = has_next ? (const char*)g.A + (size_t)nxt.pm * tstepA : cA; const char* nB = has_next ? (const char*)g.Bt + (size_t)nxt.pn * tstepB : cB;
        for (int t = 0; t < nt; t += 2) {
            const bool last = (t == nt - 2);
            const char* a1 = cA + (size_t)(t + 1) * kstep;
            const char* a2 = last ? nA : cA + (size_t)(t + 2) * kstep; const char* b2 = last ? nB : cB + (size_t)(t + 2) * kstep;
            const char* a3 = a2 + kstep; const char* b3 = b2 + kstep;
            if (last && has_next) S.a_ready(nxt);
            if constexpr (SP2) {
            PG8_LDB(B0, 0, 0); PG8_LDB(B1, 0, 1); PG8_SCHED; PG8_LDA(At, 0, 0); PG8_STAGE(PG8_SA(1, 1), a1 + hstepA, voffA);
            PG8_WAIT_V(8); PG8_WAIT_L(0); PG8_BAR; PG8_MMA(0, 0, At, B0); PG8_MMA(0, 1, At, B1); PG8_BAR; PG8_SCHED;
            PG8_LDA(At, 0, 1); PG8_STAGE(PG8_SB(0, 0), b2, voffB); PG8_STAGE(PG8_SB(0, 1), b2 + hstepB, voffB); PG8_STAGE(PG8_SA(0, 0), a2, voffA);
            PG8_WAIT_V(8); PG8_WAIT_L(0); PG8_BAR; PG8_MMA(1, 0, At, B0); PG8_MMA(1, 1, At, B1); PG8_BAR; PG8_SCHED;
            PG8_LDB(B0, 1, 0); PG8_LDB(B1, 1, 1); PG8_SCHED; PG8_LDA(At, 1, 0); PG8_STAGE(PG8_SA(0, 1), a2 + hstepA, voffA);
            PG8_WAIT_V(8); PG8_WAIT_L(0); PG8_BAR; PG8_MMA(0, 0, At, B0); PG8_MMA(0, 1, At, B1); PG8_BAR; PG8_SCHED;
            PG8_LDA(At, 1, 1); PG8_STAGE(PG8_SB(1, 0), b3, voffB); PG8_STAGE(PG8_SB(1, 1), b3 + hstepB, voffB); PG8_STAGE(PG8_SA(1, 0), a3, voffA);
            PG8_WAIT_V(8); PG8_WAIT_L(0); PG8_BAR; PG8_MMA(1, 0, At, B0); PG8_MMA(1, 1, At, B1); PG8_BAR; PG8_SCHED;
            } else {
            PG8_LDB(B0, 0, 0); PG8_SCHED; PG8_LDA(At, 0, 0); PG8_STAGE(PG8_SA(1, 1), a1 + hstepA, voffA);
            PG8_WAIT_L(8); PG8_BAR; PG8_WAIT_L(0); PG8_MMA(0, 0, At, B0); PG8_BAR; PG8_SCHED;
            PG8_LDB(B1, 0, 1); PG8_STAGE(PG8_SB(0, 0), b2, voffB);
            PG8_BAR; PG8_WAIT_L(0); PG8_MMA(0, 1, At, B1); PG8_BAR;
            PG8_LDA(At, 0, 1); PG8_STAGE(PG8_SA(0, 0), a2, voffA);
            PG8_BAR; PG8_WAIT_L(0); PG8_MMA(1, 0, At, B0); PG8_BAR; PG8_SCHED;
            PG8_STAGE(PG8_SB(0, 1), b2 + hstepB, voffB);
            PG8_WAIT_V(6); PG8_BAR; PG8_MMA(1, 1, At, B1); PG8_BAR;
            PG8_LDB(B0, 1, 0); PG8_SCHED; PG8_LDA(At, 1, 0); PG8_STAGE(PG8_SA(0, 1), a2 + hstepA, voffA);
            PG8_WAIT_L(8); PG8_BAR; PG8_WAIT_L(0); PG8_MMA(0, 0, At, B0); PG8_BAR; PG8_SCHED;
            PG8_LDB(B1, 1, 1); PG8_STAGE(PG8_SB(1, 0), b3, voffB);
            PG8_BAR; PG8_WAIT_L(0); PG8_MMA(0, 1, At, B1); PG8_BAR;
            PG8_LDA(At, 1, 1); PG8_STAGE(PG8_SA(1, 0), a3, voffA);
            PG8_BAR; PG8_WAIT_L(0); PG8_MMA(1, 0, At, B0); PG8_BAR; PG8_SCHED;
            PG8_STAGE(PG8_SB(1, 1), b3 + hstepB, voffB);
            PG8_WAIT_V(6); PG8_BAR; PG8_MMA(1, 1, At, B1); PG8_BAR;
            }
        }
        if constexpr (ALIGN_EPI) { if (wr == 0) PG8_BAR; }
        if constexpr (!Epi::AFTER_DRAIN) { E(acc, cur, wr, wc, fr, fq); S.done(cur); }
        if (!has_next) break;
#pragma unroll
        for (int a = 0; a < 2; ++a)
#pragma unroll
            for (int b = 0; b < 2; ++b)
#pragma unroll
                for (int m = 0; m < 4; ++m)
#pragma unroll
                    for (int n = 0; n < 2; ++n) acc[a][b][m][n] = (f32x4){0.f, 0.f, 0.f, 0.f};
        cur = nxt; cA = nA; cB = nB; ++ui;
        if constexpr (ALIGN_EPI) { if (wr == 1) PG8_BAR; }
    }
    PG8_WAIT_V(0);
    if constexpr (!ALIGN_EPI) { if (wr == 0) PG8_BAR; }
    PG8_BAR;
    if constexpr (Epi::AFTER_DRAIN) { E.fused(acc, cur, wr, wc, fr, fq, lds, wid, lane); S.done(cur); }
#undef PG8_SA
#undef PG8_SB
#undef PG8_STAGE
#undef PG8_LDA
#undef PG8_LDB
#undef PG8_MMA
#undef PG8_WAIT_V
#undef PG8_WAIT_L
#undef PG8_BAR
#undef PG8_SCHED
}
}
namespace pg8 {
__device__ __forceinline__ unsigned cvt_pk_bf16(float lo, float hi) { unsigned r; asm volatile("v_cvt_pk_bf16_f32 %0, %1, %2" : "=v"(r) : "v"(lo), "v"(hi)); return r; }
DI int tile_mb(int pm) { return pm < 16 ? 4 : ((pm - 16) >> 4); }
struct EpiProj {
    static constexpr bool PERM = true, AFTER_DRAIN = false;
    int l;
    __device__ __forceinline__ void operator()(const f32x4 (&acc)[2][2][4][2], const Unit& u, int wr, int wc, int fr, int fq) const {
        KPc kp = (KPc)__builtin_amdgcn_kernarg_segment_ptr(); asm volatile("" : "+s"(kp));
        unsigned char* ws = kp->ws; bf16_t* O = (bf16_t*)(ws + WS_R1); const float* RSS = (const float*)(ws + WS_RSSP1);
        const int row0 = u.pm * BM + wr * 64 + fr, col0 = u.pn * BM + wc * 32 + 8 * fq;
        const float* sw = (const float*)(ws + WS_SWIN) + (size_t)(l * 5 + tile_mb(u.pm)) * IN_COLS;
        if (u.pn == 14) {
            if (wc == 0) {
                float* LOGIT = (float*)(ws + WS_LOGIT); const int lane = fr + 16 * fq;
                const f32x4 s0 = *(const f32x4*)(sw + 2048 + 8 * (fq & 1)), s1 = *(const f32x4*)(sw + 2048 + 8 * (fq & 1) + 4);
#pragma unroll
                for (int ai = 0; ai < 2; ++ai)
#pragma unroll
                    for (int m = 0; m < 4; ++m) { const int r = row0 + ai * HALF + m * 16; const float rstd = rsqrtf(rss_read(RSS, r) * (1.f / D) + EPS);
                        f32x4 v0 = acc[ai][0][m][0], v1 = acc[ai][0][m][1];
#pragma unroll
                        for (int e = 0; e < 4; ++e) { v0[e] += shx(v0[e], 32, lane); v1[e] += shx(v1[e], 32, lane); }
                        if (fq < 2) { *(f32x4*)(LOGIT + (size_t)r * 16 + 8 * fq) = v0 * rstd + s0; *(f32x4*)(LOGIT + (size_t)r * 16 + 8 * fq + 4) = v1 * rstd + s1; } }
            }
            return;
        }
        f32x4 bv[2][2];
#pragma unroll
        for (int bj = 0; bj < 2; ++bj)
#pragma unroll
            for (int n = 0; n < 2; ++n) { const int cc = col0 + bj * HALF + 4 * n; bv[bj][n] = *(const f32x4*)(sw + (cc >= 2048 ? cc + 16 : cc)); }
#pragma unroll
        for (int ai = 0; ai < 2; ++ai)
#pragma unroll
            for (int m = 0; m < 4; ++m) { const int r = row0 + ai * HALF + m * 16; const float rstd = rsqrtf(rss_read(RSS, r) * (1.f / D) + EPS); bf16_t* rowp = O + (size_t)r * NP + col0;
#pragma unroll
                for (int bj = 0; bj < 2; ++bj) { const f32x4 v0 = acc[ai][bj][m][0] * rstd + bv[bj][0], v1 = acc[ai][bj][m][1] * rstd + bv[bj][1];
                    u32x4 w; w.x = cvt_pk_bf16(v0[0], v0[1]); w.y = cvt_pk_bf16(v0[2], v0[3]); w.z = cvt_pk_bf16(v1[0], v1[1]); w.w = cvt_pk_bf16(v1[2], v1[3]);
                    *(u32x4*)(rowp + bj * HALF) = w; } }
    }
};
struct EpiH {
    static constexpr bool PERM = true, AFTER_DRAIN = false;
    int l;
    __device__ __forceinline__ void operator()(const f32x4 (&acc)[2][2][4][2], const Unit& u, int wr, int wc, int fr, int fq) const {
        KPc kp = (KPc)__builtin_amdgcn_kernarg_segment_ptr(); asm volatile("" : "+s"(kp));
        unsigned char* ws = kp->ws; bf16_t* O = (bf16_t*)(ws + WS_R1); const float* RSS = (const float*)(ws + WS_RSSP2);
        const int row0 = u.pm * BM + wr * 64 + fr, col0 = u.pn * BM + wc * 32 + 8 * fq;
        const float* sw = (const float*)(ws + WS_SW1) + (size_t)(l * 5 + tile_mb(u.pm)) * FF;
        f32x4 bv[2][2];
#pragma unroll
        for (int bj = 0; bj < 2; ++bj)
#pragma unroll
            for (int n = 0; n < 2; ++n) bv[bj][n] = *(const f32x4*)(sw + col0 + bj * HALF + 4 * n);
#pragma unroll
        for (int ai = 0; ai < 2; ++ai)
#pragma unroll
            for (int m = 0; m < 4; ++m) { const int r = row0 + ai * HALF + m * 16; const float rstd = rsqrtf(rss_read(RSS, r) * (1.f / D) + EPS); bf16_t* rowp = O + (size_t)r * FF + col0;
#pragma unroll
                for (int bj = 0; bj < 2; ++bj) { f32x4 v0 = acc[ai][bj][m][0] * rstd + bv[bj][0], v1 = acc[ai][bj][m][1] * rstd + bv[bj][1];
                    v0 = __builtin_elementwise_max(v0, (f32x4){0.f, 0.f, 0.f, 0.f}); v1 = __builtin_elementwise_max(v1, (f32x4){0.f, 0.f, 0.f, 0.f}); v0 = v0 * v0; v1 = v1 * v1;
                    u32x4 w; w.x = cvt_pk_bf16(v0[0], v0[1]); w.y = cvt_pk_bf16(v0[2], v0[3]); w.z = cvt_pk_bf16(v1[0], v1[1]); w.w = cvt_pk_bf16(v1[2], v1[3]);
                    *(u32x4*)(rowp + bj * HALF) = w; } }
    }
};
template <int WHICH>
struct EpiRes {
    static constexpr bool PERM = true, AFTER_DRAIN = false;
    int l;
    struct Cols { f32x4 gt[2][2], gs[2][2]; float* X; const float* Xin; bf16_t* An; float* RSS; bool has_next; int row0, col0, pn, wc; };
    __device__ __forceinline__ void prepare(Cols& q, const Unit& u, int wr, int wc, int fr, int fq) const {
        KPc kp = (KPc)__builtin_amdgcn_kernarg_segment_ptr(); asm volatile("" : "+s"(kp));
        unsigned char* ws = kp->ws; q.X = kp->out; const float* MOD = (const float*)(ws + WS_MOD);
        q.Xin = (WHICH == 1 && l == 0) ? (u.pm < 16 ? kp->in[0] : kp->in[1] - (size_t)NCTX * D) : (const float*)kp->out;
        q.has_next = (WHICH == 1) || (l + 1 < DEPTH); const int ln = (WHICH == 1) ? l : (q.has_next ? l + 1 : l);
        const int mb = tile_mb(u.pm);
        const float* gateb = MOD + (size_t)(l * 5 + mb) * 6144 + (WHICH == 1 ? 2 : 5) * 1024;
        const float* scaleb = MOD + (size_t)(ln * 5 + mb) * 6144 + (WHICH == 1 ? 4 : 1) * 1024;
        const float* ng = (WHICH == 1 ? kp->in[8] : kp->in[7]) + ln * 1024;
        q.An = (bf16_t*)(ws + WS_A); q.RSS = (float*)(ws + (WHICH == 1 ? WS_RSSP2 : WS_RSSP1));
        q.row0 = u.pm * BM + wr * 64 + fr; q.col0 = u.pn * BM + wc * 32 + 8 * fq; q.pn = u.pn; q.wc = wc;
#pragma unroll
        for (int bj = 0; bj < 2; ++bj)
#pragma unroll
            for (int n = 0; n < 2; ++n) { const int cc = q.col0 + bj * HALF + 4 * n; q.gt[bj][n] = *(const f32x4*)(gateb + cc);
                q.gs[bj][n] = *(const f32x4*)(ng + cc) * (*(const f32x4*)(scaleb + cc) + 1.0f); }
    }
    __device__ __forceinline__ void rowgroup(const Cols& q, int ai, int m, const f32x4 (&v)[2][2], int fr, int fq) const {
        const int r = q.row0 + ai * HALF + m * 16; float* xp = q.X + (size_t)r * D + q.col0; const float* xi = q.Xin + (size_t)r * D + q.col0; float ss = 0.f;
#pragma unroll
        for (int bj = 0; bj < 2; ++bj) { f32x4 x0 = *(const f32x4*)(xi + bj * HALF), x1 = *(const f32x4*)(xi + bj * HALF + 4);
            x0 = x0 + q.gt[bj][0] * v[bj][0]; x1 = x1 + q.gt[bj][1] * v[bj][1];
            *(f32x4*)(xp + bj * HALF) = x0; *(f32x4*)(xp + bj * HALF + 4) = x1;
            ss += (x0[0] * x0[0] + x0[1] * x0[1]) + (x0[2] * x0[2] + x0[3] * x0[3]) + (x1[0] * x1[0] + x1[1] * x1[1]) + (x1[2] * x1[2] + x1[3] * x1[3]);
            if (q.has_next) { const f32x4 a0 = x0 * q.gs[bj][0], a1 = x1 * q.gs[bj][1];
                u32x4 w; w.x = cvt_pk_bf16(a0[0], a0[1]); w.y = cvt_pk_bf16(a0[2], a0[3]); w.z = cvt_pk_bf16(a1[0], a1[1]); w.w = cvt_pk_bf16(a1[2], a1[3]);
                *(u32x4*)(q.An + (size_t)r * D + q.col0 + bj * HALF) = w; } }
        ss += shx(ss, 16, fr + 16 * fq); ss += shx(ss, 32, fr + 16 * fq);
        if (fq == 0) q.RSS[(size_t)r * 16 + q.pn * 4 + q.wc] = ss;
    }
    __device__ __forceinline__ void operator()(const f32x4 (&acc)[2][2][4][2], const Unit& u, int wr, int wc, int fr, int fq) const {
        Cols q; prepare(q, u, wr, wc, fr, fq);
#pragma unroll
        for (int ai = 0; ai < 2; ++ai)
#pragma unroll
            for (int m = 0; m < 4; ++m) { const f32x4 v[2][2] = {{acc[ai][0][m][0], acc[ai][0][m][1]}, {acc[ai][1][m][0], acc[ai][1][m][1]}};
                rowgroup(q, ai, m, v, fr, fq);
                if (m & 1) asm volatile("" ::: "memory"); }
    }
};
struct FirstRoundOrder {
    int c;
    __device__ __forceinline__ bool next(int i, Unit& u) const { if (i > 0) return false; StaticOrderT<1024> S{256, c}; return S.next(0, u); }
    __device__ __forceinline__ void a_ready(const Unit&) const {}
    __device__ __forceinline__ void done(const Unit&) const {}
};
struct TailOrder {
    int c;
    __device__ __forceinline__ bool next(int i, Unit& u) const { if (i > 0) return false; StaticOrderT<1024> S{256, c >> 2}; return S.next(1, u); }
    __device__ __forceinline__ void a_ready(const Unit&) const {}
    __device__ __forceinline__ void done(const Unit&) const {}
};
struct EpiSlab {
    static constexpr bool PERM = true, AFTER_DRAIN = false;
    float* slab; int tid;
    __device__ __forceinline__ void operator()(const f32x4 (&acc)[2][2][4][2], const Unit&, int, int, int, int) const {
        f32x4* p = (f32x4*)slab + tid;
#pragma unroll
        for (int ai = 0; ai < 2; ++ai)
#pragma unroll
            for (int bj = 0; bj < 2; ++bj)
#pragma unroll
                for (int m = 0; m < 4; ++m)
#pragma unroll
                    for (int n = 0; n < 2; ++n) p[(((ai * 2 + bj) * 4 + m) * 2 + n) * 512] = acc[ai][bj][m][n];
    }
};
}

constexpr int NPL = 3840;
constexpr size_t WT_IN = WS_WT, WT_OUT = WS_WT + 8 * MiB, WT_1 = WS_WT + 10 * MiB, WT_2 = WS_WT + 18 * MiB;

template <int EPI>
DI void phase_gemm_fast(const Ctx& c, int l) {
    if (EPI == EPI_PROJ) {
        pg8::GemmT<NPL, D, D> g{(const bf16*)(c.ws + WS_A), (const bf16*)(c.ws + WT_IN)}; pg8::StaticOrderT<NPL> S{c.G, c.bid}; pg8::EpiProj E{l};
        pg8::gemm_phase<pg8::EpiProj, pg8::StaticOrderT<NPL>, pg8::GemmT<NPL, D, D>, true, true>(c.lds, g, S, E, c.tid);
    } else if (EPI == EPI_H) {
        pg8::GemmT<FF, D, D> g{(const bf16*)(c.ws + WS_A), (const bf16*)(c.ws + WT_1)}; pg8::StaticOrderT<FF> S{c.G, c.bid}; pg8::EpiH E{l};
        pg8::gemm_phase<pg8::EpiH, pg8::StaticOrderT<FF>, pg8::GemmT<FF, D, D>, true, true>(c.lds, g, S, E, c.tid);
    } else if (EPI == EPI_RES1) {
        pg8::GemmT<D, D, NP> g{(const bf16*)(c.ws + WS_R1) + 2560, (const bf16*)(c.ws + WT_OUT)}; pg8::StaticOrderT<D> S{c.G, c.bid}; pg8::EpiRes<1> E{l};
        pg8::gemm_phase<pg8::EpiRes<1>, pg8::StaticOrderT<D>, pg8::GemmT<D, D, NP>, true, true>(c.lds, g, S, E, c.tid);
    } else {
        pg8::GemmT<D, FF, FF> g{(const bf16*)(c.ws + WS_R1), (const bf16*)(c.ws + WT_2)}; pg8::StaticOrderT<D> S{c.G, c.bid}; pg8::EpiRes<2> E{l};
        pg8::gemm_phase<pg8::EpiRes<2>, pg8::StaticOrderT<D>, pg8::GemmT<D, FF, FF>, true, true>(c.lds, g, S, E, c.tid);
    }
}

constexpr size_t WS_SLAB = WS_QKVN;
DI void phase_g4_main(const Ctx& c, int l) {
    { pg8::GemmT<D, FF, FF> g{(const bf16*)(c.ws + WS_R1), (const bf16*)(c.ws + WT_2)}; pg8::FirstRoundOrder S{c.bid}; pg8::EpiRes<2> E{l};
      pg8::gemm_phase<pg8::EpiRes<2>, pg8::FirstRoundOrder, pg8::GemmT<D, FF, FF>, true, true>(c.lds, g, S, E, c.tid); }
    { const int kq = c.bid & 3;
      pg8::GemmT<D, 1024, FF, FF> g{(const bf16*)(c.ws + WS_R1) + kq * 1024, (const bf16*)(c.ws + WT_2) + kq * 1024}; pg8::TailOrder S{c.bid};
      pg8::EpiSlab E{(float*)(c.ws + WS_SLAB) + (size_t)c.bid * 65536, c.tid};
      pg8::gemm_phase<pg8::EpiSlab, pg8::TailOrder, pg8::GemmT<D, 1024, FF, FF>, true, true>(c.lds, g, S, E, c.tid); }
}
DI void phase_g4_combine(const Ctx& c, int l) {
    pg8::Unit u; { pg8::StaticOrderT<1024> S{256, c.bid >> 2}; S.next(1, u); }
    const char* ub = (const char*)(c.ws + WS_SLAB) + (size_t)(c.bid >> 2) * 4 * 262144;
    const unsigned lo = (unsigned)c.tid * 16u;
    const int wid = c.wave, lane = c.tid & 63, fr = lane & 15, fq = lane >> 4, part = c.bid & 3;
    pg8::EpiRes<2> E{l}; pg8::EpiRes<2>::Cols q; E.prepare(q, u, wid >> 2, wid & 3, fr, fq);
    f32x4 v[2][2][2];
#pragma unroll
    for (int g2 = 0; g2 < 2; ++g2) { const int rg = part * 2 + g2;
#pragma unroll
        for (int bj = 0; bj < 2; ++bj)
#pragma unroll
            for (int n = 0; n < 2; ++n) { const int e = ((((rg >> 2) * 2 + bj) * 4 + (rg & 3)) * 2 + n) * 8192;
                const f32x4 a0 = *(const f32x4*)(ub + e + lo), a1 = *(const f32x4*)(ub + 262144 + e + lo), a2 = *(const f32x4*)(ub + 2 * 262144 + e + lo), a3 = *(const f32x4*)(ub + 3 * 262144 + e + lo);
                v[g2][bj][n] = (a0 + a1) + (a2 + a3); } }
#pragma unroll
    for (int g2 = 0; g2 < 2; ++g2) { const int rg = part * 2 + g2; E.rowgroup(q, rg >> 2, rg & 3, v[g2], fr, fq); }
}

DI void wconv_item(const float* W, int ldw, int K, int nblk, bf16* WT, LAS float* scr, int item, int lane, bool remap) {
    const int kb = item / nblk, nb = item % nblk, k0 = 64 * kb, n0 = 32 * nb; const int ns = (remap && n0 >= 2048) ? n0 + 16 : n0;
    { const int rr = lane >> 3, c4 = (lane & 7) * 4;
        f32x4 v[8];
#pragma unroll
        for (int i = 0; i < 8; ++i) v[i] = *(const f32x4*)(W + (size_t)(k0 + rr + 8 * i) * ldw + ns + c4);
#pragma unroll
        for (int i = 0; i < 8; ++i) { LAS float* sp = scr + (rr + 8 * i) * 33 + c4; sp[0] = v[i][0]; sp[1] = v[i][1]; sp[2] = v[i][2]; sp[3] = v[i][3]; } }
    asm volatile("s_waitcnt lgkmcnt(0)" ::: "memory");
    const int cch = lane & 7;
#pragma unroll
    for (int j = 0; j < 4; ++j) { const int n = (lane >> 3) + 8 * j; const LAS float* sp = scr + (8 * cch) * 33 + n;
        u32x4 o; o.x = pk2(sp[0 * 33], sp[1 * 33]); o.y = pk2(sp[2 * 33], sp[3 * 33]); o.z = pk2(sp[4 * 33], sp[5 * 33]); o.w = pk2(sp[6 * 33], sp[7 * 33]);
        *(u32x4*)(WT + (size_t)(n0 + n) * K + k0 + 8 * cch) = o; }
    asm volatile("s_waitcnt lgkmcnt(0)" ::: "memory");
}
DI void wconv_logit_item(const Ctx& c, int l, int kb) {
    const float* W = c.in[9] + (size_t)l * D * IN_COLS + 2048; bf16* WT = (bf16*)(c.ws + WT_IN);
    const int n = c.lane & 31, kh = c.lane >> 5, k0 = 64 * kb + 32 * kh;
    unsigned pk[16];
#pragma unroll
    for (int i = 0; i < 16; ++i) { const float x0 = W[(size_t)(k0 + 2 * i) * IN_COLS + (n & 15)], x1 = W[(size_t)(k0 + 2 * i + 1) * IN_COLS + (n & 15)];
        const bf16 h0 = f2bf(x0), h1 = f2bf(x1);
        pk[i] = n < 16 ? ((unsigned)h0 | ((unsigned)h1 << 16)) : pk2(x0 - bf2f(h0), x1 - bf2f(h1)); }
    u32x4* dst = (u32x4*)(WT + (size_t)(NP + n) * D + k0);
#pragma unroll
    for (int q = 0; q < 4; ++q) { u32x4 o; o.x = pk[4 * q]; o.y = pk[4 * q + 1]; o.z = pk[4 * q + 2]; o.w = pk[4 * q + 3]; dst[q] = o; }
}
DI void wconv_zero_rows(const Ctx& c) {
    u32x4* z = (u32x4*)((bf16*)(c.ws + WT_IN) + (size_t)(NP + 32) * D); const u32x4 zero4 = {0u, 0u, 0u, 0u};
    for (int i = c.bid * NTHR + c.tid; i < (NPL - NP - 32) * D / 8; i += c.G * NTHR) z[i] = zero4;
}
DI void wconv_wave_item(const Ctx& c, int l, int set, int r) {
    LAS float* scr = (LAS float*)(c.lds + c.wave * 16384);
    if (set == 0) { if (r < 16 * 112) wconv_item(c.in[9] + (size_t)l * D * IN_COLS, IN_COLS, D, 112, (bf16*)(c.ws + WT_IN), scr, r, c.lane, true); else if (r < 16 * 112 + 16) wconv_logit_item(c, l, r - 16 * 112); return; }
    constexpr int I_OUT = 16 * 32, I_1 = 16 * 128, I_2 = 64 * 32;
    if (r < I_OUT) { wconv_item(c.in[23] + (size_t)l * D * D, D, D, 32, (bf16*)(c.ws + WT_OUT), scr, r, c.lane, false); return; } r -= I_OUT;
    if (r < I_1) { wconv_item(c.in[24] + (size_t)l * D * FF, FF, D, 128, (bf16*)(c.ws + WT_1), scr, r, c.lane, false); return; } r -= I_1;
    if (r < I_2) wconv_item(c.in[25] + (size_t)l * FF * D, D, FF, 32, (bf16*)(c.ws + WT_2), scr, r, c.lane, false);
}
constexpr int WC_BLK_IN = 226, WC_BLK_REST = 576;
DI void phase_wconv_in(const Ctx& c, int l) {
    for (int bi = c.bid; bi < WC_BLK_IN; bi += c.G) wconv_wave_item(c, l, 0, bi * 8 + c.wave);
    wconv_zero_rows(c);
    __syncthreads();
}
DI void phase_zero(const Ctx& c, size_t off, int nfloats) {
    float* p = (float*)(c.ws + off);
    for (int i = c.bid * NTHR + c.tid; i < nfloats; i += c.G * NTHR) p[i] = 0.f;
}

DI void seg_of_row(int r, int& s0, int& s1) { if (r < NCTX) { s0 = r & ~255; s1 = s0 + 256; } else { s0 = r & ~63; s1 = s0 + 64; } }

DI void phase_prep_naive(const Ctx& c, int l) {
    const bf16* PROJ = (const bf16*)(c.ws + WS_R1);
    bf16* QKVN = (bf16*)(c.ws + WS_QKVN);
    const float* cw = c.in[10] + (size_t)l * 5 * 1536;
    const float* a_log = c.in[11] + l * 8; const float* dt_bias = c.in[12] + l * 8;
    const float* LOGIT = (const float*)(c.ws + WS_LOGIT);
    float* GBG = (float*)(c.ws + WS_GBG); float* GBB = (float*)(c.ws + WS_GBB);
    const int gw = c.bid * NWAVES + c.wave, NGW = c.G * NWAVES;
    for (int task = gw; task < NTOK * 4; task += NGW) {
        const int r = task >> 2, h = task & 3; int s0, s1; seg_of_row(r, s0, s1);
#pragma unroll
        for (int p = 0; p < 3; ++p) {
            const int col = p * 512 + h * 128 + 2 * c.lane;
            float y0 = 0.f, y1 = 0.f;
#pragma unroll
            for (int j = 0; j < 5; ++j) { const int rr = r + j - 2;
                if (rr >= s0 && rr < s1) { const unsigned u = *(const unsigned*)(PROJ + (size_t)rr * NP + col); const f32x2 w = *(const f32x2*)(cw + j * 1536 + col);
                    y0 += w.x * bf2f((bf16)(u & 0xffffu)); y1 += w.y * bf2f((bf16)(u >> 16)); } }
            y0 = silu_f(y0); y1 = silu_f(y1);
            if (p < 2) { const float ss = wave_sum(y0 * y0 + y1 * y1, c.lane); float sc = rsqrtf(ss + EPS); if (p == 0) sc *= 0.08838834764831845f; y0 *= sc; y1 *= sc; }
            *(unsigned*)(QKVN + (size_t)r * 1536 + col) = pk2(y0, y1);
        }
        if (c.lane < 2) { const int dir = c.lane, idx = dir * 4 + h;
            const float al = LOGIT[(size_t)r * 16 + idx], bl = LOGIT[(size_t)r * 16 + 8 + idx];
            GBG[(size_t)r * 8 + idx] = -__expf(a_log[idx]) * softplus_f(al + dt_bias[idx]);
            GBB[(size_t)r * 8 + idx] = sigmoid_f(bl); }
    }
}
DI void phase_hyprep_naive(const Ctx& c, int l) {
    const bf16* PROJ = (const bf16*)(c.ws + WS_R1);
    const float* hw = c.in[14] + (size_t)l * 3 * 1536;
    bf16* X0C = (bf16*)(c.ws + WS_X0C); bf16* ZZT = (bf16*)(c.ws + WS_ZZT);
    for (size_t i = (size_t)c.bid * NTHR + c.tid; i < (size_t)NTOK * 512; i += (size_t)c.G * NTHR) {
        const int r = (int)(i >> 9), ch = (int)(i & 511); int s0, s1; seg_of_row(r, s0, s1);
        float y[3] = {0.f, 0.f, 0.f};
#pragma unroll
        for (int j = 0; j < 3; ++j) { const int rr = r + j - 1;
            if (rr >= s0 && rr < s1) {
#pragma unroll
                for (int p = 0; p < 3; ++p) y[p] += hw[j * 1536 + p * 512 + ch] * bf2f(PROJ[(size_t)rr * NP + 2048 + p * 512 + ch]); } }
        X0C[(size_t)r * 512 + ch] = f2bf(y[0]);
        ZZT[(size_t)ch * NTOK + r] = f2bf(y[1] * y[2]);
    }
}

DI void phase_scan_naive(const Ctx& c, int l) {
    const bf16* QKVN = (const bf16*)(c.ws + WS_QKVN);
    const float* GBG = (const float*)(c.ws + WS_GBG); const float* GBB = (const float*)(c.ws + WS_GBB);
    bf16* OF = (bf16*)(c.ws + WS_OF); bf16* OB = (bf16*)(c.ws + WS_OB);
    const float* state_in = c.in[2]; float* state_out = c.out + (size_t)NTOK * D;
    constexpr int TB = 32;
    LAS float* qs = (LAS float*)c.lds;
    LAS float* ks = qs + TB * 256;
    LAS float* vs = ks + TB * 256;
    LAS float* gs = vs + TB * 256;
    LAS float* bs = gs + TB * 2;
    const int half = c.lane >> 5, dv = (c.wave & 3) * 32 + (c.lane & 31), hl = c.wave >> 2;
    for (int task = c.bid; task < 80; task += c.G) {
        const int s = task >> 2, dir = (task >> 1) & 1, hp = task & 1, h = hp * 2 + hl;
        const bool isctx = s < 16; const int L = isctx ? 256 : 4096, row0 = isctx ? s * 256 : NCTX + (s - 16) * 4096;
        float S[64];
        if (isctx) {
#pragma unroll
            for (int k = 0; k < 64; ++k) S[k] = 0.f;
        } else { const float* sp = state_in + ((((size_t)(s - 16) * 4 + l) * 2 + dir) * 4 + h) * 16384 + (size_t)(half * 64) * 128 + dv;
#pragma unroll
            for (int k = 0; k < 64; ++k) S[k] = sp[(size_t)k * 128]; }
        bf16* O = dir == 0 ? OF : OB;
        for (int i0 = 0; i0 < L; i0 += TB) {
            __syncthreads();
            { const int cc = c.tid & 255, jj = c.tid >> 8;
#pragma unroll 4
              for (int j = jj; j < TB; j += 2) { const int i = i0 + j, t = dir == 0 ? i : L - 1 - i, r = row0 + t; const bf16* src = QKVN + (size_t)r * 1536 + hp * 256 + cc;
                qs[j * 256 + cc] = bf2f(src[0]); ks[j * 256 + cc] = bf2f(src[512]); vs[j * 256 + cc] = bf2f(src[1024]); } }
            if (c.tid < TB * 2) { const int j = c.tid >> 1, hh = c.tid & 1, i = i0 + j, t = dir == 0 ? i : L - 1 - i, r = row0 + t;
                gs[c.tid] = __expf(GBG[(size_t)r * 8 + dir * 4 + hp * 2 + hh]); bs[c.tid] = GBB[(size_t)r * 8 + dir * 4 + hp * 2 + hh]; }
            __syncthreads();
            for (int j = 0; j < TB; ++j) {
                const float a = gs[j * 2 + hl], be = bs[j * 2 + hl];
                const LAS f32x4* kp = (const LAS f32x4*)(ks + j * 256 + hl * 128 + half * 64); const LAS f32x4* qp = (const LAS f32x4*)(qs + j * 256 + hl * 128 + half * 64);
                float rr = 0.f;
#pragma unroll
                for (int k4 = 0; k4 < 16; ++k4) { const f32x4 kk = kp[k4]; rr += kk.x * S[4 * k4] + kk.y * S[4 * k4 + 1] + kk.z * S[4 * k4 + 2] + kk.w * S[4 * k4 + 3]; }
                rr += shx(rr, 32, c.lane);
                const float delta = be * (vs[j * 256 + hl * 128 + dv] - a * rr);
                float o = 0.f;
#pragma unroll
                for (int k4 = 0; k4 < 16; ++k4) { const f32x4 kk = kp[k4], qq = qp[k4];
                    S[4 * k4] = a * S[4 * k4] + kk.x * delta; S[4 * k4 + 1] = a * S[4 * k4 + 1] + kk.y * delta; S[4 * k4 + 2] = a * S[4 * k4 + 2] + kk.z * delta; S[4 * k4 + 3] = a * S[4 * k4 + 3] + kk.w * delta;
                    o += qq.x * S[4 * k4] + qq.y * S[4 * k4 + 1] + qq.z * S[4 * k4 + 2] + qq.w * S[4 * k4 + 3]; }
                o += shx(o, 32, c.lane);
                const int i = i0 + j, t = dir == 0 ? i : L - 1 - i, r = row0 + t;
                if (half == 0) O[(size_t)r * 512 + h * 128 + dv] = f2bf(o);
            }
        }
        if (isctx) { float* sp = state_out + ((((size_t)s * 4 + l) * 2 + dir) * 4 + h) * 16384 + (size_t)(half * 64) * 128 + dv;
#pragma unroll
            for (int k = 0; k < 64; ++k) sp[(size_t)k * 128] = S[k]; }
    }
}

constexpr int HY_R4L = 0, HY_CSL = 8192 * 2 + 64, HY_R4C = 4 * HY_CSL, HY_CSC = 512 * 2 + 64, HY_ZL = HY_R4C + 4 * HY_CSC, HY_ZLS = (4096 + 1024) * 2 + 80 * 16 + 64  , HY_ZC = HY_ZL + 4 * HY_ZLS, HY_ZCS = (256 + 256) * 2 + 32, HY_END = HY_ZC + 16 * HY_ZCS;
static_assert(HY_END <= 146944 && HY_ZLS % 256 == 64 && HY_R4C % 16 == 0 && HY_ZL % 16 == 0 && HY_ZC % 16 == 0 && HY_ZLS % 16 == 0 && HY_ZCS % 16 == 0, "hyena LDS map");

template <int L, int NB>
DI void toep_wave(LAS const unsigned char* R4, const int cstride, LAS const unsigned char* Z, const int zstride, const int w, const int lane, bf16* outb) {
    constexpr int BPW = 32 / NB, ZPAD = (BPW == 8) ? 512 : 128;
    const int n = lane & 31, hh = lane >> 5;
    const int d_lo = 64 * BPW * w - (L - 16), d_hi = 64 * (BPW * w + BPW - 1), nst = (d_hi - d_lo) / 16 + 1;
    const int rb = n % NB, rblk = BPW * w + n / NB;
    constexpr bool PADZ = (L == 4096);
    const int E0 = ZPAD + 64 * rblk - d_lo + 8 * hh;
    const int abase = rb * zstride + E0 * 2 + (PADZ ? 16 * (E0 >> 6) : 0);
#define HY_AOFF(m) (-(32 * (m) + (PADZ ? 16 * ((m) >> 2) : 0)))
    const int Q0 = L - n - d_lo + 8 * hh, sh = Q0 & 3;
    int baddr = sh * cstride + (Q0 - sh) * 2;
    f32x16 acc0, acc1;
#pragma unroll
    for (int i = 0; i < 16; ++i) { acc0[i] = 0.f; acc1[i] = 0.f; }
#define HY_LDB(dst, off) do { const s16x4v lo_ = *(const volatile LAS s16x4v*)(R4 + baddr + (off)); const s16x4v hi_ = *(const volatile LAS s16x4v*)(R4 + baddr + (off) + 8);     dst = __builtin_shufflevector(lo_, hi_, 0, 1, 2, 3, 4, 5, 6, 7); } while (0)
    bf16x8v F[6], A[3];
    HY_LDB(F[0], 0); HY_LDB(F[1], -32); HY_LDB(F[2], -64); HY_LDB(F[3], -96); HY_LDB(F[4], -128);
    A[0] = *(const LAS bf16x8v*)(Z + abase + HY_AOFF(0)); A[1] = *(const LAS bf16x8v*)(Z + abase + HY_AOFF(1));
    baddr -= 160;
#define HY_STEP(j) do { \
        A[((j) + 2) % 3] = *(const LAS bf16x8v*)(Z + abase + HY_AOFF(k + (j) + 2));        \
        if (k + (j) + 5 <= nst + 1) HY_LDB(F[((j) + 5) % 6], 0); \
        baddr -= 32; \
        __builtin_amdgcn_sched_barrier(0); \
        acc0 = __builtin_amdgcn_mfma_f32_32x32x16_bf16(A[(j) % 3], F[(j) % 6], acc0, 0, 0, 0); \
        acc1 = __builtin_amdgcn_mfma_f32_32x32x16_bf16(A[(j) % 3], F[((j) + 2) % 6], acc1, 0, 0, 0); \
        __builtin_amdgcn_sched_barrier(0); } while (0)
    int k = 0;
    for (; k + 6 <= nst; k += 6) { HY_STEP(0); HY_STEP(1); HY_STEP(2); HY_STEP(3); HY_STEP(4); HY_STEP(5); }
    if (k + 0 < nst) HY_STEP(0);
    if (k + 1 < nst) HY_STEP(1);
    if (k + 2 < nst) HY_STEP(2);
    if (k + 3 < nst) HY_STEP(3);
    if (k + 4 < nst) HY_STEP(4);
#undef HY_STEP
#undef HY_AOFF
#undef HY_LDB
#pragma unroll
    for (int i = 0; i < 16; ++i) { const int ri = (i & 3) + 8 * (i >> 2) + 4 * hh, ob = ri % NB, oblk = BPW * w + ri / NB;
        bf16* op = outb + (size_t)ob * L + 64 * oblk + n;
        op[0] = f2bf(acc0[i]); op[32] = f2bf(acc1[i]); }
}

DI void hyena_channel(const Ctx& c, int l, int ch) {
    bf16* ZZT = (bf16*)(c.ws + WS_ZZT);
    const bf16* RL = (const bf16*)(c.ws + WS_FILT + (l & 1) * FILT_SLOT); const bf16* RC = RL + 8 * MiB / 2;
    LAS unsigned char* lds = c.lds;
    {
        { u32x4 rv[2]; u32x2 rn[2];
#pragma unroll
          for (int i = 0; i < 2; ++i) { const int p0 = (c.tid + NTHR * i) * 8; rv[i] = *(const u32x4*)(RL + (size_t)ch * 8192 + p0);
              rn[i] = (u32x2){0u, 0u}; if (p0 + 8 < 8192) rn[i] = *(const u32x2*)(RL + (size_t)ch * 8192 + p0 + 8); }
#pragma unroll
          for (int i = 0; i < 2; ++i) { const int p0 = (c.tid + NTHR * i) * 8;
              const unsigned w0 = rv[i].x, w1 = rv[i].y, w2 = rv[i].z, w3 = rv[i].w, w4 = rn[i].x, w5 = rn[i].y;
#define HY_AB(hi, lo) __builtin_amdgcn_alignbit((hi), (lo), 16u)
              *(LAS u32x4*)(lds + HY_R4L + 0 * HY_CSL + p0 * 2) = rv[i];
              *(LAS u32x4*)(lds + HY_R4L + 1 * HY_CSL + p0 * 2) = (u32x4){HY_AB(w1, w0), HY_AB(w2, w1), HY_AB(w3, w2), HY_AB(w4, w3)};
              *(LAS u32x4*)(lds + HY_R4L + 2 * HY_CSL + p0 * 2) = (u32x4){w1, w2, w3, w4};
              *(LAS u32x4*)(lds + HY_R4L + 3 * HY_CSL + p0 * 2) = (u32x4){HY_AB(w2, w1), HY_AB(w3, w2), HY_AB(w4, w3), HY_AB(w5, w4)};
#undef HY_AB
          } }
        { const int q = c.tid; const bf16 v = RC[(size_t)ch * 512 + q];
#pragma unroll
            for (int sft = 0; sft < 4; ++sft) if (q - sft >= 0) *(LAS bf16*)(lds + HY_R4C + sft * HY_CSC + (q - sft) * 2) = v; }
        const u32x4 zero4 = {0u, 0u, 0u, 0u};
        for (int i = c.tid; i < 2048; i += NTHR) { const int b = i >> 9, e = (i & 511) * 8;
            const u32x4 v = *(const u32x4*)(ZZT + (size_t)ch * NTOK + NCTX + b * 4096 + e);
            *(LAS u32x4*)(lds + HY_ZL + b * HY_ZLS + (512 + e) * 2 + 16 * ((512 + e) >> 6)) = v; }
        { const int b = c.tid >> 7, side = (c.tid >> 6) & 1, e = (c.tid & 63) * 8; const int el = side ? 512 + 4096 + e : e;
            *(LAS u32x4*)(lds + HY_ZL + b * HY_ZLS + el * 2 + 16 * (el >> 6)) = zero4; }
        { const int b = c.tid >> 5, e = (c.tid & 31) * 8;
            const u32x4 v = *(const u32x4*)(ZZT + (size_t)ch * NTOK + b * 256 + e);
            *(LAS u32x4*)(lds + HY_ZC + b * HY_ZCS + (128 + e) * 2) = v;
            const int side = (c.tid >> 4) & 1, e2 = (c.tid & 15) * 8;
            *(LAS u32x4*)(lds + HY_ZC + b * HY_ZCS + (side ? 128 + 256 + e2 : e2) * 2) = zero4; }
        __syncthreads();
        toep_wave<4096, 4>(lds + HY_R4L, HY_CSL, lds + HY_ZL, HY_ZLS, c.wave, c.lane, ZZT + (size_t)ch * NTOK + NCTX);
        if (c.wave < 2) toep_wave<256, 16>(lds + HY_R4C, HY_CSC, lds + HY_ZC, HY_ZCS, c.wave, c.lane, ZZT + (size_t)ch * NTOK);
    }
}
DI void hyprep_tile(const Ctx& c, int l, int t);
DI void scan_chain(const Ctx& c, int l, int seq, int h, int dir, int half);
DI void phase_queue(const Ctx& c, int l) {
    LAS unsigned char* lds = c.lds;
    unsigned* qhead = (unsigned*)(c.ws + WS_CTL) + 2048 + 64 * l;
    volatile LAS unsigned* qslot = (volatile LAS unsigned*)(lds + 146944 + 64);
    const bool nx = l + 1 < DEPTH;
    constexpr int N_LAT = 64, N_CTX = 256;
    constexpr int N_HP = (NTOK / 64) * 8;
    const int n_f = nx ? 68 : 0, n_wr = WC_BLK_REST, n_wi = nx ? WC_BLK_IN : 0;
    const int n_long = N_LAT + n_f + N_CTX, n_tail = 512 + n_wi;
    unsigned* hpdone = (unsigned*)(c.ws + WS_CTL) + 3072 + 64 * l;
    int my_hp = 0; bool gated = false, published = false;
    unsigned nxt = 0u; int qk = 0;
    if (c.wave == 0 && fresh_lane() == 0) nxt = __hip_atomic_fetch_add(qhead, 1u, __ATOMIC_RELAXED, __HIP_MEMORY_SCOPE_AGENT);
    for (;;) {
        if (c.wave == 0 && fresh_lane() == 0) qslot[qk] = nxt;
        __syncthreads();
        int it = (int)qslot[qk]; qk ^= 1;
        const bool long_item = it < n_long;
        if (!long_item && c.wave == 0 && fresh_lane() == 0) nxt = __hip_atomic_fetch_add(qhead, 1u, __ATOMIC_RELAXED, __HIP_MEMORY_SCOPE_AGENT);
        Ctx cq = c; { const int lq = fresh_lane(); cq.lane = lq; cq.tid = c.wave * 64 + lq; }
        if (long_item) {
            if (it >= N_LAT && it < N_LAT + n_f) filters_task(cq, l + 1, it - N_LAT);
            else { int ch, half = it & 1, seq;
                if (it < N_LAT) { ch = it >> 1; seq = 16 + (ch >> 3); } else { ch = (it - N_LAT - n_f) >> 1; seq = ch >> 3; }
                scan_chain(cq, l, seq, (ch >> 1) & 3, ch & 1, half); }
            if (c.wave == 0 && fresh_lane() == 0) nxt = __hip_atomic_fetch_add(qhead, 1u, __ATOMIC_RELAXED, __HIP_MEMORY_SCOPE_AGENT);
            continue; }
        it -= n_long;
        if (it < N_HP / 4) { hyprep_tile(cq, l, it); my_hp += 4; continue; }
        it -= N_HP / 4;
        if (!published) {
            asm volatile("s_waitcnt vmcnt(0)" ::: "memory");
            __syncthreads();
            if (cq.tid == 0 && my_hp > 0) { __builtin_amdgcn_fence(__ATOMIC_RELEASE, "agent"); asm volatile("s_waitcnt vmcnt(0)" ::: "memory");
                (void)__hip_atomic_fetch_add(hpdone, (unsigned)my_hp, __ATOMIC_RELAXED, __HIP_MEMORY_SCOPE_AGENT); }
            published = true;
        }
        if (it < n_wr) { wconv_wave_item(cq, l, 1, it * 8 + c.wave); continue; }
        it -= n_wr;
        if (!gated) {
            if (cq.tid == 0) {
                unsigned spins = 0;
                while (__hip_atomic_load(hpdone, __ATOMIC_RELAXED, __HIP_MEMORY_SCOPE_AGENT) < (unsigned)N_HP) { __builtin_amdgcn_s_sleep(8); if (++spins > (1u << 24)) break; }
                __builtin_amdgcn_fence(__ATOMIC_ACQUIRE, "agent"); asm volatile("s_waitcnt vmcnt(0)" ::: "memory");
            }
            __syncthreads();
            gated = true;
        }
        if (it >= n_tail) break;
        if (it < 512) { hyena_channel(cq, l, it); continue; } it -= 512;
        wconv_wave_item(cq, l + 1, 0, it * 8 + c.wave);
    }
}

DI void phase_hyena_out(const Ctx& c) {
    const bf16* YT = (const bf16*)(c.ws + WS_ZZT); const bf16* X0C = (const bf16*)(c.ws + WS_X0C); bf16* PROJ = (bf16*)(c.ws + WS_R1);
    LAS bf16* tile = (LAS bf16*)c.lds;
    const int chl = c.tid >> 3, e = (c.tid & 7) * 8;
    const int rl = c.tid >> 3, cg = (c.tid & 7) * 8;
    constexpr int NT = (NTOK / 64) * 8;
    u32x4 v = {0u, 0u, 0u, 0u}, xn = {0u, 0u, 0u, 0u};
    if (c.bid < NT) { const int r0 = (c.bid >> 3) * 64, ch0 = (c.bid & 7) * 64;
        v = *(const u32x4*)(YT + (size_t)(ch0 + chl) * NTOK + r0 + e); xn = *(const u32x4*)(X0C + (size_t)(r0 + rl) * 512 + ch0 + cg); }
    for (int t = c.bid; t < NT; t += c.G) {
        const int rt = t >> 3, ct = t & 7, r0 = rt * 64, ch0 = ct * 64;
        __syncthreads();
        { LAS unsigned* tp = (LAS unsigned*)(tile + chl * 66 + e); tp[0] = v.x; tp[1] = v.y; tp[2] = v.z; tp[3] = v.w; }
        const u32x4 xv = xn;
        if (t + c.G < NT) { const int t2 = t + c.G, r2 = (t2 >> 3) * 64, c2 = (t2 & 7) * 64;
            v = *(const u32x4*)(YT + (size_t)(c2 + chl) * NTOK + r2 + e); xn = *(const u32x4*)(X0C + (size_t)(r2 + rl) * 512 + c2 + cg); }
        __syncthreads();
        { const unsigned xw[4] = {xv.x, xv.y, xv.z, xv.w}; unsigned ow[4];
#pragma unroll
            for (int p = 0; p < 4; ++p) { const float y0 = bf2f(tile[(cg + 2 * p) * 66 + rl]), y1 = bf2f(tile[(cg + 2 * p + 1) * 66 + rl]);
                ow[p] = pk2(bf2f((bf16)(xw[p] & 0xffffu)) * y0, bf2f((bf16)(xw[p] >> 16)) * y1); }
            u32x4 o; o.x = ow[0]; o.y = ow[1]; o.z = ow[2]; o.w = ow[3];
            *(u32x4*)(PROJ + (size_t)(r0 + rl) * NP + 3072 + ch0 + cg) = o; }
    }
}

DI void phase_logit(const Ctx& c, int l, int wg, int nwg) {
    const float* MOD = (const float*)(c.ws + WS_MOD); const float* ng = c.in[7] + l * 1024; const float* RSS = (const float*)(c.ws + WS_RSSP1);
    float* LOGIT = (float*)(c.ws + WS_LOGIT);
    const float* w16 = c.in[9] + (size_t)l * 1024 * IN_COLS + 2048;
    LAS float* W = (LAS float*)c.lds;
    __syncthreads();
    for (int i = c.tid; i < 4096; i += NTHR) { const int k = i >> 2, qd = i & 3; const f32x4 v = *(const f32x4*)(w16 + (size_t)k * IN_COLS + qd * 4);
        *(LAS f32x4*)(W + (((k >> 8) * 4 + (k & 3)) * 64 + ((k >> 2) & 63)) * 20 + qd * 4) = v; }
    __syncthreads();
    const int lane = c.lane;
    for (int r = wg * 8 + c.wave; r < NTOK; r += nwg * 8) {
        const int mb = mod_of_row(r); const float* mrow = MOD + (size_t)(l * 5 + mb) * 6144;
        const float rstd = rsqrtf(rss_read(RSS, r) * (1.f / D) + EPS);
        float lgv[16];
#pragma unroll
        for (int q2 = 0; q2 < 16; ++q2) lgv[q2] = 0.f;
#pragma unroll
        for (int j = 0; j < 4; ++j) { const int k0 = (lane + 64 * j) * 4;
            const f32x4 xv = *(const f32x4*)(c.X + (size_t)r * D + k0), g4 = *(const f32x4*)(ng + k0), s4 = *(const f32x4*)(mrow + 1024 + k0), sh = *(const f32x4*)(mrow + k0);
            const f32x4 hn = xv * (g4 * (s4 + 1.0f)) * rstd + sh;
#pragma unroll
            for (int e = 0; e < 4; ++e) { const LAS f32x4* wp = (const LAS f32x4*)(W + ((j * 4 + e) * 64 + lane) * 20); const float hv = hn[e];
#pragma unroll
                for (int q2 = 0; q2 < 4; ++q2) { const f32x4 w4 = wp[q2]; lgv[4 * q2] += hv * w4.x; lgv[4 * q2 + 1] += hv * w4.y; lgv[4 * q2 + 2] += hv * w4.z; lgv[4 * q2 + 3] += hv * w4.w; }
                if (e & 1) asm volatile("" ::: "memory"); } }
        float a8[8], a4[4], a2[2];
        { const bool hi = lane & 1;
#pragma unroll
          for (int i = 0; i < 8; ++i) { const float keep = hi ? lgv[8 + i] : lgv[i], send = hi ? lgv[i] : lgv[8 + i]; a8[i] = keep + shx(send, 1, lane); } }
        { const bool hi = lane & 2;
#pragma unroll
          for (int i = 0; i < 4; ++i) { const float keep = hi ? a8[4 + i] : a8[i], send = hi ? a8[i] : a8[4 + i]; a4[i] = keep + shx(send, 2, lane); } }
        { const bool hi = lane & 4;
#pragma unroll
          for (int i = 0; i < 2; ++i) { const float keep = hi ? a4[2 + i] : a4[i], send = hi ? a4[i] : a4[2 + i]; a2[i] = keep + shx(send, 4, lane); } }
        float a1; { const bool hi = lane & 8; const float keep = hi ? a2[1] : a2[0], send = hi ? a2[0] : a2[1]; a1 = keep + shx(send, 8, lane); }
        a1 += shx(a1, 16, lane); a1 += shx(a1, 32, lane);
        if (lane < 16) { const int jj = 8 * (lane & 1) + 4 * ((lane >> 1) & 1) + 2 * ((lane >> 2) & 1) + ((lane >> 3) & 1); LOGIT[(size_t)r * 16 + jj] = a1; }
    }
    __syncthreads();
}

constexpr size_t WS_TM = WS_TMQK, WS_QKM = WS_TMQK + 20 * MiB;
constexpr int PF_QS = 0, PF_KS = 17408, PF_RAW = 34816, PF_CO = PF_RAW + 52224, PF_A = PF_CO + 3 * 1024, PF_ASZ = 2112 * 4;
static_assert(PF_A + 6 * PF_ASZ <= 146944, "prep LDS");
DI int prow(int r) { const int nn = r - 1, G = nn >> 2, rem = nn & 3; return r <= 0 ? 0 : (2 * G * (G + 1) + rem * (G + 1)); }
DI float wave_sum_dpp(float v) {
    v += __builtin_bit_cast(float, __builtin_amdgcn_update_dpp(0, __builtin_bit_cast(int, v), 0xB1, 0xF, 0xF, true));
    v += __builtin_bit_cast(float, __builtin_amdgcn_update_dpp(0, __builtin_bit_cast(int, v), 0x4E, 0xF, 0xF, true));
    v += __builtin_bit_cast(float, __builtin_amdgcn_update_dpp(0, __builtin_bit_cast(int, v), 0x141, 0xF, 0xF, true));
    v += __builtin_bit_cast(float, __builtin_amdgcn_update_dpp(0, __builtin_bit_cast(int, v), 0x140, 0xF, 0xF, true));
    const int iv = __builtin_bit_cast(int, v);
    return (__builtin_bit_cast(float, __builtin_amdgcn_readlane(iv, 0)) + __builtin_bit_cast(float, __builtin_amdgcn_readlane(iv, 16))) + (__builtin_bit_cast(float, __builtin_amdgcn_readlane(iv, 32)) + __builtin_bit_cast(float, __builtin_amdgcn_readlane(iv, 48)));
}
struct PrepRegs { u32x4 v[7]; float lg[4]; };
DI void prep_load(const Ctx& c, int task, int lane, PrepRegs& pr) {
    const bf16* PROJ = (const bf16*)(c.ws + WS_R1); const float* LOGIT = (const float*)(c.ws + WS_LOGIT);
    const int tidl = c.wave * 64 + lane, chunk = task >> 2, h = task & 3, r0 = chunk * 64; int s0, s1; seg_of_row(r0, s0, s1);
#pragma unroll
    for (int it = 0; it < 7; ++it) { const int u = it * NTHR + tidl;
        if (u < 68 * 48) { const int rr = u / 48, cu = u % 48, p = cu >> 4, c16 = cu & 15; const int r = r0 - 2 + rr; const bool ok = r >= s0 && r < s1;
            pr.v[it] = *(const u32x4*)(PROJ + (size_t)(ok ? r : r0) * NP + p * 512 + h * 128 + c16 * 8);
            if (!ok) pr.v[it] = (u32x4){0u, 0u, 0u, 0u}; } }
    if (c.wave == 0) { const int r = r0 + lane;
#pragma unroll
        for (int q = 0; q < 4; ++q) pr.lg[q] = LOGIT[(size_t)r * 16 + 4 * q + h]; }
}
DI void prep_task(const Ctx& c, int l, int task, int slot, int lane, PrepRegs& pr, int next_task) {
    bf16* QKVN = (bf16*)(c.ws + WS_QKVN);
    const float* cw = c.in[10] + (size_t)l * 5 * 1536;
    const float* a_log = c.in[11] + l * 8; const float* dt_bias = c.in[12] + l * 8;
    float* GBG = (float*)(c.ws + WS_GBG); float* GBB = (float*)(c.ws + WS_GBB);
    bf16* QKM = (bf16*)(c.ws + WS_QKM);
    LAS unsigned char* lds = c.lds;
    LAS float* CO = (LAS float*)(lds + PF_CO + slot * 1024);
    LAS float* Am = (LAS float*)(lds + PF_A + slot * 2 * PF_ASZ);
    const int w = c.wave, tidl = w * 64 + lane;
    const int chunk = task >> 2, h = task & 3, r0 = chunk * 64;
    __syncthreads();
#pragma unroll
    for (int it = 0; it < 7; ++it) { const int u = it * NTHR + tidl;
        if (u < 68 * 48) { const int rr = u / 48, cu = u % 48; *(LAS u32x4*)(lds + PF_RAW + rr * 768 + cu * 16) = pr.v[it]; } }
    const float lg0 = pr.lg[0], lg1 = pr.lg[1], lg2 = pr.lg[2], lg3 = pr.lg[3];
    f32x2 cwv[3][5];
#pragma unroll
    for (int p = 0; p < 3; ++p)
#pragma unroll
        for (int j = 0; j < 5; ++j) cwv[p][j] = *(const f32x2*)(cw + j * 1536 + p * 512 + h * 128 + 2 * lane);
    asm volatile("" ::: "memory");
    if (next_task >= 0) prep_load(c, next_task, lane, pr);
    if (w == 0) {
        const int r = r0 + lane;
        const float g0 = -__expf(a_log[h]) * softplus_f(lg0 + dt_bias[h]);
        const float g1 = -__expf(a_log[4 + h]) * softplus_f(lg1 + dt_bias[4 + h]);
        const float b0 = sigmoid_f(lg2), b1 = sigmoid_f(lg3);
        float x0 = g0, x1 = g1;
#pragma unroll
        for (int o = 1; o < 64; o <<= 1) { const float y0 = shi(x0, (lane - o) & 63), y1 = shi(x1, (lane + o) & 63); if (lane >= o) x0 += y0; if (lane + o < 64) x1 += y1; }
        CO[lane] = x0; CO[64 + lane] = x1; CO[128 + lane] = b0; CO[192 + lane] = b1;
        GBG[(size_t)r * 8 + h] = x0; GBG[(size_t)r * 8 + 4 + h] = x1; GBB[(size_t)r * 8 + h] = b0; GBB[(size_t)r * 8 + 4 + h] = b1;
    }
    __syncthreads();
#pragma unroll
    for (int p = 0; p < 3; ++p) {
        const int col = p * 512 + h * 128 + 2 * lane;
        float xl[12], xh[12];
#pragma unroll
        for (int i = 0; i < 12; ++i) { const unsigned u = *(const LAS unsigned*)(lds + PF_RAW + (w * 8 + i) * 768 + p * 256 + lane * 4); xl[i] = bf2f((bf16)(u & 0xffffu)); xh[i] = bf2f((bf16)(u >> 16)); }
        float y0[8], y1[8];
#pragma unroll
        for (int t = 0; t < 8; ++t) { float a0 = 0.f, a1 = 0.f;
#pragma unroll
            for (int j = 0; j < 5; ++j) { a0 += cwv[p][j].x * xl[t + j]; a1 += cwv[p][j].y * xh[t + j]; }
            y0[t] = silu_f(a0); y1[t] = silu_f(a1); }
        if (p < 2) {
            float ss[8];
#pragma unroll
            for (int t = 0; t < 8; ++t) ss[t] = wave_sum_dpp(y0[t] * y0[t] + y1[t] * y1[t]);
#pragma unroll
            for (int t = 0; t < 8; ++t) { float sc = rsqrtf(ss[t] + EPS); if (p == 0) sc *= 0.08838834764831845f; y0[t] *= sc; y1[t] *= sc; } }
#pragma unroll
        for (int t = 0; t < 8; ++t) { const int tok = w * 8 + t; const unsigned pk = pk2(y0[t], y1[t]);
            *(unsigned*)(QKVN + (size_t)(r0 + tok) * 1536 + col) = pk;
            if (p == 0) *(LAS unsigned*)(lds + PF_QS + tok * 272 + lane * 4) = pk;
            if (p == 1) *(LAS unsigned*)(lds + PF_KS + tok * 272 + lane * 4) = pk; }
    }
    __syncthreads();
    {
        const int mat = w >> 2, ti = (w >> 1) & 1, tj = w & 1, n = lane & 31, hh = lane >> 5;
        f32x16 acc;
#pragma unroll
        for (int i = 0; i < 16; ++i) acc[i] = 0.f;
        const LAS unsigned char* ap = lds + (mat ? PF_QS : PF_KS) + (32 * ti + n) * 272 + hh * 16;
        const LAS unsigned char* bp = lds + PF_KS + (32 * tj + n) * 272 + hh * 16;
#pragma unroll
        for (int ks = 0; ks < 8; ++ks) { const bf16x8v a = *(const LAS bf16x8v*)(ap + ks * 32), b = *(const LAS bf16x8v*)(bp + ks * 32);
            acc = __builtin_amdgcn_mfma_f32_32x32x16_bf16(a, b, acc, 0, 0, 0); }
        const int col = 32 * tj + n; const float gc0c = CO[col], gc1c = CO[64 + col];
        const size_t mb0 = ((size_t)(chunk * 4 + h) * 2 + 0) * 4096, mb1 = mb0 + 4096;
#pragma unroll
        for (int i = 0; i < 16; ++i) { const int row = 32 * ti + (i & 3) + 8 * (i >> 2) + 4 * hh; const float v = acc[i];
            const float d0 = __expf(CO[row] - gc0c), d1 = __expf(CO[64 + row] - gc1c);
            if (mat == 0) { if (col < row) Am[4 * prow(row) + col] = CO[128 + row] * v * d0;
                            if (col > row) Am[2112 + 4 * prow(63 - row) + (63 - col)] = CO[192 + row] * v * d1; }
            else { QKM[mb0 + row * 64 + col] = f2bf(col <= row ? v * d0 : 0.f); QKM[mb1 + (63 - row) * 64 + (63 - col)] = f2bf(col >= row ? v * d1 : 0.f); } }
    }
}
DI void prep_invert(const Ctx& c, int task, int slot, int dir, int lane) {
    bf16* TM = (bf16*)(c.ws + WS_TM);
    const LAS float* Ad = (const LAS float*)(c.lds + PF_A + (slot * 2 + dir) * PF_ASZ);
    const int chunk = task >> 2, h = task & 3;
    bf16* Tg = TM + ((size_t)(chunk * 4 + h) * 2 + dir) * 4096;
    float t[64];
    t[0] = lane == 0 ? 1.f : 0.f; Tg[lane] = f2bf(t[0]);
#pragma unroll
    for (int i = 1; i < 64; ++i) { float a0 = lane == i ? 1.f : 0.f, a1 = 0.f, a2 = 0.f, a3 = 0.f;
        const int ro = 4 * (2 * ((i - 1) >> 2) * (((i - 1) >> 2) + 1) + ((i - 1) & 3) * (((i - 1) >> 2) + 1));
#pragma unroll
        for (int j4 = 0; j4 * 4 < i; ++j4) { const f32x4 a4 = *(const LAS f32x4*)(Ad + ro + 4 * j4);
            a0 -= a4.x * t[4 * j4];
            if (4 * j4 + 1 < i) a1 -= a4.y * t[4 * j4 + 1];
            if (4 * j4 + 2 < i) a2 -= a4.z * t[4 * j4 + 2];
            if (4 * j4 + 3 < i) a3 -= a4.w * t[4 * j4 + 3]; }
        const float a = (a0 + a1) + (a2 + a3);
        t[i] = a; Tg[i * 64 + lane] = f2bf(a); asm volatile("" ::: "memory"); }
}
DI void phase_prep_fast(const Ctx& c, int l) {
    PrepRegs pr;
    prep_load(c, c.bid, fresh_lane(), pr);
    for (int b0 = 0; b0 < 5; b0 += 3) {
        const int nb = (5 - b0) < 3 ? (5 - b0) : 3;
        for (int s = 0; s < nb; ++s) { const int task = c.bid + 256 * (b0 + s); if (task < (NTOK / 64) * 4) prep_task(c, l, task, s, fresh_lane(), pr, (b0 + s + 1 < 5) ? task + 256 : -1); }
        __syncthreads();
        if (c.wave < 2 * nb) { const int s = c.wave >> 1, task = c.bid + 256 * (b0 + s); if (task < (NTOK / 64) * 4) prep_invert(c, task, s, c.wave & 1, fresh_lane()); }
        __syncthreads();
    }
}

DI void hyprep_tile(const Ctx& c, int l, int item) {
    const bf16* PROJ = (const bf16*)(c.ws + WS_R1);
    const float* hw = c.in[14] + (size_t)l * 3 * 1536;
    bf16* X0C = (bf16*)(c.ws + WS_X0C); bf16* ZZT = (bf16*)(c.ws + WS_ZZT);
    LAS bf16* sin_ = (LAS bf16*)c.lds;
    LAS bf16* zt = (LAS bf16*)(c.lds + 3 * 66 * 64 * 2);
    const int ct = item & 7, rt0 = (item >> 3) * 4, ch0 = ct * 64;
    u32x4 v[4];
#define HP_LOAD(rt_) do { const int r0_ = (rt_) * 64; int s0_, s1_; seg_of_row(r0_, s0_, s1_); \
        _Pragma("unroll") for (int it = 0; it < 4; ++it) { const int i = it * NTHR + c.tid; \
            if (i < 3 * 66 * 8) { const int p = i / (66 * 8), rem = i % (66 * 8), rr = rem >> 3, c8 = (rem & 7) * 8; const int r = r0_ - 1 + rr; const bool ok = r >= s0_ && r < s1_; \
                v[it] = *(const u32x4*)(PROJ + (size_t)(ok ? r : r0_) * NP + 2048 + p * 512 + ch0 + c8); \
                if (!ok) v[it] = (u32x4){0u, 0u, 0u, 0u}; } } } while (0)
    HP_LOAD(rt0);
    const int rl = c.tid >> 3, cg = (c.tid & 7) * 8;
    f32x4 wA[3][3], wB[3][3];
#pragma unroll
    for (int p = 0; p < 3; ++p)
#pragma unroll
        for (int j = 0; j < 3; ++j) { wA[p][j] = *(const f32x4*)(hw + j * 1536 + p * 512 + ch0 + cg); wB[p][j] = *(const f32x4*)(hw + j * 1536 + p * 512 + ch0 + cg + 4); }
    for (int jt = 0; jt < 4; ++jt) {
        const int r0 = (rt0 + jt) * 64;
        if (jt) __syncthreads();
#pragma unroll
        for (int it = 0; it < 4; ++it) { const int i = it * NTHR + c.tid;
            if (i < 3 * 66 * 8) { const int p = i / (66 * 8), rem = i % (66 * 8), rr = rem >> 3, c8 = (rem & 7) * 8; *(LAS u32x4*)(sin_ + (p * 66 + rr) * 64 + c8) = v[it]; } }
        if (jt + 1 < 4) HP_LOAD(rt0 + jt + 1);
        __syncthreads();
        { float y[3][8];
#pragma unroll
            for (int p = 0; p < 3; ++p)
#pragma unroll
                for (int e = 0; e < 8; ++e) y[p][e] = 0.f;
#pragma unroll
            for (int p = 0; p < 3; ++p)
#pragma unroll
                for (int j = 0; j < 3; ++j) { const u32x4 xv = *(const LAS u32x4*)(sin_ + (p * 66 + rl + j) * 64 + cg);
                    const f32x4 w0 = wA[p][j], w1 = wB[p][j];
                    const unsigned xw[4] = {xv.x, xv.y, xv.z, xv.w};
#pragma unroll
                    for (int q = 0; q < 4; ++q) { const float wl = q < 2 ? w0[2 * q] : w1[2 * q - 4], wh = q < 2 ? w0[2 * q + 1] : w1[2 * q - 3];
                        y[p][2 * q] += wl * bf2f((bf16)(xw[q] & 0xffffu)); y[p][2 * q + 1] += wh * bf2f((bf16)(xw[q] >> 16)); } }
            u32x4 o; o.x = pk2(y[0][0], y[0][1]); o.y = pk2(y[0][2], y[0][3]); o.z = pk2(y[0][4], y[0][5]); o.w = pk2(y[0][6], y[0][7]);
            *(u32x4*)(X0C + (size_t)(r0 + rl) * 512 + ch0 + cg) = o;
#pragma unroll
            for (int e = 0; e < 8; ++e) zt[(cg + e) * 72 + rl] = f2bf(y[1][e] * y[2][e]); }
        __syncthreads();
        { const int chl = c.tid >> 3, e = (c.tid & 7) * 8;
            const u32x4 zv = *(const LAS u32x4*)(zt + chl * 72 + e);
            *(u32x4*)(ZZT + (size_t)(ch0 + chl) * NTOK + r0 + e) = zv; }
    }
#undef HP_LOAD
}

constexpr int SC_K = 0, SC_Q = 16384, SC_V = 32768, SC_T = 49152, SC_QK = 57344, SC_CO = 65536, SC_BUF = 66816;
static_assert(2 * SC_BUF <= 146944, "scan LDS");
typedef short v4i16_t __attribute__((ext_vector_type(4)));
typedef __bf16 bf16x2_t __attribute__((ext_vector_type(2)));
DI unsigned cvtpk(float lo, float hi) { f32x2 v = {lo, hi}; bf16x2_t b = __builtin_convertvector(v, bf16x2_t); return __builtin_bit_cast(unsigned, b); }
DI bf16x8v pack44(const f32x4& a, const f32x4& b) { u32x4 p; p.x = cvtpk(a[0], a[1]); p.y = cvtpk(a[2], a[3]); p.z = cvtpk(b[0], b[1]); p.w = cvtpk(b[2], b[3]); return __builtin_bit_cast(bf16x8v, p); }
DI s16x4v ldtr(const LAS unsigned char* p) { return __builtin_bit_cast(s16x4v, __builtin_amdgcn_ds_read_tr16_b64_v4i16((LAS v4i16_t*)p)); }
DI int kq_off(int r, int ch8) { return r * 256 + ((ch8 ^ (((r & 7) << 2) | (((r >> 3) & 1) << 1))) << 3); }
DI int t_off(int r, int ch8) { return r * 128 + ((ch8 ^ (((r >> 1) & 7) << 1)) << 3); }
DI bf16x8v ldA(const LAS unsigned char* mat, int nb, int c0) { const s16x4v lo = *(const volatile LAS s16x4v*)(mat + (nb ^ (c0 << 3))), hi = *(const volatile LAS s16x4v*)(mat + (nb ^ ((c0 + 4) << 3)));     return __builtin_shufflevector(lo, hi, 0, 1, 2, 3, 4, 5, 6, 7); }
#define MFMA16(a, b, c) __builtin_amdgcn_mfma_f32_16x16x32_bf16((a), (b), (c), 0, 0, 0)
#define SC_BAR() do { asm volatile("s_waitcnt lgkmcnt(0)" ::: "memory"); __builtin_amdgcn_s_barrier(); asm volatile("" ::: "memory"); } while (0)

DI void scan_load(const Ctx& c, u32x4 (&d)[16], float& gcv, float& be, int rowbase, int chunkid, int h, int dir, int ltid  ) {
    const bf16* QKVN = (const bf16*)(c.ws + WS_QKVN); const bf16* TM = (const bf16*)(c.ws + WS_TM); const bf16* QKM = (const bf16*)(c.ws + WS_QKM);
    const size_t mbase = ((size_t)(chunkid * 4 + h) * 2 + dir) * 4096;
#pragma unroll
    for (int it = 0; it < 16; ++it) { const int u = it * 256 + ltid, v = u & 1023;
        if (it < 12) { const int which = it >> 2; const int row = v >> 4, c16 = v & 15; const int srow = rowbase + (dir ? 63 - row : row);
            const int coff = (which == 0 ? 512 : (which == 1 ? 0 : 1024)) + h * 128 + c16 * 8;
            d[it] = *(const u32x4*)(QKVN + (size_t)srow * 1536 + coff); }
        else { const int mat = v >> 9, row = (v & 511) >> 3, c16 = v & 7;
            d[it] = *(const u32x4*)((mat ? QKM : TM) + mbase + row * 64 + c16 * 8); } }
    if (ltid < 64) { const float* GBG = (const float*)(c.ws + WS_GBG); const float* GBB = (const float*)(c.ws + WS_GBB);
        const int tok = dir ? 63 - ltid : ltid; const int ri = (rowbase + tok) * 8 + dir * 4 + h;
        gcv = GBG[ri]; be = GBB[ri]; }
}
DI void scan_store(LAS unsigned char* buf, const u32x4 (&d)[16], float gcv, float be, int ltid) {
#pragma unroll
    for (int it = 0; it < 16; ++it) { const int u = it * 256 + ltid, v = u & 1023; const u32x2 lo = {d[it].x, d[it].y}, hi = {d[it].z, d[it].w};
        if (it < 12) { const int which = it >> 2; const int row = v >> 4, c16 = v & 15; LAS unsigned char* bb = buf + (which == 0 ? SC_K : (which == 1 ? SC_Q : SC_V));
            *(LAS u32x2*)(bb + kq_off(row, 2 * c16)) = lo; *(LAS u32x2*)(bb + kq_off(row, 2 * c16 + 1)) = hi; }
        else { const int mat = v >> 9, row = (v & 511) >> 3, c16 = v & 7; LAS unsigned char* bb = buf + (mat ? SC_QK : SC_T);
            *(LAS u32x2*)(bb + t_off(row, 2 * c16)) = lo; *(LAS u32x2*)(bb + t_off(row, 2 * c16 + 1)) = hi; } }
    if (ltid < 64) { const float gl = shi(gcv, 63);
        LAS float* CO = (LAS float*)(buf + SC_CO); const float eg = __expf(gcv);
        CO[ltid] = be; CO[64 + ltid] = be * eg; CO[128 + ltid] = eg; CO[192 + ltid] = __expf(gl - gcv); if (ltid == 0) CO[256] = __expf(gl); }
}

DI void scan_chain(const Ctx& c, int l, int seq, int h, int dir, int half) {
    const bool isctx = seq < 16; const int NCH = isctx ? 4 : 64, row0 = isctx ? seq * 256 : NCTX + (seq - 16) * 4096;
    const int lane = fresh_lane();
    const int w = c.wave, n = lane & 15, g = lane >> 4, dv0 = 64 * half + 16 * (w & 3);
    LAS unsigned char* lds = c.lds;
    const int cstep = dir ? -1 : 1, cfirst = dir ? NCH - 1 : 0, chunk0 = row0 >> 6;
    __syncthreads();
    if (w >= 4) {
        u32x4 dreg[16]; float gcv_ = 0.f, be_ = 0.f;
        int lt = (w - 4) * 64 + lane; asm volatile("" : "+v"(lt));
        scan_load(c, dreg, gcv_, be_, row0 + cfirst * 64, chunk0 + cfirst, h, dir, lt);
        scan_store(lds, dreg, gcv_, be_, lt);
        if (NCH > 1) scan_load(c, dreg, gcv_, be_, row0 + (cfirst + cstep) * 64, chunk0 + cfirst + cstep, h, dir, lt);
        SC_BAR();
        for (int st = 0; st < NCH; ++st) {
            const int cn = cfirst + cstep * st;
            int lt2 = lt; asm volatile("" : "+v"(lt2));
            if (st + 1 < NCH) scan_store(lds + ((st + 1) & 1) * SC_BUF, dreg, gcv_, be_, lt2);
            if (st + 2 < NCH) { const int c2 = cn + 2 * cstep; scan_load(c, dreg, gcv_, be_, row0 + c2 * 64, chunk0 + c2, h, dir, lt2); }
            SC_BAR();
        }
    } else {
        bf16* O = (bf16*)(c.ws + (dir == 0 ? WS_OF : WS_OB));
        const int nbkq0 = (n << 8) | ((g ^ (((n & 7) << 2) | (((n >> 3) & 1) << 1))) << 3), nbt0 = (n << 7) | ((g ^ (((n >> 1) & 7) << 1)) << 3);
        const int qb_ = (lane >> 2) & 3, pp_ = lane & 3;
        const int trb0 = ((4 * g + qb_) << 8) | ((pp_ ^ (((4 * (g & 1) + qb_) << 2) | ((g >> 1) << 1))) << 3);
        f32x4 St[8];
        if (isctx) {
#pragma unroll
            for (int m = 0; m < 8; ++m) St[m] = (f32x4){0.f, 0.f, 0.f, 0.f};
        } else { const float* sp = c.in[2] + ((((size_t)(seq - 16) * 4 + l) * 2 + dir) * 4 + h) * 16384 + dv0 + n + (size_t)(4 * g) * 128; asm volatile("" : "+v"(sp));
#pragma unroll
            for (int m = 0; m < 8; ++m)
#pragma unroll
                for (int e = 0; e < 4; ++e) St[m][e] = sp[(16 * m + e) * 128]; }
        SC_BAR();
        for (int st = 0; st < NCH; ++st) {
            const int cn = cfirst + cstep * st;
            LAS unsigned char* buf = lds + (st & 1) * SC_BUF;
        int nbkq_ = nbkq0, nbt_ = nbt0, trb_ = trb0; asm volatile("" : "+v"(nbkq_), "+v"(nbt_), "+v"(trb_));
        const int nbkq = nbkq_, nbt = nbt_, trb = trb_;
        const LAS float* CO = (const LAS float*)(buf + SC_CO);
#define SB() __builtin_amdgcn_sched_barrier(0)
        bf16x8v Kf[4][4];
#pragma unroll
        for (int s4 = 0; s4 < 4; ++s4)
#pragma unroll
            for (int tt = 0; tt < 4; ++tt) Kf[s4][tt] = ldA(buf + SC_K + tt * 4096, nbkq, 8 * s4);
        SB();
        s16x4v vv[4]; f32x4 c1[4], c2[4]; bf16x8v Tf[6];
#pragma unroll
        for (int tt = 0; tt < 4; ++tt) { vv[tt] = ldtr(buf + SC_V + tt * 4096 + (trb ^ ((dv0 >> 2) << 3)));
            c1[tt] = *(const LAS f32x4*)(CO + 16 * tt + 4 * g); c2[tt] = *(const LAS f32x4*)(CO + 64 + 16 * tt + 4 * g); }
        Tf[0] = ldA(buf + SC_T + 0 * 2048, nbt, 0); Tf[1] = ldA(buf + SC_T + 1 * 2048, nbt, 0); Tf[2] = ldA(buf + SC_T + 2 * 2048, nbt, 0);
        Tf[3] = ldA(buf + SC_T + 2 * 2048, nbt, 8); Tf[4] = ldA(buf + SC_T + 3 * 2048, nbt, 0); Tf[5] = ldA(buf + SC_T + 3 * 2048, nbt, 8);
        SB();
        bf16x8v Bf[4];
#pragma unroll
        for (int s4 = 0; s4 < 4; ++s4) Bf[s4] = pack44(St[2 * s4], St[2 * s4 + 1]);
        f32x4 KS[4];
#pragma unroll
        for (int tt = 0; tt < 4; ++tt) KS[tt] = (f32x4){0.f, 0.f, 0.f, 0.f};
#pragma unroll
        for (int s4 = 0; s4 < 4; ++s4)
#pragma unroll
            for (int tt = 0; tt < 4; ++tt) KS[tt] = MFMA16(Kf[s4][tt], Bf[s4], KS[tt]);
        SB();
        bf16x8v Qf[4][4];
#pragma unroll
        for (int s4 = 0; s4 < 4; ++s4)
#pragma unroll
            for (int tt = 0; tt < 4; ++tt) Qf[s4][tt] = ldA(buf + SC_Q + tt * 4096, nbkq, 8 * s4);
        SB();
#pragma unroll
        for (int tt = 0; tt < 4; ++tt)
#pragma unroll
            for (int e = 0; e < 4; ++e) KS[tt][e] = c1[tt][e] * bf2f((bf16)vv[tt][e]) - c2[tt][e] * KS[tt][e];
        f32x4 VN[4];
        { const bf16x8v xf0 = pack44(KS[0], KS[1]), xf1 = pack44(KS[2], KS[3]);
          VN[0] = MFMA16(Tf[0], xf0, ((f32x4){0.f, 0.f, 0.f, 0.f})); VN[1] = MFMA16(Tf[1], xf0, ((f32x4){0.f, 0.f, 0.f, 0.f}));
          VN[2] = MFMA16(Tf[2], xf0, ((f32x4){0.f, 0.f, 0.f, 0.f})); VN[3] = MFMA16(Tf[4], xf0, ((f32x4){0.f, 0.f, 0.f, 0.f}));
          VN[2] = MFMA16(Tf[3], xf1, VN[2]); VN[3] = MFMA16(Tf[5], xf1, VN[3]); }
        SB();
        bf16x8v Mf[6]; f32x4 egv[4], edv[4];
        Mf[0] = ldA(buf + SC_QK + 0 * 2048, nbt, 0); Mf[1] = ldA(buf + SC_QK + 1 * 2048, nbt, 0); Mf[2] = ldA(buf + SC_QK + 2 * 2048, nbt, 0);
        Mf[3] = ldA(buf + SC_QK + 2 * 2048, nbt, 8); Mf[4] = ldA(buf + SC_QK + 3 * 2048, nbt, 0); Mf[5] = ldA(buf + SC_QK + 3 * 2048, nbt, 8);
#pragma unroll
        for (int tt = 0; tt < 4; ++tt) { egv[tt] = *(const LAS f32x4*)(CO + 128 + 16 * tt + 4 * g); edv[tt] = *(const LAS f32x4*)(CO + 192 + 16 * tt + 4 * g); }
        const float egl = CO[256];
        SB();
        f32x4 QS[4];
#pragma unroll
        for (int tt = 0; tt < 4; ++tt) QS[tt] = (f32x4){0.f, 0.f, 0.f, 0.f};
#pragma unroll
        for (int s4 = 0; s4 < 4; ++s4)
#pragma unroll
            for (int tt = 0; tt < 4; ++tt) QS[tt] = MFMA16(Qf[s4][tt], Bf[s4], QS[tt]);
#pragma unroll
        for (int tt = 0; tt < 4; ++tt) QS[tt] = QS[tt] * egv[tt];
        { const bf16x8v vf0 = pack44(VN[0], VN[1]), vf1 = pack44(VN[2], VN[3]);
          QS[0] = MFMA16(Mf[0], vf0, QS[0]); QS[1] = MFMA16(Mf[1], vf0, QS[1]); QS[2] = MFMA16(Mf[2], vf0, QS[2]); QS[3] = MFMA16(Mf[4], vf0, QS[3]);
          QS[2] = MFMA16(Mf[3], vf1, QS[2]); QS[3] = MFMA16(Mf[5], vf1, QS[3]); }
        SB();
        bf16x8v Ktf[8][2];
#pragma unroll
        for (int m = 0; m < 8; ++m) {
            { const s16x4v lo = ldtr(buf + SC_K + 0 * 256 + (trb ^ ((4 * m) << 3))), hi = ldtr(buf + SC_K + 16 * 256 + (trb ^ ((4 * m) << 3))); Ktf[m][0] = __builtin_shufflevector(lo, hi, 0, 1, 2, 3, 4, 5, 6, 7); }
            { const s16x4v lo = ldtr(buf + SC_K + 32 * 256 + (trb ^ ((4 * m) << 3))), hi = ldtr(buf + SC_K + 48 * 256 + (trb ^ ((4 * m) << 3))); Ktf[m][1] = __builtin_shufflevector(lo, hi, 0, 1, 2, 3, 4, 5, 6, 7); } }
        SB();
        { const int crow0 = row0 + cn * 64;
#pragma unroll
          for (int tt = 0; tt < 4; ++tt)
#pragma unroll
            for (int e = 0; e < 4; ++e) { const int ip = 16 * tt + 4 * g + e; const int tok = dir ? 63 - ip : ip;
                O[(size_t)(crow0 + tok) * 512 + h * 128 + dv0 + n] = f2bf(QS[tt][e]); } }
        { const bf16x8v vs0 = pack44(VN[0] * edv[0], VN[1] * edv[1]), vs1 = pack44(VN[2] * edv[2], VN[3] * edv[3]);
#pragma unroll
          for (int m = 0; m < 8; ++m) { St[m] = St[m] * egl; St[m] = MFMA16(Ktf[m][0], vs0, St[m]); St[m] = MFMA16(Ktf[m][1], vs1, St[m]); } }
            SC_BAR();
        }
        if (isctx) { const int l2 = fresh_lane();
            float* sp = c.out + (size_t)NTOK * D + ((((size_t)seq * 4 + l) * 2 + dir) * 4 + h) * 16384 + dv0 + (l2 & 15) + (size_t)(4 * (l2 >> 4)) * 128;
#pragma unroll
            for (int m = 0; m < 8; ++m)
#pragma unroll
                for (int e = 0; e < 4; ++e) sp[(16 * m + e) * 128] = St[m][e]; }
    }
}

DI void phase_gdn_out(const Ctx& c, int l) {
    const bf16* OF = (const bf16*)(c.ws + WS_OF); const bf16* OB = (const bf16*)(c.ws + WS_OB);
    bf16* PROJ = (bf16*)(c.ws + WS_R1); const float* gn = c.in[13] + l * 128;
    const int gw = c.bid * NWAVES + c.wave, NGW = c.G * NWAVES;
    const int col = 8 * c.lane;
    const f32x4 gA = *(const f32x4*)(gn + (col & 127)), gB = *(const f32x4*)(gn + (col & 127) + 4);
#define GO_ROW(uf, ub, ug, r_) do { \
        const unsigned wf[4] = {uf.x, uf.y, uf.z, uf.w}, wb[4] = {ub.x, ub.y, ub.z, ub.w}, wg[4] = {ug.x, ug.y, ug.z, ug.w}; \
        float o[8]; float ss = 0.f; \
        _Pragma("unroll") for (int q = 0; q < 4; ++q) { o[2 * q] = bf2f((bf16)(wf[q] & 0xffffu)) + bf2f((bf16)(wb[q] & 0xffffu)); o[2 * q + 1] = bf2f((bf16)(wf[q] >> 16)) + bf2f((bf16)(wb[q] >> 16)); ss += o[2 * q] * o[2 * q] + o[2 * q + 1] * o[2 * q + 1]; } \
        ss += __builtin_bit_cast(float, __builtin_amdgcn_update_dpp(0, __builtin_bit_cast(int, ss), 0xB1, 0xF, 0xF, true)); \
        ss += __builtin_bit_cast(float, __builtin_amdgcn_update_dpp(0, __builtin_bit_cast(int, ss), 0x4E, 0xF, 0xF, true)); \
        ss += __builtin_bit_cast(float, __builtin_amdgcn_update_dpp(0, __builtin_bit_cast(int, ss), 0x141, 0xF, 0xF, true)); \
        ss += __builtin_bit_cast(float, __builtin_amdgcn_update_dpp(0, __builtin_bit_cast(int, ss), 0x140, 0xF, 0xF, true)); \
        const float rstd = rsqrtf(ss * (1.f / 128.f) + EPS); \
        unsigned ow[4]; \
        _Pragma("unroll") for (int q = 0; q < 4; ++q) { const float g0 = bf2f((bf16)(wg[q] & 0xffffu)), g1 = bf2f((bf16)(wg[q] >> 16)); \
            const float s0 = q < 2 ? gA[2 * q] : gB[2 * q - 4], s1 = q < 2 ? gA[2 * q + 1] : gB[2 * q - 3]; \
            ow[q] = pk2(o[2 * q] * rstd * s0 * silu_f(g0), o[2 * q + 1] * rstd * s1 * silu_f(g1)); } \
        u32x4 ov; ov.x = ow[0]; ov.y = ow[1]; ov.z = ow[2]; ov.w = ow[3]; \
        *(u32x4*)(PROJ + (size_t)(r_) * NP + 2560 + col) = ov; } while (0)
    for (int r = gw; r < NTOK; r += 2 * NGW) {
        const int r1 = r + NGW; const bool has1 = r1 < NTOK; const int r1c = has1 ? r1 : r;
        const u32x4 f0 = *(const u32x4*)(OF + (size_t)r * 512 + col), b0 = *(const u32x4*)(OB + (size_t)r * 512 + col), g0v = *(const u32x4*)(PROJ + (size_t)r * NP + 1536 + col);
        const u32x4 f1 = *(const u32x4*)(OF + (size_t)r1c * 512 + col), b1 = *(const u32x4*)(OB + (size_t)r1c * 512 + col), g1v = *(const u32x4*)(PROJ + (size_t)r1c * NP + 1536 + col);
        GO_ROW(f0, b0, g0v, r);
        if (has1) GO_ROW(f1, b1, g1v, r1);
    }
#undef GO_ROW
}

DI void phase_final(const Ctx& c) {
    const float* fg = c.in[26];
    const int gw = c.bid * NWAVES + c.wave, NGW = c.G * NWAVES;
    f32x4 g4[4];
#pragma unroll
    for (int j = 0; j < 4; ++j) g4[j] = *(const f32x4*)(fg + (c.lane + 64 * j) * 4);
    for (int r = gw; r < NTOK; r += 2 * NGW) {
        const int r1 = (r + NGW < NTOK) ? r + NGW : r;
        f32x4* xr = (f32x4*)(c.X + (size_t)r * D); f32x4* xs = (f32x4*)(c.X + (size_t)r1 * D);
        f32x4 v[4], u[4]; float ss = 0.f, st = 0.f;
#pragma unroll
        for (int j = 0; j < 4; ++j) { v[j] = xr[c.lane + 64 * j]; u[j] = xs[c.lane + 64 * j]; }
#pragma unroll
        for (int j = 0; j < 4; ++j) { ss += (v[j].x * v[j].x + v[j].y * v[j].y) + (v[j].z * v[j].z + v[j].w * v[j].w); st += (u[j].x * u[j].x + u[j].y * u[j].y) + (u[j].z * u[j].z + u[j].w * u[j].w); }
        ss = wave_sum(ss, c.lane); st = wave_sum(st, c.lane);
        const float rstd = rsqrtf(ss * (1.f / D) + EPS), rstd1 = rsqrtf(st * (1.f / D) + EPS);
#pragma unroll
        for (int j = 0; j < 4; ++j) xr[c.lane + 64 * j] = v[j] * rstd * g4[j];
        if (r1 != r) {
#pragma unroll
            for (int j = 0; j < 4; ++j) xs[c.lane + 64 * j] = u[j] * rstd1 * g4[j]; }
    }
}

#define XB_TMO      128
#define XB_XCNT(j)  (256  + 64 * (j))
#define XB_XSUB(j)  (1280 + 64 * (j))
#define XB_XGEN(j)  (2304 + 64 * (j))
#define XB_TOP      3328
#define XB_TOPGEN   3392
#define XCD_BAR_WORDS 3456
#define XB_SPIN_CAP (1u << 22)
DI unsigned xb_ld(unsigned* p) { return __hip_atomic_load(p, __ATOMIC_RELAXED, __HIP_MEMORY_SCOPE_AGENT); }
DI unsigned xb_add(unsigned* p, unsigned v) { return __hip_atomic_fetch_add(p, v, __ATOMIC_RELAXED, __HIP_MEMORY_SCOPE_AGENT); }
DI unsigned xb_xcc_id() { return (unsigned)__builtin_amdgcn_s_getreg((3 << 11) | 20) & 0xFu; }
#define XB_SPIN(cond, bar) do { unsigned _sp = 0; while (cond) { __builtin_amdgcn_s_sleep(1); \
    if ((++_sp & 255u) == 0u) { if (xb_ld(&(bar)[XB_TMO])) break; if (_sp > XB_SPIN_CAP) { atomicAdd(&(bar)[XB_TMO], 1u); break; } } } } while (0)
struct XcdBarrier { unsigned* bar; unsigned x; volatile LAS unsigned* st; };
DI XcdBarrier xcd_barrier_post(unsigned* bar, volatile LAS unsigned* st, int tid) {
    XcdBarrier b; b.bar = bar; b.x = xb_xcc_id(); b.st = st;
    if (tid == 0) (void)xb_add(&bar[XB_XCNT(b.x)], 1u);
    return b;
}
DI void xcd_barrier_complete(unsigned* bar, unsigned x, unsigned& nloc, unsigned& nx) {
    const unsigned G = gridDim.x * gridDim.y * gridDim.z;
    unsigned sum, cnt, mine, sp = 0u;
    for (;;) {
        sum = 0u; cnt = 0u; mine = 0u;
#pragma unroll
        for (unsigned j = 0; j < 16; ++j) { const unsigned cc = xb_ld(&bar[XB_XCNT(j)]); sum += cc; cnt += (cc > 0u) ? 1u : 0u; mine = (j == x) ? cc : mine; }
        if (sum == G) break;
        __builtin_amdgcn_s_sleep(1);
        if ((++sp & 255u) == 0u) { if (xb_ld(&bar[XB_TMO])) break; if (sp > XB_SPIN_CAP) { atomicAdd(&bar[XB_TMO], 1u); break; } }
    }
    nloc = mine > 0u ? mine : 1u; nx = cnt > 0u ? cnt : 1u;
}
DI void xcd_barrier(const XcdBarrier& b, int tid) {
    asm volatile("s_waitcnt vmcnt(0)" ::: "memory");
    __syncthreads();
    if (tid == 0) {
        unsigned* bar = b.bar;
        __builtin_amdgcn_s_waitcnt(0);
        unsigned nloc = b.st[0], nx = b.st[1];
        if (nloc == 0u) { xcd_barrier_complete(bar, b.x, nloc, nx); b.st[0] = nloc; b.st[1] = nx; }
        const unsigned old = xb_add(&bar[XB_XSUB(b.x)], 1u);
        const unsigned gen = old / nloc;
        if (old + 1u == (gen + 1u) * nloc) {
            __builtin_amdgcn_fence(__ATOMIC_RELEASE, "agent");
            asm volatile("s_waitcnt vmcnt(0)" ::: "memory");
            const unsigned og = xb_add(&bar[XB_TOP], 1u);
            const unsigned tg = og / nx;
            if (og + 1u == (tg + 1u) * nx) xb_add(&bar[XB_TOPGEN], 1u);
            else XB_SPIN(xb_ld(&bar[XB_TOPGEN]) == tg, bar);
            __builtin_amdgcn_fence(__ATOMIC_ACQUIRE, "agent");
            xb_add(&bar[XB_XGEN(b.x)], 1u);
            asm volatile("s_waitcnt vmcnt(0)" ::: "memory");
        } else {
            XB_SPIN(xb_ld(&bar[XB_XGEN(b.x)]) == gen, bar);
            __builtin_amdgcn_fence(__ATOMIC_ACQUIRE, "agent");
            asm volatile("s_waitcnt vmcnt(0)" ::: "memory");
        }
    }
    __syncthreads();
}

constexpr int MISC_OFF = 146944;
__global__ void __launch_bounds__(NTHR, 2) fwd_kernel(KP p) {
    extern __shared__ __attribute__((aligned(16))) unsigned char lds_raw[];
    LAS unsigned char* lds0 = (LAS unsigned char*)lds_raw;
    const int wave0 = __builtin_amdgcn_readfirstlane((int)(threadIdx.x >> 6));
#define CUR_TID() ({ unsigned z_ = 0u; asm volatile("" : "+s"(z_)); wave0 * 64 + (int)__builtin_amdgcn_mbcnt_hi(~0u, __builtin_amdgcn_mbcnt_lo(~0u, z_)); })
    { const int t0 = CUR_TID(); volatile LAS unsigned* M0 = (volatile LAS unsigned*)(lds0 + MISC_OFF); if (t0 < 32) M0[t0] = 0u; }
    __syncthreads();
    const bool multi = (p.ph_hi - p.ph_lo) < 2;
    if (!multi) { KPc kp0 = (KPc)__builtin_amdgcn_kernarg_segment_ptr(); (void)xcd_barrier_post((unsigned*)(kp0->ws + WS_CTL) + 4096, (volatile LAS unsigned*)(lds0 + MISC_OFF) + 8, CUR_TID()); }
    for (int ph = p.ph_lo; ph < p.ph_hi; ++ph) {
        for (int rep = 0; rep < 2; ++rep) {
        KPc kp = (KPc)__builtin_amdgcn_kernarg_segment_ptr(); asm volatile("" : "+s"(kp));
        int tid = CUR_TID(); asm volatile("" : "+v"(tid));
        int bid = blockIdx.x; asm volatile("" : "+s"(bid));
        Ctx c;
        c.in = kp->in; c.X = kp->out; c.out = kp->out; c.ws = kp->ws; c.lds = lds0;
        c.tid = tid; c.lane = tid & 63; c.wave = __builtin_amdgcn_readfirstlane(tid >> 6); c.bid = bid; c.G = gridDim.x;
        if (ph == 0) { if (rep == 0 || (DUP_MASK & 32)) phase_mod(c); }
        else if (ph == 1) { if (rep == 0 || (DUP_MASK & 32)) { phase_sw(c); phase_rowprep<1, true>(c, 0); phase_filters(c, 0); phase_wconv_in(c, 0); } }
        else if (ph == NPH - 1) { if (rep == 0) phase_final(c); }
        else {
            const int l = (ph - 2) >> 3, sub = (ph - 2) & 7;
            if (rep == 1) break;
            switch (sub) {
                case 0: phase_gemm_fast<EPI_PROJ>(c, l); break;
                case 1: phase_prep_fast(c, l); break;
                case 2: phase_queue(c, l); break;
                case 3: phase_gdn_out(c, l); phase_hyena_out(c); break;
                case 4: phase_gemm_fast<EPI_RES1>(c, l); break;
                case 5: phase_gemm_fast<EPI_H>(c, l); break;
                case 6: phase_g4_main(c, l); break;
                default: phase_g4_combine(c, l); break;
            }
        }
        if (DUP_MASK == 0) break;
        __syncthreads();
        }
        KPc kpb = (KPc)__builtin_amdgcn_kernarg_segment_ptr();
        if (DUP_MASK & 64) { XcdBarrier bar; bar.bar = (unsigned*)(kpb->ws + WS_CTL) + 4096; bar.x = xb_xcc_id(); bar.st = (volatile LAS unsigned*)(lds0 + MISC_OFF) + 8; xcd_barrier(bar, CUR_TID()); }
        if (ph + 1 < kpb->ph_hi) { XcdBarrier bar; bar.bar = (unsigned*)(kpb->ws + WS_CTL) + 4096; bar.x = xb_xcc_id(); bar.st = (volatile LAS unsigned*)(lds0 + MISC_OFF) + 8; xcd_barrier(bar, CUR_TID()); }
    }
}

extern "C" void kernel_launch(void* const* d_in, const int* in_sizes, int n_in, void* d_out, int out_size, void* d_ws, size_t ws_size, hipStream_t stream) {
    static int grid = 0;
    if (grid == 0) {
        if (n_in != 27 || out_size != NTOK * D + 16 * 4 * 2 * 4 * 128 * 128 || ws_size < WS_END) {
            fprintf(stderr, "kernel_launch: unexpected problem: n_in %d out %d ws %zu (need %zu)\n", n_in, out_size, ws_size, (size_t)WS_END); grid = -1; return; }
        int dev = 0, cus = 0;
        if (hipGetDevice(&dev) != hipSuccess || hipDeviceGetAttribute(&cus, hipDeviceAttributeMultiprocessorCount, dev) != hipSuccess) { grid = -1; return; }
        if (hipFuncSetAttribute((const void*)fwd_kernel, hipFuncAttributeMaxDynamicSharedMemorySize, LDS_BYTES) != hipSuccess) { fprintf(stderr, "kernel_launch: hipFuncSetAttribute failed\n"); grid = -1; return; }
        int per_cu = 0;
        if (hipOccupancyMaxActiveBlocksPerMultiprocessor(&per_cu, (const void*)fwd_kernel, NTHR, LDS_BYTES) != hipSuccess || per_cu < 1)
            fprintf(stderr, "kernel_launch: occupancy query says %d blocks per CU\n", per_cu);
        (void)hipGetLastError();
        grid = cus;
    }
    if (grid < 0) return;
    (void)hipMemsetAsync((char*)d_ws + WS_CTL, 0, CTL_ZERO_BYTES, stream);
    KP p{};
    for (int i = 0; i < 27; ++i) p.in[i] = (const float*)d_in[i];
    p.out = (float*)d_out; p.ws = (unsigned char*)d_ws;
#if MK_MULTI
    for (int ph = 0; ph < NPH; ++ph) { p.ph_lo = ph; p.ph_hi = ph + 1; hipLaunchKernelGGL(fwd_kernel, dim3(grid), dim3(NTHR), LDS_BYTES, stream, p); }
#else
    p.ph_lo = 0; p.ph_hi = NPH; hipLaunchKernelGGL(fwd_kernel, dim3(grid), dim3(NTHR), LDS_BYTES, stream, p);
#endif
}
```

```cpp
#include <hip/hip_runtime.h>
#include <cstdio>
#include <cstdint>

#define GAS __attribute__((address_space(1)))
#define LAS __attribute__((address_space(3)))
#define DI __device__ __forceinline__
typedef unsigned short bf16;
typedef float f32x4 __attribute__((ext_vector_type(4)));
typedef float f32x2 __attribute__((ext_vector_type(2)));
typedef unsigned u32x4 __attribute__((ext_vector_type(4)));
typedef unsigned u32x2 __attribute__((ext_vector_type(2)));
typedef short bf16x8v __attribute__((ext_vector_type(8)));
typedef float f32x16 __attribute__((ext_vector_type(16)));
typedef short s16x4v __attribute__((ext_vector_type(4)));

#ifndef DUP_MASK
#define DUP_MASK 0
#endif
#ifndef MK_MULTI
#define MK_MULTI 0
#endif

constexpr int D = 1024, FF = 4096, DEPTH = 4;
constexpr int NCTX = 4096, NTOK = 20480;
constexpr int NP = 3584;
constexpr int IN_COLS = 3600;
constexpr int NWAVES = 8, NTHR = 512;
constexpr float EPS = 1e-6f;
constexpr int NPH = 35;

constexpr size_t MiB = 1u << 20;
constexpr size_t WS_CTL = 0, CTL_ZERO_BYTES = 1 * MiB;
constexpr size_t WS_MOD = 1 * MiB;
constexpr size_t WS_SWIN = 1 * MiB + 512 * 1024;
constexpr size_t WS_SW1 = 2 * MiB;
constexpr size_t WS_RSS1 = 2 * MiB + 512 * 1024;
constexpr size_t WS_RSS2 = WS_RSS1 + 128 * 1024;
constexpr size_t WS_LOGIT = 3 * MiB;
constexpr size_t WS_GBG = 4 * MiB + 512 * 1024;
constexpr size_t WS_GBB = WS_GBG + 640 * 1024;
constexpr size_t WS_WT = 6 * MiB;
constexpr size_t WS_FILT = 32 * MiB;
constexpr size_t WS_A = 50 * MiB;
constexpr size_t WS_OF = WS_A, WS_OB = WS_A + 20 * MiB;
constexpr size_t WS_R1 = 90 * MiB;
constexpr size_t WS_ZZT = WS_R1 + 140 * MiB;
constexpr size_t WS_QKVN = 250 * MiB;
constexpr size_t WS_TMQK = 310 * MiB;
constexpr size_t WS_X0C = 350 * MiB;
constexpr size_t WS_RSSP1 = 370 * MiB;
constexpr size_t WS_RSSP2 = 372 * MiB;
constexpr size_t WS_END = 374 * MiB;

constexpr int LDS_BYTES = 147456;

DI float bf2f(bf16 h) { return __builtin_bit_cast(float, (unsigned)h << 16); }
DI bf16 f2bf(float f) { unsigned u = __builtin_bit_cast(unsigned, f); return (bf16)((u + 0x7fffu + ((u >> 16) & 1u)) >> 16); }
DI unsigned pk2(float lo, float hi) { return (unsigned)f2bf(lo) | ((unsigned)f2bf(hi) << 16); }
DI float shx(float v, int o, int lane) { return __builtin_bit_cast(float, __builtin_amdgcn_ds_bpermute((lane ^ o) << 2, __builtin_bit_cast(int, v))); }
DI float shi(float v, int src) { return __builtin_bit_cast(float, __builtin_amdgcn_ds_bpermute(src << 2, __builtin_bit_cast(int, v))); }
DI int fresh_lane() { unsigned z_ = 0u; asm volatile("" : "+s"(z_)); return (int)__builtin_amdgcn_mbcnt_hi(~0u, __builtin_amdgcn_mbcnt_lo(~0u, z_)); }
DI float wave_sum(float v, int lane) {
#pragma unroll
    for (int o = 1; o < 64; o <<= 1) v += shx(v, o, lane);
    return v;
}
DI float silu_f(float x) { return x * __builtin_amdgcn_rcpf(1.f + __expf(-x)); }
DI float sigmoid_f(float x) { return __builtin_amdgcn_rcpf(1.f + __expf(-x)); }
DI float softplus_f(float x) { return x > 15.f ? x : __logf(1.f + __expf(x)); }
DI float sin_rev(float rev) { return __builtin_amdgcn_sinf(rev); }
DI float cos_rev(float rev) { return __builtin_amdgcn_cosf(rev); }
DI float rss_read(const float* P, int r) { const f32x4* p = (const f32x4*)(P + (size_t)r * 16); const f32x4 a = p[0], b = p[1], c2 = p[2], d = p[3]; const f32x4 t = (a + b) + (c2 + d); return (t.x + t.y) + (t.z + t.w); }
DI int mod_of_row(int r) { return r < NCTX ? 4 : ((r - NCTX) >> 12); }

struct KP {
    const float* in[27];
    float* out;
    unsigned char* ws;
    int ph_lo, ph_hi;
};

#define CAS __attribute__((address_space(4)))
typedef const KP CAS* KPc;
typedef const float* const CAS* InTab;
struct Ctx {
    InTab in;
    float* X;
    float* out;
    unsigned char* ws;
    LAS unsigned char* lds;
    int tid, lane, wave, bid, G;
};

DI void phase_mod(const Ctx& c) {
    const float* cin = c.in[3]; const float* cctx = c.in[4]; const float* w_ada = c.in[5]; const float* b_ada = c.in[6];
    LAS float* sc = (LAS float*)c.lds;
    LAS float* red = sc + 5 * 1024;
    for (int i = c.tid; i < 5 * 1024; i += NTHR) { const int m = i >> 10, k = i & 1023; const float v = (m < 4) ? cin[m * 1024 + k] : cctx[k]; sc[i] = silu_f(v); }
    __syncthreads();
    float* MOD = (float*)(c.ws + WS_MOD);
    const int jl = c.tid & 63, ks = c.tid >> 6;
    for (int task = c.bid; task < 4 * 96; task += c.G) {
        const int l = task / 96, cb = task % 96, j = cb * 64 + jl;
        float acc[5] = {0.f, 0.f, 0.f, 0.f, 0.f};
        const float* wp = w_ada + (size_t)l * 1024 * 6144 + j;
        for (int k = ks * 128; k < ks * 128 + 128; ++k) { const float w = wp[(size_t)k * 6144];
#pragma unroll
            for (int m = 0; m < 5; ++m) acc[m] += sc[m * 1024 + k] * w; }
#pragma unroll
        for (int m = 0; m < 5; ++m) red[(ks * 5 + m) * 64 + jl] = acc[m];
        __syncthreads();
        if (c.tid < 320) { const int m = c.tid >> 6; float s = 0.f;
#pragma unroll
            for (int q = 0; q < 8; ++q) s += red[(q * 5 + m) * 64 + jl];
            MOD[(size_t)(l * 5 + m) * 6144 + j] = s + b_ada[l * 6144 + j]; }
        __syncthreads();
    }
}

DI void phase_sw(const Ctx& c) {
    const float* MOD = (const float*)(c.ws + WS_MOD);
    LAS float* sc = (LAS float*)c.lds;
    LAS float* red = sc + 5 * 1024;
    float* SWIN = (float*)(c.ws + WS_SWIN); float* SW1 = (float*)(c.ws + WS_SW1);
    const int jl = c.tid & 63, ks = c.tid >> 6;
    constexpr int NB_IN = 57, NB_1 = 64, PER_L = NB_IN + NB_1;
    int cur_key = -1;
    for (int task = c.bid; task < 4 * PER_L; task += c.G) {
        const int l = task / PER_L, t = task % PER_L; const bool is1 = t >= NB_IN; const int cb = is1 ? t - NB_IN : t;
        const int key = l * 2 + (is1 ? 1 : 0);
        if (key != cur_key) {
            __syncthreads();
            for (int i = c.tid; i < 5 * 1024; i += NTHR) { const int m = i >> 10, k = i & 1023; sc[i] = MOD[(size_t)(l * 5 + m) * 6144 + (is1 ? 3 : 0) * 1024 + k]; }
            __syncthreads(); cur_key = key;
        }
        const int N = is1 ? FF : IN_COLS; const float* W = (is1 ? c.in[24] : c.in[9]) + (size_t)l * 1024 * N;
        const int j = cb * 64 + jl; const bool ok = j < N;
        float acc[5] = {0.f, 0.f, 0.f, 0.f, 0.f};
        if (ok) { const float* wp = W + j;
            for (int k = ks * 128; k < ks * 128 + 128; ++k) { const float w = wp[(size_t)k * N];
#pragma unroll
                for (int m = 0; m < 5; ++m) acc[m] += sc[m * 1024 + k] * w; } }
#pragma unroll
        for (int m = 0; m < 5; ++m) red[(ks * 5 + m) * 64 + jl] = acc[m];
        __syncthreads();
        if (c.tid < 320 && ok) { const int m = c.tid >> 6; float s = 0.f;
#pragma unroll
            for (int q = 0; q < 8; ++q) s += red[(q * 5 + m) * 64 + jl];
            (is1 ? SW1 : SWIN)[(size_t)(l * 5 + m) * N + j] = s; }
        __syncthreads();
    }
}

template <int WHICH, bool FIRST>
DI void phase_rowprep(const Ctx& c, int l) {
    const float* MOD = (const float*)(c.ws + WS_MOD);
    const float* ng = (WHICH == 1 ? c.in[7] : c.in[8]) + l * 1024;
    float* RSS = (float*)(c.ws + (WHICH == 1 ? WS_RSSP1 : WS_RSSP2));
    bf16* A = (bf16*)(c.ws + WS_A);
    float* LOGIT = (float*)(c.ws + WS_LOGIT);
    const float* w_in = c.in[9] + (size_t)l * 1024 * IN_COLS;
    const int gw = c.bid * NWAVES + c.wave, NGW = c.G * NWAVES;
    for (int r = gw; r < NTOK; r += NGW) {
        const int mb = mod_of_row(r);
        const float* mrow = MOD + (size_t)(l * 5 + mb) * 6144;
        const float* shift = mrow + (WHICH == 1 ? 0 : 3) * 1024; const float* scale = mrow + (WHICH == 1 ? 1 : 4) * 1024;
        const f32x4* xr = FIRST ? (const f32x4*)((r < NCTX ? c.in[0] : c.in[1] - (size_t)NCTX * D) + (size_t)r * D) : (const f32x4*)(c.X + (size_t)r * D);
        f32x4 v[4]; float ss = 0.f;
#pragma unroll
        for (int j = 0; j < 4; ++j) { v[j] = xr[c.lane + 64 * j]; ss += (v[j].x * v[j].x + v[j].y * v[j].y) + (v[j].z * v[j].z + v[j].w * v[j].w); }
        ss = wave_sum(ss, c.lane);
        if (!FIRST) ss = rss_read(RSS, r);
        if (FIRST && c.lane < 16) RSS[(size_t)r * 16 + c.lane] = c.lane == 0 ? ss : 0.f;
        const float rstd = rsqrtf(ss * (1.f / D) + EPS);
        if (FIRST)
#pragma unroll
        for (int j = 0; j < 4; ++j) {
            const int k0 = (c.lane + 64 * j) * 4;
            const f32x4 g4 = *(const f32x4*)(ng + k0), s4 = *(const f32x4*)(scale + k0);
            const f32x4 a = v[j] * (g4 * (s4 + 1.0f));
            u32x2 w; w.x = pk2(a.x, a.y); w.y = pk2(a.z, a.w);
            *(u32x2*)(A + (size_t)r * D + k0) = w;
        }
        float lg[16];
#pragma unroll
        for (int q = 0; q < 16; ++q) lg[q] = 0.f;
        if (WHICH == 1 && !FIRST) {
#pragma unroll 1
            for (int j = 0; j < 4; ++j) {
                const int k0 = (c.lane + 64 * j) * 4;
                const f32x4 xv = xr[c.lane + 64 * j];
                const f32x4 g4 = *(const f32x4*)(ng + k0), s4 = *(const f32x4*)(scale + k0), sh = *(const f32x4*)(shift + k0);
                const f32x4 hn = xv * (g4 * (s4 + 1.0f)) * rstd + sh;
#pragma unroll
                for (int e = 0; e < 4; ++e) { const float h = hn[e]; const f32x4* wp = (const f32x4*)(w_in + (size_t)(k0 + e) * IN_COLS + 2048);
#pragma unroll
                    for (int q = 0; q < 4; ++q) { const f32x4 w4 = wp[q]; lg[4 * q] += h * w4.x; lg[4 * q + 1] += h * w4.y; lg[4 * q + 2] += h * w4.z; lg[4 * q + 3] += h * w4.w; }
                    asm volatile("" ::: "memory"); }
            }
        }
        if (WHICH == 1 && !FIRST) {
#pragma unroll
            for (int q = 0; q < 16; ++q) { const float s = wave_sum(lg[q], c.lane); if (c.lane == q) LOGIT[(size_t)r * 16 + q] = s; }
        }
    }
}

constexpr size_t FILT_SLOT = 9 * MiB;
DI void filters_task(const Ctx& c, int l, int task) {
    const float* w1 = c.in[15] + l * 33 * 64; const float* b1 = c.in[16] + l * 64; const float* fr = c.in[17] + l * 64;
    const float* w2 = c.in[18] + l * 64 * 64; const float* b2 = c.in[19] + l * 64; const float* w3 = c.in[20] + (size_t)l * 64 * 1024; const float* b3 = c.in[21] + l * 1024;
    bf16* RL = (bf16*)(c.ws + WS_FILT + (l & 1) * FILT_SLOT);
    bf16* RC = RL + 8 * MiB / 2;
    const float* skip = c.in[22] + l * 512;
    LAS float* H2 = (LAS float*)c.lds;
    const float min_decay = -3.0701134573253945f, max_decay = -15.350567286626972f;
    {
        const bool isL = task < 64; const int L = isL ? 4096 : 256, tb = isL ? task * 64 : (task - 64) * 64;
        float w1c[33], w2c[64];
#pragma unroll
        for (int i = 0; i < 33; ++i) w1c[i] = w1[i * 64 + c.lane];
#pragma unroll
        for (int i = 0; i < 64; ++i) w2c[i] = w2[i * 64 + c.lane];
        const float b1v = b1[c.lane], b2v = b2[c.lane], frv = fr[c.lane] * 0.15915494309189535f;
        for (int k = 0; k < 8; ++k) {
            const int tl = c.wave * 8 + k, t = tb + tl;
            const float tn = (float)t / (float)(L - 1), trev = (float)t / (float)L;
            float z = 0.f;
            if (c.lane == 0) z = tn;
            else if (c.lane <= 32) { const int i = (c.lane - 1) & 15; const float f = 1e-4f + (float)i * ((15.0f - 1e-4f) / 15.0f); z = (c.lane <= 16) ? cos_rev(f * trev) : -sin_rev(f * trev); }
            float a = b1v;
#pragma unroll
            for (int i = 0; i < 33; ++i) a += shi(z, i) * w1c[i];
            const float h1 = sin_rev(frv * a);
            float a2 = b2v;
#pragma unroll
            for (int i = 0; i < 64; ++i) a2 += shi(h1, i) * w2c[i];
            H2[tl * 68 + c.lane] = sin_rev(frv * a2);
        }
        __syncthreads();
        const int n = c.lane & 31, hh = c.lane >> 5;
        for (int ot = 0; ot < 4; ++ot) {
            const int o0 = c.wave * 128 + ot * 32;
            f32x16 acc[2];
#pragma unroll
            for (int tt = 0; tt < 2; ++tt)
#pragma unroll
                for (int i = 0; i < 16; ++i) acc[tt][i] = 0.f;
#pragma unroll
            for (int ks = 0; ks < 4; ++ks) {
                float wv[8];
#pragma unroll
                for (int j = 0; j < 8; ++j) wv[j] = w3[(16 * ks + 8 * hh + j) * 1024 + o0 + n];
                u32x4 ah, al;
#pragma unroll
                for (int j = 0; j < 4; ++j) { const float x0 = wv[2 * j], x1 = wv[2 * j + 1]; const bf16 h0 = f2bf(x0), h1 = f2bf(x1);
                    ah[j] = (unsigned)h0 | ((unsigned)h1 << 16); al[j] = pk2(x0 - bf2f(h0), x1 - bf2f(h1)); }
#pragma unroll
                for (int tt = 0; tt < 2; ++tt) {
                    const LAS f32x4* hp = (const LAS f32x4*)(H2 + (32 * tt + n) * 68 + 16 * ks + 8 * hh); const f32x4 p0 = hp[0], p1 = hp[1];
                    const float hv[8] = {p0.x, p0.y, p0.z, p0.w, p1.x, p1.y, p1.z, p1.w};
                    u32x4 bh, bl;
#pragma unroll
                    for (int j = 0; j < 4; ++j) { const float x0 = hv[2 * j], x1 = hv[2 * j + 1]; const bf16 h0 = f2bf(x0), h1 = f2bf(x1);
                        bh[j] = (unsigned)h0 | ((unsigned)h1 << 16); bl[j] = pk2(x0 - bf2f(h0), x1 - bf2f(h1)); }
                    const bf16x8v Ah = __builtin_bit_cast(bf16x8v, ah), Al = __builtin_bit_cast(bf16x8v, al), Bh = __builtin_bit_cast(bf16x8v, bh), Bl = __builtin_bit_cast(bf16x8v, bl);
                    acc[tt] = __builtin_amdgcn_mfma_f32_32x32x16_bf16(Ah, Bh, acc[tt], 0, 0, 0);
                    acc[tt] = __builtin_amdgcn_mfma_f32_32x32x16_bf16(Ah, Bl, acc[tt], 0, 0, 0);
                    acc[tt] = __builtin_amdgcn_mfma_f32_32x32x16_bf16(Al, Bh, acc[tt], 0, 0, 0);
                }
            }
#pragma unroll
            for (int tt = 0; tt < 2; ++tt) { const int t = tb + 32 * tt + n; const float tn = (float)t / (float)(L - 1);
#pragma unroll
                for (int i = 0; i < 16; ++i) { const int oo = o0 + (i & 3) + 8 * (i >> 2) + 4 * hh, dir = oo >> 9, ch = oo & 511;
                    const float delta = fabsf(min_decay + (float)ch * ((max_decay - min_decay) / 511.0f));
                    float val = (acc[tt][i] + b3[oo]) * __expf(-tn * delta);
                    if (t == 0) val = dir == 0 ? val + skip[ch] : 0.f;
                    const int q = dir == 0 ? L - t : (t == 0 ? 0 : L + t);
                    if (isL) RL[(size_t)ch * 8192 + q] = f2bf(val); else RC[(size_t)ch * 512 + q] = f2bf(val); } }
        }
    }
}
DI void phase_filters(const Ctx& c, int l) {
    for (int task = c.bid; task < 68; task += c.G) { __syncthreads(); Ctx cf = c; { const int lq = fresh_lane(); cf.lane = lq; cf.tid = c.wave * 64 + lq; } filters_task(cf, l, task); }
    __syncthreads();
}

enum { EPI_PROJ = 0, EPI_RES1 = 1, EPI_H = 2, EPI_RES2 = 3 };
template <int EPI>
DI void phase_gemm_naive(const Ctx& c, int l) {
    const bf16* A; int lda, K, N, ldw; const float* W;
    if (EPI == EPI_PROJ) { A = (const bf16*)(c.ws + WS_A); lda = D; K = D; N = NP; ldw = IN_COLS; W = c.in[9] + (size_t)l * D * IN_COLS; }
    else if (EPI == EPI_RES1) { A = (const bf16*)(c.ws + WS_R1) + 2560; lda = NP; K = D; N = D; ldw = D; W = c.in[23] + (size_t)l * D * D; }
    else if (EPI == EPI_H) { A = (const bf16*)(c.ws + WS_A); lda = D; K = D; N = FF; ldw = FF; W = c.in[24] + (size_t)l * D * FF; }
    else { A = (const bf16*)(c.ws + WS_R1); lda = FF; K = FF; N = D; ldw = D; W = c.in[25] + (size_t)l * FF * D; }
    const float* MOD = (const float*)(c.ws + WS_MOD);
    const float* RSS1 = (const float*)(c.ws + WS_RSS1); const float* RSS2 = (const float*)(c.ws + WS_RSS2);
    const float* SWIN = (const float*)(c.ws + WS_SWIN); const float* SW1 = (const float*)(c.ws + WS_SW1);
    bf16* PROJ = (bf16*)(c.ws + WS_R1); bf16* Hb = (bf16*)(c.ws + WS_R1);
    LAS float* As = (LAS float*)c.lds;
    LAS float* Bs = As + 16 * 68;
    const int ty = c.tid >> 5, tx = c.tid & 31;
    const int nMt = NTOK / 64, nNt = N / 128;
    for (int tile = c.bid; tile < nMt * nNt; tile += c.G) {
        const int tm = tile / nNt, tn = tile % nNt, row0 = tm * 64, col0 = tn * 128;
        float acc[4][4];
#pragma unroll
        for (int i = 0; i < 4; ++i)
#pragma unroll
            for (int j = 0; j < 4; ++j) acc[i][j] = 0.f;
        for (int k0 = 0; k0 < K; k0 += 16) {
            { const int ar = c.tid >> 3, kp = (c.tid & 7) * 2; const unsigned u = *(const unsigned*)(A + (size_t)(row0 + ar) * lda + k0 + kp);
              As[kp * 68 + ar] = bf2f((bf16)(u & 0xffffu)); As[(kp + 1) * 68 + ar] = bf2f((bf16)(u >> 16)); }
            { const int kr = c.tid >> 5, c4 = (c.tid & 31) * 4; int col = col0 + c4; if (EPI == EPI_PROJ && col >= 2048) col += 16;
              const f32x4 w = *(const f32x4*)(W + (size_t)(k0 + kr) * ldw + col); *(LAS f32x4*)(Bs + kr * 128 + c4) = w; }
            __syncthreads();
#pragma unroll
            for (int kk = 0; kk < 16; ++kk) { const f32x4 a = *(const LAS f32x4*)(As + kk * 68 + ty * 4); const f32x4 b = *(const LAS f32x4*)(Bs + kk * 128 + tx * 4);
#pragma unroll
                for (int i = 0; i < 4; ++i)
#pragma unroll
                    for (int j = 0; j < 4; ++j) acc[i][j] += a[i] * b[j]; }
            __syncthreads();
        }
#pragma unroll
        for (int i = 0; i < 4; ++i) {
            const int r = row0 + ty * 4 + i, mb = mod_of_row(r), n = col0 + tx * 4;
            if (EPI == EPI_PROJ) {
                const float rstd = rsqrtf(RSS1[r] * (1.f / D) + EPS); const int oc = n >= 2048 ? n + 16 : n;
                const f32x4 sw = *(const f32x4*)(SWIN + (size_t)(l * 5 + mb) * IN_COLS + oc);
                u32x2 w; w.x = pk2(acc[i][0] * rstd + sw.x, acc[i][1] * rstd + sw.y); w.y = pk2(acc[i][2] * rstd + sw.z, acc[i][3] * rstd + sw.w);
                *(u32x2*)(PROJ + (size_t)r * NP + n) = w;
            } else if (EPI == EPI_H) {
                const float rstd = rsqrtf(RSS2[r] * (1.f / D) + EPS);
                const f32x4 sw = *(const f32x4*)(SW1 + (size_t)(l * 5 + mb) * FF + n);
                float v[4];
#pragma unroll
                for (int j = 0; j < 4; ++j) { float t = acc[i][j] * rstd + sw[j]; t = t > 0.f ? t : 0.f; v[j] = t * t; }
                u32x2 w; w.x = pk2(v[0], v[1]); w.y = pk2(v[2], v[3]);
                *(u32x2*)(Hb + (size_t)r * FF + n) = w;
            } else {
                const f32x4 gate = *(const f32x4*)(MOD + (size_t)(l * 5 + mb) * 6144 + (EPI == EPI_RES1 ? 2 : 5) * 1024 + n);
                f32x4* xp = (f32x4*)(c.X + (size_t)r * D + n); f32x4 x = *xp;
                x.x += gate.x * acc[i][0]; x.y += gate.y * acc[i][1]; x.z += gate.z * acc[i][2]; x.w += gate.w * acc[i][3];
                *xp = x;
            }
        }
    }
}


namespace pg8 {
#define PG8_LAS __attribute__((address_space(3)))
typedef unsigned short bf16_t;
typedef short bf16x8 __attribute__((ext_vector_type(8)));
typedef float f32x4 __attribute__((ext_vector_type(4)));
typedef unsigned u32x4 __attribute__((ext_vector_type(4)));
constexpr int BM = 256, BK = 64, HALF = 128, HTB = HALF * BK * 2  , STAGE_BYTES = 8 * HTB, NXCD = 8, WGM = 8;

__host__ __device__ __forceinline__ int lds_byte(int r, int c) { const int st = (r >> 4) * 2 + (c >> 5), rr = r & 15, cc = c & 31, ob = rr * 64 + cc * 2; return st * 1024 + (ob ^ (((ob >> 9) & 1) << 5)); }
__host__ __device__ __forceinline__ void stage_rc(int b, int& R, int& C) { const int st = b / 1024, sb = b % 1024, swz = sb ^ (((sb >> 9) & 1) << 5); R = (st >> 1) * 16 + swz / 64; C = (st & 1) * 32 + (swz % 64) / 2; }
__host__ __device__ __forceinline__ int perm32(int rho) { const int n = rho >> 4, i = rho & 15; return 8 * (i >> 2) + 4 * n + (i & 3); }

struct Unit { int pm, pn; };
struct Gemm { const bf16_t* A; const bf16_t* Bt; int M, N, K, lda; };

struct StaticOrder {
    int nM, nN, nwg, G, c;
    __host__ __device__ void init(int M, int N, int G_, int c_) { nM = M / BM; nN = N / BM; nwg = nM * nN; G = G_; c = c_; }
    __host__ __device__ bool next(int i, Unit& u) const {
        const long L = (long)i * G + c; if (L >= nwg) return false;
        int wgid = (int)L; { const int q = nwg / NXCD, r = nwg % NXCD, xcd = wgid % NXCD, off = wgid / NXCD; wgid = (xcd < r ? xcd * (q + 1) : r * (q + 1) + (xcd - r) * q) + off; }
        const int nig = WGM * nN, gid = wgid / nig, fm = gid * WGM, gsz = (nM - fm) < WGM ? (nM - fm) : WGM;
        u.pm = fm + ((wgid % nig) % gsz); u.pn = (wgid % nig) / gsz; return true;
    }
    __device__ __forceinline__ void a_ready(const Unit&) const {}
    __device__ __forceinline__ void done(const Unit&) const {}
};

template <int N_, int K_, int LDA_, int LDB_ = K_> struct GemmT { const bf16_t* A; const bf16_t* Bt; static constexpr int M = 20480, N = N_, K = K_, lda = LDA_, ldb = LDB_; };
template <int N_> struct StaticOrderT {
    static constexpr int nM = 20480 / BM, nN = N_ / BM, nwg = nM * nN; int G, c;
    __device__ __forceinline__ bool next(int i, Unit& u) const {
        const int L = i * G + c; if (L >= nwg) return false;
        int wgid = L; { constexpr int q = nwg / NXCD, r = nwg % NXCD; const int xcd = wgid % NXCD, off = wgid / NXCD; wgid = (xcd < r ? xcd * (q + 1) : r * (q + 1) + (xcd - r) * q) + off; }
        constexpr int nig = WGM * nN; const int gid = wgid / nig, fm = gid * WGM, gsz = (nM - fm) < WGM ? (nM - fm) : WGM;
        u.pm = fm + ((wgid % nig) % gsz); u.pn = (wgid % nig) / gsz; return true;
    }
    __device__ __forceinline__ void a_ready(const Unit&) const {}
    __device__ __forceinline__ void done(const Unit&) const {}
};
template <class Epi, class Sched, class GemmX, bool ALIGN_EPI = false, bool SP2 = false>
__device__ __forceinline__ void gemm_phase(PG8_LAS unsigned char* lds, const GemmX g, const Sched& S, const Epi& E, const int tid) {
    const int wid = __builtin_amdgcn_readfirstlane(tid >> 6), lane = tid & 63, wr = wid >> 2, wc = wid & 3, fr = lane & 15, fq = lane >> 4;
    constexpr int K = GemmX::K, nt = K / BK;
    unsigned voffA[2], voffB[2];
#pragma unroll
    for (int i = 0; i < 2; ++i) { int R, C; stage_rc(tid * 16 + i * 8192, R, C); const int Rb = Epi::PERM ? ((R & ~31) + perm32(R & 31)) : R;
        voffA[i] = (unsigned)(R * GemmX::lda + C) * 2u; voffB[i] = (unsigned)(Rb * GemmX::ldb + C) * 2u; }
    constexpr size_t kstep = (size_t)(BK * 2);
    constexpr size_t hstepA = (size_t)HALF * GemmX::lda * 2, hstepB = (size_t)HALF * GemmX::ldb * 2;
    constexpr size_t tstepA = 2 * hstepA, tstepB = 2 * hstepB;
    const unsigned ldsw = (unsigned)wid * 1024u;
    const int aoff = lds_byte(wr * 64 + fr, fq * 8), boff = lds_byte(wc * 32 + fr, fq * 8);
#define PG8_SA(b, h) (((b) * 2 + (h)) * HTB)
#define PG8_SB(b, h) ((4 + (b) * 2 + (h)) * HTB)
#define PG8_STAGE(bufoff, gbase, voff) do { _Pragma("unroll") for (int _i = 0; _i < 2; ++_i) \
        __builtin_amdgcn_global_load_lds((const unsigned*)((const char*)(gbase) + (voff)[_i]), (PG8_LAS unsigned*)(lds + (bufoff) + ldsw + _i * 8192), 16, 0, 0); } while (0)
#define PG8_LDA(dst, b, h) do { _Pragma("unroll") for (int m = 0; m < 4; ++m) _Pragma("unroll") for (int k = 0; k < 2; ++k) dst[m][k] = *(const PG8_LAS bf16x8*)(lds + PG8_SA(b, h) + aoff + m * 2048 + k * 1024); } while (0)
#define PG8_LDB(dst, b, h) do { _Pragma("unroll") for (int n = 0; n < 2; ++n) _Pragma("unroll") for (int k = 0; k < 2; ++k) dst[n][k] = *(const PG8_LAS bf16x8*)(lds + PG8_SB(b, h) + boff + n * 2048 + k * 1024); } while (0)
#define PG8_MMA(ai, bj, At, Bt) do { __builtin_amdgcn_s_setprio(1); _Pragma("unroll") for (int m = 0; m < 4; ++m) _Pragma("unroll") for (int n = 0; n < 2; ++n) _Pragma("unroll") for (int k = 0; k < 2; ++k) \
        acc[ai][bj][m][n] = __builtin_amdgcn_mfma_f32_16x16x32_bf16(Bt[n][k], At[m][k], acc[ai][bj][m][n], 0, 0, 0); __builtin_amdgcn_s_setprio(0); } while (0)
#define PG8_WAIT_V(n) asm volatile("s_waitcnt vmcnt(" #n ")" ::: "memory")
#define PG8_WAIT_L(n) asm volatile("s_waitcnt lgkmcnt(" #n ")" ::: "memory")
#define PG8_BAR __builtin_amdgcn_s_barrier()
#define PG8_SCHED __builtin_amdgcn_sched_barrier(0)
    Unit cur, nxt; int ui = 0;
    if (!S.next(0, cur)) return;
    f32x4 acc[2][2][4][2];
#pragma unroll
    for (int a = 0; a < 2; ++a)
#pragma unroll
        for (int b = 0; b < 2; ++b)
#pragma unroll
            for (int m = 0; m < 4; ++m)
#pragma unroll
                for (int n = 0; n < 2; ++n) acc[a][b][m][n] = (f32x4){0.f, 0.f, 0.f, 0.f};
    bf16x8 At[4][2], B0[2][2], B1[2][2];
    const char* cA = (const char*)g.A + (size_t)cur.pm * tstepA; const char* cB = (const char*)g.Bt + (size_t)cur.pn * tstepB;
    S.a_ready(cur);
    if constexpr (SP2) {
        PG8_STAGE(PG8_SB(0, 0), cB, voffB); PG8_STAGE(PG8_SB(0, 1), cB + hstepB, voffB); PG8_STAGE(PG8_SA(0, 0), cA, voffA); PG8_STAGE(PG8_SA(0, 1), cA + hstepA, voffA);
        if (wr == 1) PG8_BAR;
        PG8_WAIT_V(2); PG8_BAR;
        PG8_STAGE(PG8_SB(1, 0), cB + kstep, voffB); PG8_STAGE(PG8_SA(1, 0), cA + kstep, voffA); PG8_STAGE(PG8_SB(1, 1), cB + hstepB + kstep, voffB);
        PG8_WAIT_V(6); PG8_BAR;
    } else {
        PG8_STAGE(PG8_SB(0, 0), cB, voffB); PG8_STAGE(PG8_SA(0, 0), cA, voffA); PG8_STAGE(PG8_SB(0, 1), cB + hstepB, voffB); PG8_STAGE(PG8_SA(0, 1), cA + hstepA, voffA);
        if (wr == 1) PG8_BAR;
        PG8_WAIT_V(4); PG8_BAR;
        PG8_STAGE(PG8_SB(1, 0), cB + kstep, voffB); PG8_STAGE(PG8_SA(1, 0), cA + kstep, voffA); PG8_STAGE(PG8_SB(1, 1), cB + hstepB + kstep, voffB);
        PG8_WAIT_V(6); PG8_BAR;
    }
    for (;;) {
        const bool has_next = S.next(ui + 1, nxt);
        const char* nA = has_next ? (const char*)g.A + (size_t)nxt.pm * tstepA : cA; const char* nB = has_next ? (const char*)g.Bt + (size_t)nxt.pn * tstepB : cB;
        for (int t = 0; t < nt; t += 2) {
            const bool last = (t == nt - 2);
            const char* a1 = cA + (size_t)(t + 1) * kstep;
            const char* a2 = last ? nA : cA + (size_t)(t + 2) * kstep; const char* b2 = last ? nB : cB + (size_t)(t + 2) * kstep;
            const char* a3 = a2 + kstep; const char* b3 = b2 + kstep;
            if (last && has_next) S.a_ready(nxt);
            if constexpr (SP2) {
            PG8_LDB(B0, 0, 0); PG8_LDB(B1, 0, 1); PG8_SCHED; PG8_LDA(At, 0, 0); PG8_STAGE(PG8_SA(1, 1), a1 + hstepA, voffA);
            PG8_WAIT_V(8); PG8_WAIT_L(0); PG8_BAR; PG8_MMA(0, 0, At, B0); PG8_MMA(0, 1, At, B1); PG8_BAR; PG8_SCHED;
            PG8_LDA(At, 0, 1); PG8_STAGE(PG8_SB(0, 0), b2, voffB); PG8_STAGE(PG8_SB(0, 1), b2 + hstepB, voffB); PG8_STAGE(PG8_SA(0, 0), a2, voffA);
            PG8_WAIT_V(8); PG8_WAIT_L(0); PG8_BAR; PG8_MMA(1, 0, At, B0); PG8_MMA(1, 1, At, B1); PG8_BAR; PG8_SCHED;
            PG8_LDB(B0, 1, 0); PG8_LDB(B1, 1, 1); PG8_SCHED; PG8_LDA(At, 1, 0); PG8_STAGE(PG8_SA(0, 1), a2 + hstepA, voffA);
            PG8_WAIT_V(8); PG8_WAIT_L(0); PG8_BAR; PG8_MMA(0, 0, At, B0); PG8_MMA(0, 1, At, B1); PG8_BAR; PG8_SCHED;
            PG8_LDA(At, 1, 1); PG8_STAGE(PG8_SB(1, 0), b3, voffB); PG8_STAGE(PG8_SB(1, 1), b3 + hstepB, voffB); PG8_STAGE(PG8_SA(1, 0), a3, voffA);
            PG8_WAIT_V(8); PG8_WAIT_L(0); PG8_BAR; PG8_MMA(1, 0, At, B0); PG8_MMA(1, 1, At, B1); PG8_BAR; PG8_SCHED;
            } else {
            PG8_LDB(B0, 0, 0); PG8_SCHED; PG8_LDA(At, 0, 0); PG8_STAGE(PG8_SA(1, 1), a1 + hstepA, voffA);
            PG8_WAIT_L(8); PG8_BAR; PG8_WAIT_L(0); PG8_MMA(0, 0, At, B0); PG8_BAR; PG8_SCHED;
            PG8_LDB(B1, 0, 1); PG8_STAGE(PG8_SB(0, 0), b2, voffB);
            PG8_BAR; PG8_WAIT_L(0); PG8_MMA(0, 1, At, B1); PG8_BAR;
            PG8_LDA(At, 0, 1); PG8_STAGE(PG8_SA(0, 0), a2, voffA);
            PG8_BAR; PG8_WAIT_L(0); PG8_MMA(1, 0, At, B0); PG8_BAR; PG8_SCHED;
            PG8_STAGE(PG8_SB(0, 1), b2 + hstepB, voffB);
            PG8_WAIT_V(6); PG8_BAR; PG8_MMA(1, 1, At, B1); PG8_BAR;
            PG8_LDB(B0, 1, 0); PG8_SCHED; PG8_LDA(At, 1, 0); PG8_STAGE(PG8_SA(0, 1), a2 + hstepA, voffA);
            PG8_WAIT_L(8); PG8_BAR; PG8_WAIT_L(0); PG8_MMA(0, 0, At, B0); PG8_BAR; PG8_SCHED;
            PG8_LDB(B1, 1, 1); PG8_STAGE(PG8_SB(1, 0), b3, voffB);
            PG8_BAR; PG8_WAIT_L(0); PG8_MMA(0, 1, At, B1); PG8_BAR;
            PG8_LDA(At, 1, 1); PG8_STAGE(PG8_SA(1, 0), a3, voffA);
            PG8_BAR; PG8_WAIT_L(0); PG8_MMA(1, 0, At, B0); PG8_BAR; PG8_SCHED;
            PG8_STAGE(PG8_SB(1, 1), b3 + hstepB, voffB);
            PG8_WAIT_V(6); PG8_BAR; PG8_MMA(1, 1, At, B1); PG8_BAR;
            }
        }
        if constexpr (ALIGN_EPI) { if (wr == 0) PG8_BAR; }
        if constexpr (!Epi::AFTER_DRAIN) { E(acc, cur, wr, wc, fr, fq); S.done(cur); }
        if (!has_next) break;
#pragma unroll
        for (int a = 0; a < 2; ++a)
#pragma unroll
            for (int b = 0; b < 2; ++b)
#pragma unroll
                for (int m = 0; m < 4; ++m)
#pragma unroll
                    for (int n = 0; n < 2; ++n) acc[a][b][m][n] = (f32x4){0.f, 0.f, 0.f, 0.f};
        cur = nxt; cA = nA; cB = nB; ++ui;
        if constexpr (ALIGN_EPI) { if (wr == 1) PG8_BAR; }
    }
    PG8_WAIT_V(0);
    if constexpr (!ALIGN_EPI) { if (wr == 0) PG8_BAR; }
    PG8_BAR;
    if constexpr (Epi::AFTER_DRAIN) { E.fused(acc, cur, wr, wc, fr, fq, lds, wid, lane); S.done(cur); }
#undef PG8_SA
#undef PG8_SB
#undef PG8_STAGE
#undef PG8_LDA
#undef PG8_LDB
#undef PG8_MMA
#undef PG8_WAIT_V
#undef PG8_WAIT_L
#undef PG8_BAR
#undef PG8_SCHED
}
}
namespace pg8 {
__device__ __forceinline__ unsigned cvt_pk_bf16(float lo, float hi) { unsigned r; asm volatile("v_cvt_pk_bf16_f32 %0, %1, %2" : "=v"(r) : "v"(lo), "v"(hi)); return r; }
DI int tile_mb(int pm) { return pm < 16 ? 4 : ((pm - 16) >> 4); }
struct EpiProj {
    static constexpr bool PERM = true, AFTER_DRAIN = false;
    int l;
    __device__ __forceinline__ void operator()(const f32x4 (&acc)[2][2][4][2], const Unit& u, int wr, int wc, int fr, int fq) const {
        KPc kp = (KPc)__builtin_amdgcn_kernarg_segment_ptr(); asm volatile("" : "+s"(kp));
        unsigned char* ws = kp->ws; bf16_t* O = (bf16_t*)(ws + WS_R1); const float* RSS = (const float*)(ws + WS_RSSP1);
        const int row0 = u.pm * BM + wr * 64 + fr, col0 = u.pn * BM + wc * 32 + 8 * fq;
        const float* sw = (const float*)(ws + WS_SWIN) + (size_t)(l * 5 + tile_mb(u.pm)) * IN_COLS;
        if (u.pn == 14) {
            if (wc == 0) {
                float* LOGIT = (float*)(ws + WS_LOGIT); const int lane = fr + 16 * fq;
                const f32x4 s0 = *(const f32x4*)(sw + 2048 + 8 * (fq & 1)), s1 = *(const f32x4*)(sw + 2048 + 8 * (fq & 1) + 4);
#pragma unroll
                for (int ai = 0; ai < 2; ++ai)
#pragma unroll
                    for (int m = 0; m < 4; ++m) { const int r = row0 + ai * HALF + m * 16; const float rstd = rsqrtf(rss_read(RSS, r) * (1.f / D) + EPS);
                        f32x4 v0 = acc[ai][0][m][0], v1 = acc[ai][0][m][1];
#pragma unroll
                        for (int e = 0; e < 4; ++e) { v0[e] += shx(v0[e], 32, lane); v1[e] += shx(v1[e], 32, lane); }
                        if (fq < 2) { *(f32x4*)(LOGIT + (size_t)r * 16 + 8 * fq) = v0 * rstd + s0; *(f32x4*)(LOGIT + (size_t)r * 16 + 8 * fq + 4) = v1 * rstd + s1; } }
            }
            return;
        }
        f32x4 bv[2][2];
#pragma unroll
        for (int bj = 0; bj < 2; ++bj)
#pragma unroll
            for (int n = 0; n < 2; ++n) { const int cc = col0 + bj * HALF + 4 * n; bv[bj][n] = *(const f32x4*)(sw + (cc >= 2048 ? cc + 16 : cc)); }
#pragma unroll
        for (int ai = 0; ai < 2; ++ai)
#pragma unroll
            for (int m = 0; m < 4; ++m) { const int r = row0 + ai * HALF + m * 16; const float rstd = rsqrtf(rss_read(RSS, r) * (1.f / D) + EPS); bf16_t* rowp = O + (size_t)r * NP + col0;
#pragma unroll
                for (int bj = 0; bj < 2; ++bj) { const f32x4 v0 = acc[ai][bj][m][0] * rstd + bv[bj][0], v1 = acc[ai][bj][m][1] * rstd + bv[bj][1];
                    u32x4 w; w.x = cvt_pk_bf16(v0[0], v0[1]); w.y = cvt_pk_bf16(v0[2], v0[3]); w.z = cvt_pk_bf16(v1[0], v1[1]); w.w = cvt_pk_bf16(v1[2], v1[3]);
                    *(u32x4*)(rowp + bj * HALF) = w; } }
    }
};
struct EpiH {
    static constexpr bool PERM = true, AFTER_DRAIN = false;
    int l;
    __device__ __forceinline__ void operator()(const f32x4 (&acc)[2][2][4][2], const Unit& u, int wr, int wc, int fr, int fq) const {
        KPc kp = (KPc)__builtin_amdgcn_kernarg_segment_ptr(); asm volatile("" : "+s"(kp));
        unsigned char* ws = kp->ws; bf16_t* O = (bf16_t*)(ws + WS_R1); const float* RSS = (const float*)(ws + WS_RSSP2);
        const int row0 = u.pm * BM + wr * 64 + fr, col0 = u.pn * BM + wc * 32 + 8 * fq;
        const float* sw = (const float*)(ws + WS_SW1) + (size_t)(l * 5 + tile_mb(u.pm)) * FF;
        f32x4 bv[2][2];
#pragma unroll
        for (int bj = 0; bj < 2; ++bj)
#pragma unroll
            for (int n = 0; n < 2; ++n) bv[bj][n] = *(const f32x4*)(sw + col0 + bj * HALF + 4 * n);
#pragma unroll
        for (int ai = 0; ai < 2; ++ai)
#pragma unroll
            for (int m = 0; m < 4; ++m) { const int r = row0 + ai * HALF + m * 16; const float rstd = rsqrtf(rss_read(RSS, r) * (1.f / D) + EPS); bf16_t* rowp = O + (size_t)r * FF + col0;
#pragma unroll
                for (int bj = 0; bj < 2; ++bj) { f32x4 v0 = acc[ai][bj][m][0] * rstd + bv[bj][0], v1 = acc[ai][bj][m][1] * rstd + bv[bj][1];
                    v0 = __builtin_elementwise_max(v0, (f32x4){0.f, 0.f, 0.f, 0.f}); v1 = __builtin_elementwise_max(v1, (f32x4){0.f, 0.f, 0.f, 0.f}); v0 = v0 * v0; v1 = v1 * v1;
                    u32x4 w; w.x = cvt_pk_bf16(v0[0], v0[1]); w.y = cvt_pk_bf16(v0[2], v0[3]); w.z = cvt_pk_bf16(v1[0], v1[1]); w.w = cvt_pk_bf16(v1[2], v1[3]);
                    *(u32x4*)(rowp + bj * HALF) = w; } }
    }
};
template <int WHICH>
struct EpiRes {
    static constexpr bool PERM = true, AFTER_DRAIN = false;
    int l;
    struct Cols { f32x4 gt[2][2], gs[2][2]; float* X; const float* Xin; bf16_t* An; float* RSS; bool has_next; int row0, col0, pn, wc; };
    __device__ __forceinline__ void prepare(Cols& q, const Unit& u, int wr, int wc, int fr, int fq) const {
        KPc kp = (KPc)__builtin_amdgcn_kernarg_segment_ptr(); asm volatile("" : "+s"(kp));
        unsigned char* ws = kp->ws; q.X = kp->out; const float* MOD = (const float*)(ws + WS_MOD);
        q.Xin = (WHICH == 1 && l == 0) ? (u.pm < 16 ? kp->in[0] : kp->in[1] - (size_t)NCTX * D) : (const float*)kp->out;
        q.has_next = (WHICH == 1) || (l + 1 < DEPTH); const int ln = (WHICH == 1) ? l : (q.has_next ? l + 1 : l);
        const int mb = tile_mb(u.pm);
        const float* gateb = MOD + (size_t)(l * 5 + mb) * 6144 + (WHICH == 1 ? 2 : 5) * 1024;
        const float* scaleb = MOD + (size_t)(ln * 5 + mb) * 6144 + (WHICH == 1 ? 4 : 1) * 1024;
        const float* ng = (WHICH == 1 ? kp->in[8] : kp->in[7]) + ln * 1024;
        q.An = (bf16_t*)(ws + WS_A); q.RSS = (float*)(ws + (WHICH == 1 ? WS_RSSP2 : WS_RSSP1));
        q.row0 = u.pm * BM + wr * 64 + fr; q.col0 = u.pn * BM + wc * 32 + 8 * fq; q.pn = u.pn; q.wc = wc;
#pragma unroll
        for (int bj = 0; bj < 2; ++bj)
#pragma unroll
            for (int n = 0; n < 2; ++n) { const int cc = q.col0 + bj * HALF + 4 * n; q.gt[bj][n] = *(const f32x4*)(gateb + cc);
                q.gs[bj][n] = *(const f32x4*)(ng + cc) * (*(const f32x4*)(scaleb + cc) + 1.0f); }
    }
    __device__ __forceinline__ void rowgroup(const Cols& q, int ai, int m, const f32x4 (&v)[2][2], int fr, int fq) const {
        const int r = q.row0 + ai * HALF + m * 16; float* xp = q.X + (size_t)r * D + q.col0; const float* xi = q.Xin + (size_t)r * D + q.col0; float ss = 0.f;
#pragma unroll
        for (int bj = 0; bj < 2; ++bj) { f32x4 x0 = *(const f32x4*)(xi + bj * HALF), x1 = *(const f32x4*)(xi + bj * HALF + 4);
            x0 = x0 + q.gt[bj][0] * v[bj][0]; x1 = x1 + q.gt[bj][1] * v[bj][1];
            *(f32x4*)(xp + bj * HALF) = x0; *(f32x4*)(xp + bj * HALF + 4) = x1;
            ss += (x0[0] * x0[0] + x0[1] * x0[1]) + (x0[2] * x0[2] + x0[3] * x0[3]) + (x1[0] * x1[0] + x1[1] * x1[1]) + (x1[2] * x1[2] + x1[3] * x1[3]);
            if (q.has_next) { const f32x4 a0 = x0 * q.gs[bj][0], a1 = x1 * q.gs[bj][1];
                u32x4 w; w.x = cvt_pk_bf16(a0[0], a0[1]); w.y = cvt_pk_bf16(a0[2], a0[3]); w.z = cvt_pk_bf16(a1[0], a1[1]); w.w = cvt_pk_bf16(a1[2], a1[3]);
                *(u32x4*)(q.An + (size_t)r * D + q.col0 + bj * HALF) = w; } }
        ss += shx(ss, 16, fr + 16 * fq); ss += shx(ss, 32, fr + 16 * fq);
        if (fq == 0) q.RSS[(size_t)r * 16 + q.pn * 4 + q.wc] = ss;
    }
    __device__ __forceinline__ void operator()(const f32x4 (&acc)[2][2][4][2], const Unit& u, int wr, int wc, int fr, int fq) const {
        Cols q; prepare(q, u, wr, wc, fr, fq);
#pragma unroll
        for (int ai = 0; ai < 2; ++ai)
#pragma unroll
            for (int m = 0; m < 4; ++m) { const f32x4 v[2][2] = {{acc[ai][0][m][0], acc[ai][0][m][1]}, {acc[ai][1][m][0], acc[ai][1][m][1]}};
                rowgroup(q, ai, m, v, fr, fq);
                if (m & 1) asm volatile("" ::: "memory"); }
    }
};
struct FirstRoundOrder {
    int c;
    __device__ __forceinline__ bool next(int i, Unit& u) const { if (i > 0) return false; StaticOrderT<1024> S{256, c}; return S.next(0, u); }
    __device__ __forceinline__ void a_ready(const Unit&) const {}
    __device__ __forceinline__ void done(const Unit&) const {}
};
struct TailOrder {
    int c;
    __device__ __forceinline__ bool next(int i, Unit& u) const { if (i > 0) return false; StaticOrderT<1024> S{256, c >> 2}; return S.next(1, u); }
    __device__ __forceinline__ void a_ready(const Unit&) const {}
    __device__ __forceinline__ void done(const Unit&) const {}
};
struct EpiSlab {
    static constexpr bool PERM = true, AFTER_DRAIN = false;
    float* slab; int tid;
    __device__ __forceinline__ void operator()(const f32x4 (&acc)[2][2][4][2], const Unit&, int, int, int, int) const {
        f32x4* p = (f32x4*)slab + tid;
#pragma unroll
        for (int ai = 0; ai < 2; ++ai)
#pragma unroll
            for (int bj = 0; bj < 2; ++bj)
#pragma unroll
                for (int m = 0; m < 4; ++m)
#pragma unroll
                    for (int n = 0; n < 2; ++n) p[(((ai * 2 + bj) * 4 + m) * 2 + n) * 512] = acc[ai][bj][m][n];
    }
};
}

constexpr int NPL = 3840;
constexpr size_t WT_IN = WS_WT, WT_OUT = WS_WT + 8 * MiB, WT_1 = WS_WT + 10 * MiB, WT_2 = WS_WT + 18 * MiB;

template <int EPI>
DI void phase_gemm_fast(const Ctx& c, int l) {
    if (EPI == EPI_PROJ) {
        pg8::GemmT<NPL, D, D> g{(const bf16*)(c.ws + WS_A), (const bf16*)(c.ws + WT_IN)}; pg8::StaticOrderT<NPL> S{c.G, c.bid}; pg8::EpiProj E{l};
        pg8::gemm_phase<pg8::EpiProj, pg8::StaticOrderT<NPL>, pg8::GemmT<NPL, D, D>, true, true>(c.lds, g, S, E, c.tid);
    } else if (EPI == EPI_H) {
        pg8::GemmT<FF, D, D> g{(const bf16*)(c.ws + WS_A), (const bf16*)(c.ws + WT_1)}; pg8::StaticOrderT<FF> S{c.G, c.bid}; pg8::EpiH E{l};
        pg8::gemm_phase<pg8::EpiH, pg8::StaticOrderT<FF>, pg8::GemmT<FF, D, D>, true, true>(c.lds, g, S, E, c.tid);
    } else if (EPI == EPI_RES1) {
        pg8::GemmT<D, D, NP> g{(const bf16*)(c.ws + WS_R1) + 2560, (const bf16*)(c.ws + WT_OUT)}; pg8::StaticOrderT<D> S{c.G, c.bid}; pg8::EpiRes<1> E{l};
        pg8::gemm_phase<pg8::EpiRes<1>, pg8::StaticOrderT<D>, pg8::GemmT<D, D, NP>, true, true>(c.lds, g, S, E, c.tid);
    } else {
        pg8::GemmT<D, FF, FF> g{(const bf16*)(c.ws + WS_R1), (const bf16*)(c.ws + WT_2)}; pg8::StaticOrderT<D> S{c.G, c.bid}; pg8::EpiRes<2> E{l};
        pg8::gemm_phase<pg8::EpiRes<2>, pg8::StaticOrderT<D>, pg8::GemmT<D, FF, FF>, true, true>(c.lds, g, S, E, c.tid);
    }
}

constexpr size_t WS_SLAB = WS_QKVN;
DI void phase_g4_main(const Ctx& c, int l) {
    { pg8::GemmT<D, FF, FF> g{(const bf16*)(c.ws + WS_R1), (const bf16*)(c.ws + WT_2)}; pg8::FirstRoundOrder S{c.bid}; pg8::EpiRes<2> E{l};
      pg8::gemm_phase<pg8::EpiRes<2>, pg8::FirstRoundOrder, pg8::GemmT<D, FF, FF>, true, true>(c.lds, g, S, E, c.tid); }
    { const int kq = c.bid & 3;
      pg8::GemmT<D, 1024, FF, FF> g{(const bf16*)(c.ws + WS_R1) + kq * 1024, (const bf16*)(c.ws + WT_2) + kq * 1024}; pg8::TailOrder S{c.bid};
      pg8::EpiSlab E{(float*)(c.ws + WS_SLAB) + (size_t)c.bid * 65536, c.tid};
      pg8::gemm_phase<pg8::EpiSlab, pg8::TailOrder, pg8::GemmT<D, 1024, FF, FF>, true, true>(c.lds, g, S, E, c.tid); }
}
DI void phase_g4_combine(const Ctx& c, int l) {
    pg8::Unit u; { pg8::StaticOrderT<1024> S{256, c.bid >> 2}; S.next(1, u); }
    const char* ub = (const char*)(c.ws + WS_SLAB) + (size_t)(c.bid >> 2) * 4 * 262144;
    const unsigned lo = (unsigned)c.tid * 16u;
    const int wid = c.wave, lane = c.tid & 63, fr = lane & 15, fq = lane >> 4, part = c.bid & 3;
    pg8::EpiRes<2> E{l}; pg8::EpiRes<2>::Cols q; E.prepare(q, u, wid >> 2, wid & 3, fr, fq);
    f32x4 v[2][2][2];
#pragma unroll
    for (int g2 = 0; g2 < 2; ++g2) { const int rg = part * 2 + g2;
#pragma unroll
        for (int bj = 0; bj < 2; ++bj)
#pragma unroll
            for (int n = 0; n < 2; ++n) { const int e = ((((rg >> 2) * 2 + bj) * 4 + (rg & 3)) * 2 + n) * 8192;
                const f32x4 a0 = *(const f32x4*)(ub + e + lo), a1 = *(const f32x4*)(ub + 262144 + e + lo), a2 = *(const f32x4*)(ub + 2 * 262144 + e + lo), a3 = *(const f32x4*)(ub + 3 * 262144 + e + lo);
                v[g2][bj][n] = (a0 + a1) + (a2 + a3); } }
#pragma unroll
    for (int g2 = 0; g2 < 2; ++g2) { const int rg = part * 2 + g2; E.rowgroup(q, rg >> 2, rg & 3, v[g2], fr, fq); }
}

DI void wconv_item(const float* W, int ldw, int K, int nblk, bf16* WT, LAS float* scr, int item, int lane, bool remap) {
    const int kb = item / nblk, nb = item % nblk, k0 = 64 * kb, n0 = 32 * nb; const int ns = (remap && n0 >= 2048) ? n0 + 16 : n0;
    { const int rr = lane >> 3, c4 = (lane & 7) * 4;
        f32x4 v[8];
#pragma unroll
        for (int i = 0; i < 8; ++i) v[i] = *(const f32x4*)(W + (size_t)(k0 + rr + 8 * i) * ldw + ns + c4);
#pragma unroll
        for (int i = 0; i < 8; ++i) { LAS float* sp = scr + (rr + 8 * i) * 33 + c4; sp[0] = v[i][0]; sp[1] = v[i][1]; sp[2] = v[i][2]; sp[3] = v[i][3]; } }
    asm volatile("s_waitcnt lgkmcnt(0)" ::: "memory");
    const int cch = lane & 7;
#pragma unroll
    for (int j = 0; j < 4; ++j) { const int n = (lane >> 3) + 8 * j; const LAS float* sp = scr + (8 * cch) * 33 + n;
        u32x4 o; o.x = pk2(sp[0 * 33], sp[1 * 33]); o.y = pk2(sp[2 * 33], sp[3 * 33]); o.z = pk2(sp[4 * 33], sp[5 * 33]); o.w = pk2(sp[6 * 33], sp[7 * 33]);
        *(u32x4*)(WT + (size_t)(n0 + n) * K + k0 + 8 * cch) = o; }
    asm volatile("s_waitcnt lgkmcnt(0)" ::: "memory");
}
DI void wconv_logit_item(const Ctx& c, int l, int kb) {
    const float* W = c.in[9] + (size_t)l * D * IN_COLS + 2048; bf16* WT = (bf16*)(c.ws + WT_IN);
    const int n = c.lane & 31, kh = c.lane >> 5, k0 = 64 * kb + 32 * kh;
    unsigned pk[16];
#pragma unroll
    for (int i = 0; i < 16; ++i) { const float x0 = W[(size_t)(k0 + 2 * i) * IN_COLS + (n & 15)], x1 = W[(size_t)(k0 + 2 * i + 1) * IN_COLS + (n & 15)];
        const bf16 h0 = f2bf(x0), h1 = f2bf(x1);
        pk[i] = n < 16 ? ((unsigned)h0 | ((unsigned)h1 << 16)) : pk2(x0 - bf2f(h0), x1 - bf2f(h1)); }
    u32x4* dst = (u32x4*)(WT + (size_t)(NP + n) * D + k0);
#pragma unroll
    for (int q = 0; q < 4; ++q) { u32x4 o; o.x = pk[4 * q]; o.y = pk[4 * q + 1]; o.z = pk[4 * q + 2]; o.w = pk[4 * q + 3]; dst[q] = o; }
}
DI void wconv_zero_rows(const Ctx& c) {
    u32x4* z = (u32x4*)((bf16*)(c.ws + WT_IN) + (size_t)(NP + 32) * D); const u32x4 zero4 = {0u, 0u, 0u, 0u};
    for (int i = c.bid * NTHR + c.tid; i < (NPL - NP - 32) * D / 8; i += c.G * NTHR) z[i] = zero4;
}
DI void wconv_wave_item(const Ctx& c, int l, int set, int r) {
    LAS float* scr = (LAS float*)(c.lds + c.wave * 16384);
    if (set == 0) { if (r < 16 * 112) wconv_item(c.in[9] + (size_t)l * D * IN_COLS, IN_COLS, D, 112, (bf16*)(c.ws + WT_IN), scr, r, c.lane, true); else if (r < 16 * 112 + 16) wconv_logit_item(c, l, r - 16 * 112); return; }
    constexpr int I_OUT = 16 * 32, I_1 = 16 * 128, I_2 = 64 * 32;
    if (r < I_OUT) { wconv_item(c.in[23] + (size_t)l * D * D, D, D, 32, (bf16*)(c.ws + WT_OUT), scr, r, c.lane, false); return; } r -= I_OUT;
    if (r < I_1) { wconv_item(c.in[24] + (size_t)l * D * FF, FF, D, 128, (bf16*)(c.ws + WT_1), scr, r, c.lane, false); return; } r -= I_1;
    if (r < I_2) wconv_item(c.in[25] + (size_t)l * FF * D, D, FF, 32, (bf16*)(c.ws + WT_2), scr, r, c.lane, false);
}
constexpr int WC_BLK_IN = 226, WC_BLK_REST = 576;
DI void phase_wconv_in(const Ctx& c, int l) {
    for (int bi = c.bid; bi < WC_BLK_IN; bi += c.G) wconv_wave_item(c, l, 0, bi * 8 + c.wave);
    wconv_zero_rows(c);
    __syncthreads();
}
DI void phase_zero(const Ctx& c, size_t off, int nfloats) {
    float* p = (float*)(c.ws + off);
    for (int i = c.bid * NTHR + c.tid; i < nfloats; i += c.G * NTHR) p[i] = 0.f;
}

DI void seg_of_row(int r, int& s0, int& s1) { if (r < NCTX) { s0 = r & ~255; s1 = s0 + 256; } else { s0 = r & ~63; s1 = s0 + 64; } }

DI void phase_prep_naive(const Ctx& c, int l) {
    const bf16* PROJ = (const bf16*)(c.ws + WS_R1);
    bf16* QKVN = (bf16*)(c.ws + WS_QKVN);
    const float* cw = c.in[10] + (size_t)l * 5 * 1536;
    const float* a_log = c.in[11] + l * 8; const float* dt_bias = c.in[12] + l * 8;
    const float* LOGIT = (const float*)(c.ws + WS_LOGIT);
    float* GBG = (float*)(c.ws + WS_GBG); float* GBB = (float*)(c.ws + WS_GBB);
    const int gw = c.bid * NWAVES + c.wave, NGW = c.G * NWAVES;
    for (int task = gw; task < NTOK * 4; task += NGW) {
        const int r = task >> 2, h = task & 3; int s0, s1; seg_of_row(r, s0, s1);
#pragma unroll
        for (int p = 0; p < 3; ++p) {
            const int col = p * 512 + h * 128 + 2 * c.lane;
            float y0 = 0.f, y1 = 0.f;
#pragma unroll
            for (int j = 0; j < 5; ++j) { const int rr = r + j - 2;
                if (rr >= s0 && rr < s1) { const unsigned u = *(const unsigned*)(PROJ + (size_t)rr * NP + col); const f32x2 w = *(const f32x2*)(cw + j * 1536 + col);
                    y0 += w.x * bf2f((bf16)(u & 0xffffu)); y1 += w.y * bf2f((bf16)(u >> 16)); } }
            y0 = silu_f(y0); y1 = silu_f(y1);
            if (p < 2) { const float ss = wave_sum(y0 * y0 + y1 * y1, c.lane); float sc = rsqrtf(ss + EPS); if (p == 0) sc *= 0.08838834764831845f; y0 *= sc; y1 *= sc; }
            *(unsigned*)(QKVN + (size_t)r * 1536 + col) = pk2(y0, y1);
        }
        if (c.lane < 2) { const int dir = c.lane, idx = dir * 4 + h;
            const float al = LOGIT[(size_t)r * 16 + idx], bl = LOGIT[(size_t)r * 16 + 8 + idx];
            GBG[(size_t)r * 8 + idx] = -__expf(a_log[idx]) * softplus_f(al + dt_bias[idx]);
            GBB[(size_t)r * 8 + idx] = sigmoid_f(bl); }
    }
}
DI void phase_hyprep_naive(const Ctx& c, int l) {
    const bf16* PROJ = (const bf16*)(c.ws + WS_R1);
    const float* hw = c.in[14] + (size_t)l * 3 * 1536;
    bf16* X0C = (bf16*)(c.ws + WS_X0C); bf16* ZZT = (bf16*)(c.ws + WS_ZZT);
    for (size_t i = (size_t)c.bid * NTHR + c.tid; i < (size_t)NTOK * 512; i += (size_t)c.G * NTHR) {
        const int r = (int)(i >> 9), ch = (int)(i & 511); int s0, s1; seg_of_row(r, s0, s1);
        float y[3] = {0.f, 0.f, 0.f};
#pragma unroll
        for (int j = 0; j < 3; ++j) { const int rr = r + j - 1;
            if (rr >= s0 && rr < s1) {
#pragma unroll
                for (int p = 0; p < 3; ++p) y[p] += hw[j * 1536 + p * 512 + ch] * bf2f(PROJ[(size_t)rr * NP + 2048 + p * 512 + ch]); } }
        X0C[(size_t)r * 512 + ch] = f2bf(y[0]);
        ZZT[(size_t)ch * NTOK + r] = f2bf(y[1] * y[2]);
    }
}

DI void phase_scan_naive(const Ctx& c, int l) {
    const bf16* QKVN = (const bf16*)(c.ws + WS_QKVN);
    const float* GBG = (const float*)(c.ws + WS_GBG); const float* GBB = (const float*)(c.ws + WS_GBB);
    bf16* OF = (bf16*)(c.ws + WS_OF); bf16* OB = (bf16*)(c.ws + WS_OB);
    const float* state_in = c.in[2]; float* state_out = c.out + (size_t)NTOK * D;
    constexpr int TB = 32;
    LAS float* qs = (LAS float*)c.lds;
    LAS float* ks = qs + TB * 256;
    LAS float* vs = ks + TB * 256;
    LAS float* gs = vs + TB * 256;
    LAS float* bs = gs + TB * 2;
    const int half = c.lane >> 5, dv = (c.wave & 3) * 32 + (c.lane & 31), hl = c.wave >> 2;
    for (int task = c.bid; task < 80; task += c.G) {
        const int s = task >> 2, dir = (task >> 1) & 1, hp = task & 1, h = hp * 2 + hl;
        const bool isctx = s < 16; const int L = isctx ? 256 : 4096, row0 = isctx ? s * 256 : NCTX + (s - 16) * 4096;
        float S[64];
        if (isctx) {
#pragma unroll
            for (int k = 0; k < 64; ++k) S[k] = 0.f;
        } else { const float* sp = state_in + ((((size_t)(s - 16) * 4 + l) * 2 + dir) * 4 + h) * 16384 + (size_t)(half * 64) * 128 + dv;
#pragma unroll
            for (int k = 0; k < 64; ++k) S[k] = sp[(size_t)k * 128]; }
        bf16* O = dir == 0 ? OF : OB;
        for (int i0 = 0; i0 < L; i0 += TB) {
            __syncthreads();
            { const int cc = c.tid & 255, jj = c.tid >> 8;
#pragma unroll 4
              for (int j = jj; j < TB; j += 2) { const int i = i0 + j, t = dir == 0 ? i : L - 1 - i, r = row0 + t; const bf16* src = QKVN + (size_t)r * 1536 + hp * 256 + cc;
                qs[j * 256 + cc] = bf2f(src[0]); ks[j * 256 + cc] = bf2f(src[512]); vs[j * 256 + cc] = bf2f(src[1024]); } }
            if (c.tid < TB * 2) { const int j = c.tid >> 1, hh = c.tid & 1, i = i0 + j, t = dir == 0 ? i : L - 1 - i, r = row0 + t;
                gs[c.tid] = __expf(GBG[(size_t)r * 8 + dir * 4 + hp * 2 + hh]); bs[c.tid] = GBB[(size_t)r * 8 + dir * 4 + hp * 2 + hh]; }
            __syncthreads();
            for (int j = 0; j < TB; ++j) {
                const float a = gs[j * 2 + hl], be = bs[j * 2 + hl];
                const LAS f32x4* kp = (const LAS f32x4*)(ks + j * 256 + hl * 128 + half * 64); const LAS f32x4* qp = (const LAS f32x4*)(qs + j * 256 + hl * 128 + half * 64);
                float rr = 0.f;
#pragma unroll
                for (int k4 = 0; k4 < 16; ++k4) { const f32x4 kk = kp[k4]; rr += kk.x * S[4 * k4] + kk.y * S[4 * k4 + 1] + kk.z * S[4 * k4 + 2] + kk.w * S[4 * k4 + 3]; }
                rr += shx(rr, 32, c.lane);
                const float delta = be * (vs[j * 256 + hl * 128 + dv] - a * rr);
                float o = 0.f;
#pragma unroll
                for (int k4 = 0; k4 < 16; ++k4) { const f32x4 kk = kp[k4], qq = qp[k4];
                    S[4 * k4] = a * S[4 * k4] + kk.x * delta; S[4 * k4 + 1] = a * S[4 * k4 + 1] + kk.y * delta; S[4 * k4 + 2] = a * S[4 * k4 + 2] + kk.z * delta; S[4 * k4 + 3] = a * S[4 * k4 + 3] + kk.w * delta;
                    o += qq.x * S[4 * k4] + qq.y * S[4 * k4 + 1] + qq.z * S[4 * k4 + 2] + qq.w * S[4 * k4 + 3]; }
                o += shx(o, 32, c.lane);
                const int i = i0 + j, t = dir == 0 ? i : L - 1 - i, r = row0 + t;
                if (half == 0) O[(size_t)r * 512 + h * 128 + dv] = f2bf(o);
            }
        }
        if (isctx) { float* sp = state_out + ((((size_t)s * 4 + l) * 2 + dir) * 4 + h) * 16384 + (size_t)(half * 64) * 128 + dv;
#pragma unroll
            for (int k = 0; k < 64; ++k) sp[(size_t)k * 128] = S[k]; }
    }
}

constexpr int HY_R4L = 0, HY_CSL = 8192 * 2 + 64, HY_R4C = 4 * HY_CSL, HY_CSC = 512 * 2 + 64, HY_ZL = HY_R4C + 4 * HY_CSC, HY_ZLS = (4096 + 1024) * 2 + 80 * 16 + 64  , HY_ZC = HY_ZL + 4 * HY_ZLS, HY_ZCS = (256 + 256) * 2 + 32, HY_END = HY_ZC + 16 * HY_ZCS;
static_assert(HY_END <= 146944 && HY_ZLS % 256 == 64 && HY_R4C % 16 == 0 && HY_ZL % 16 == 0 && HY_ZC % 16 == 0 && HY_ZLS % 16 == 0 && HY_ZCS % 16 == 0, "hyena LDS map");

template <int L, int NB>
DI void toep_wave(LAS const unsigned char* R4, const int cstride, LAS const unsigned char* Z, const int zstride, const int w, const int lane, bf16* outb) {
    constexpr int BPW = 32 / NB, ZPAD = (BPW == 8) ? 512 : 128;
    const int n = lane & 31, hh = lane >> 5;
    const int d_lo = 64 * BPW * w - (L - 16), d_hi = 64 * (BPW * w + BPW - 1), nst = (d_hi - d_lo) / 16 + 1;
    const int rb = n % NB, rblk = BPW * w + n / NB;
    constexpr bool PADZ = (L == 4096);
    const int E0 = ZPAD + 64 * rblk - d_lo + 8 * hh;
    const int abase = rb * zstride + E0 * 2 + (PADZ ? 16 * (E0 >> 6) : 0);
#define HY_AOFF(m) (-(32 * (m) + (PADZ ? 16 * ((m) >> 2) : 0)))
    const int Q0 = L - n - d_lo + 8 * hh, sh = Q0 & 3;
    int baddr = sh * cstride + (Q0 - sh) * 2;
    f32x16 acc0, acc1;
#pragma unroll
    for (int i = 0; i < 16; ++i) { acc0[i] = 0.f; acc1[i] = 0.f; }
#define HY_LDB(dst, off) do { const s16x4v lo_ = *(const volatile LAS s16x4v*)(R4 + baddr + (off)); const s16x4v hi_ = *(const volatile LAS s16x4v*)(R4 + baddr + (off) + 8);     dst = __builtin_shufflevector(lo_, hi_, 0, 1, 2, 3, 4, 5, 6, 7); } while (0)
    bf16x8v F[6], A[3];
    HY_LDB(F[0], 0); HY_LDB(F[1], -32); HY_LDB(F[2], -64); HY_LDB(F[3], -96); HY_LDB(F[4], -128);
    A[0] = *(const LAS bf16x8v*)(Z + abase + HY_AOFF(0)); A[1] = *(const LAS bf16x8v*)(Z + abase + HY_AOFF(1));
    baddr -= 160;
#define HY_STEP(j) do { \
        A[((j) + 2) % 3] = *(const LAS bf16x8v*)(Z + abase + HY_AOFF(k + (j) + 2));        \
        if (k + (j) + 5 <= nst + 1) HY_LDB(F[((j) + 5) % 6], 0); \
        baddr -= 32; \
        __builtin_amdgcn_sched_barrier(0); \
        acc0 = __builtin_amdgcn_mfma_f32_32x32x16_bf16(A[(j) % 3], F[(j) % 6], acc0, 0, 0, 0); \
        acc1 = __builtin_amdgcn_mfma_f32_32x32x16_bf16(A[(j) % 3], F[((j) + 2) % 6], acc1, 0, 0, 0); \
        __builtin_amdgcn_sched_barrier(0); } while (0)
    int k = 0;
    for (; k + 6 <= nst; k += 6) { HY_STEP(0); HY_STEP(1); HY_STEP(2); HY_STEP(3); HY_STEP(4); HY_STEP(5); }
    if (k + 0 < nst) HY_STEP(0);
    if (k + 1 < nst) HY_STEP(1);
    if (k + 2 < nst) HY_STEP(2);
    if (k + 3 < nst) HY_STEP(3);
    if (k + 4 < nst) HY_STEP(4);
#undef HY_STEP
#undef HY_AOFF
#undef HY_LDB
#pragma unroll
    for (int i = 0; i < 16; ++i) { const int ri = (i & 3) + 8 * (i >> 2) + 4 * hh, ob = ri % NB, oblk = BPW * w + ri / NB;
        bf16* op = outb + (size_t)ob * L + 64 * oblk + n;
        op[0] = f2bf(acc0[i]); op[32] = f2bf(acc1[i]); }
}

DI void hyena_channel(const Ctx& c, int l, int ch) {
    bf16* ZZT = (bf16*)(c.ws + WS_ZZT);
    const bf16* RL = (const bf16*)(c.ws + WS_FILT + (l & 1) * FILT_SLOT); const bf16* RC = RL + 8 * MiB / 2;
    LAS unsigned char* lds = c.lds;
    {
        { u32x4 rv[2]; u32x2 rn[2];
#pragma unroll
          for (int i = 0; i < 2; ++i) { const int p0 = (c.tid + NTHR * i) * 8; rv[i] = *(const u32x4*)(RL + (size_t)ch * 8192 + p0);
              rn[i] = (u32x2){0u, 0u}; if (p0 + 8 < 8192) rn[i] = *(const u32x2*)(RL + (size_t)ch * 8192 + p0 + 8); }
#pragma unroll
          for (int i = 0; i < 2; ++i) { const int p0 = (c.tid + NTHR * i) * 8;
              const unsigned w0 = rv[i].x, w1 = rv[i].y, w2 = rv[i].z, w3 = rv[i].w, w4 = rn[i].x, w5 = rn[i].y;
#define HY_AB(hi, lo) __builtin_amdgcn_alignbit((hi), (lo), 16u)
              *(LAS u32x4*)(lds + HY_R4L + 0 * HY_CSL + p0 * 2) = rv[i];
              *(LAS u32x4*)(lds + HY_R4L + 1 * HY_CSL + p0 * 2) = (u32x4){HY_AB(w1, w0), HY_AB(w2, w1), HY_AB(w3, w2), HY_AB(w4, w3)};
              *(LAS u32x4*)(lds + HY_R4L + 2 * HY_CSL + p0 * 2) = (u32x4){w1, w2, w3, w4};
              *(LAS u32x4*)(lds + HY_R4L + 3 * HY_CSL + p0 * 2) = (u32x4){HY_AB(w2, w1), HY_AB(w3, w2), HY_AB(w4, w3), HY_AB(w5, w4)};
#undef HY_AB
          } }
        { const int q = c.tid; const bf16 v = RC[(size_t)ch * 512 + q];
#pragma unroll
            for (int sft = 0; sft < 4; ++sft) if (q - sft >= 0) *(LAS bf16*)(lds + HY_R4C + sft * HY_CSC + (q - sft) * 2) = v; }
        const u32x4 zero4 = {0u, 0u, 0u, 0u};
        for (int i = c.tid; i < 2048; i += NTHR) { const int b = i >> 9, e = (i & 511) * 8;
            const u32x4 v = *(const u32x4*)(ZZT + (size_t)ch * NTOK + NCTX + b * 4096 + e);
            *(LAS u32x4*)(lds + HY_ZL + b * HY_ZLS + (512 + e) * 2 + 16 * ((512 + e) >> 6)) = v; }
        { const int b = c.tid >> 7, side = (c.tid >> 6) & 1, e = (c.tid & 63) * 8; const int el = side ? 512 + 4096 + e : e;
            *(LAS u32x4*)(lds + HY_ZL + b * HY_ZLS + el * 2 + 16 * (el >> 6)) = zero4; }
        { const int b = c.tid >> 5, e = (c.tid & 31) * 8;
            const u32x4 v = *(const u32x4*)(ZZT + (size_t)ch * NTOK + b * 256 + e);
            *(LAS u32x4*)(lds + HY_ZC + b * HY_ZCS + (128 + e) * 2) = v;
            const int side = (c.tid >> 4) & 1, e2 = (c.tid & 15) * 8;
            *(LAS u32x4*)(lds + HY_ZC + b * HY_ZCS + (side ? 128 + 256 + e2 : e2) * 2) = zero4; }
        __syncthreads();
        toep_wave<4096, 4>(lds + HY_R4L, HY_CSL, lds + HY_ZL, HY_ZLS, c.wave, c.lane, ZZT + (size_t)ch * NTOK + NCTX);
        if (c.wave < 2) toep_wave<256, 16>(lds + HY_R4C, HY_CSC, lds + HY_ZC, HY_ZCS, c.wave, c.lane, ZZT + (size_t)ch * NTOK);
    }
}
DI void hyprep_tile(const Ctx& c, int l, int t);
DI void scan_chain(const Ctx& c, int l, int seq, int h, int dir, int half);
DI void phase_queue(const Ctx& c, int l) {
    LAS unsigned char* lds = c.lds;
    unsigned* qhead = (unsigned*)(c.ws + WS_CTL) + 2048 + 64 * l;
    volatile LAS unsigned* qslot = (volatile LAS unsigned*)(lds + 146944 + 64);
    const bool nx = l + 1 < DEPTH;
    constexpr int N_LAT = 64, N_CTX = 256;
    constexpr int N_HP = (NTOK / 64) * 8;
    const int n_f = nx ? 68 : 0, n_wr = WC_BLK_REST, n_wi = nx ? WC_BLK_IN : 0;
    const int n_long = N_LAT + n_f + N_CTX, n_tail = 512 + n_wi;
    unsigned* hpdone = (unsigned*)(c.ws + WS_CTL) + 3072 + 64 * l;
    int my_hp = 0; bool gated = false, published = false;
    unsigned nxt = 0u; int qk = 0;
    if (c.wave == 0 && fresh_lane() == 0) nxt = __hip_atomic_fetch_add(qhead, 1u, __ATOMIC_RELAXED, __HIP_MEMORY_SCOPE_AGENT);
    for (;;) {
        if (c.wave == 0 && fresh_lane() == 0) qslot[qk] = nxt;
        __syncthreads();
        int it = (int)qslot[qk]; qk ^= 1;
        const bool long_item = it < n_long;
        if (!long_item && c.wave == 0 && fresh_lane() == 0) nxt = __hip_atomic_fetch_add(qhead, 1u, __ATOMIC_RELAXED, __HIP_MEMORY_SCOPE_AGENT);
        Ctx cq = c; { const int lq = fresh_lane(); cq.lane = lq; cq.tid = c.wave * 64 + lq; }
        if (long_item) {
            if (it >= N_LAT && it < N_LAT + n_f) filters_task(cq, l + 1, it - N_LAT);
            else { int ch, half = it & 1, seq;
                if (it < N_LAT) { ch = it >> 1; seq = 16 + (ch >> 3); } else { ch = (it - N_LAT - n_f) >> 1; seq = ch >> 3; }
                scan_chain(cq, l, seq, (ch >> 1) & 3, ch & 1, half); }
            if (c.wave == 0 && fresh_lane() == 0) nxt = __hip_atomic_fetch_add(qhead, 1u, __ATOMIC_RELAXED, __HIP_MEMORY_SCOPE_AGENT);
            continue; }
        it -= n_long;
        if (it < N_HP / 4) { hyprep_tile(cq, l, it); my_hp += 4; continue; }
        it -= N_HP / 4;
        if (!published) {
            asm volatile("s_waitcnt vmcnt(0)" ::: "memory");
            __syncthreads();
            if (cq.tid == 0 && my_hp > 0) { __builtin_amdgcn_fence(__ATOMIC_RELEASE, "agent"); asm volatile("s_waitcnt vmcnt(0)" ::: "memory");
                (void)__hip_atomic_fetch_add(hpdone, (unsigned)my_hp, __ATOMIC_RELAXED, __HIP_MEMORY_SCOPE_AGENT); }
            published = true;
        }
        if (it < n_wr) { wconv_wave_item(cq, l, 1, it * 8 + c.wave); continue; }
        it -= n_wr;
        if (!gated) {
            if (cq.tid == 0) {
                unsigned spins = 0;
                while (__hip_atomic_load(hpdone, __ATOMIC_RELAXED, __HIP_MEMORY_SCOPE_AGENT) < (unsigned)N_HP) { __builtin_amdgcn_s_sleep(8); if (++spins > (1u << 24)) break; }
                __builtin_amdgcn_fence(__ATOMIC_ACQUIRE, "agent"); asm volatile("s_waitcnt vmcnt(0)" ::: "memory");
            }
            __syncthreads();
            gated = true;
        }
        if (it >= n_tail) break;
        if (it < 512) { hyena_channel(cq, l, it); continue; } it -= 512;
        wconv_wave_item(cq, l + 1, 0, it * 8 + c.wave);
    }
}

DI void phase_hyena_out(const Ctx& c) {
    const bf16* YT = (const bf16*)(c.ws + WS_ZZT); const bf16* X0C = (const bf16*)(c.ws + WS_X0C); bf16* PROJ = (bf16*)(c.ws + WS_R1);
    LAS bf16* tile = (LAS bf16*)c.lds;
    const int chl = c.tid >> 3, e = (c.tid & 7) * 8;
    const int rl = c.tid >> 3, cg = (c.tid & 7) * 8;
    constexpr int NT = (NTOK / 64) * 8;
    u32x4 v = {0u, 0u, 0u, 0u}, xn = {0u, 0u, 0u, 0u};
    if (c.bid < NT) { const int r0 = (c.bid >> 3) * 64, ch0 = (c.bid & 7) * 64;
        v = *(const u32x4*)(YT + (size_t)(ch0 + chl) * NTOK + r0 + e); xn = *(const u32x4*)(X0C + (size_t)(r0 + rl) * 512 + ch0 + cg); }
    for (int t = c.bid; t < NT; t += c.G) {
        const int rt = t >> 3, ct = t & 7, r0 = rt * 64, ch0 = ct * 64;
        __syncthreads();
        { LAS unsigned* tp = (LAS unsigned*)(tile + chl * 66 + e); tp[0] = v.x; tp[1] = v.y; tp[2] = v.z; tp[3] = v.w; }
        const u32x4 xv = xn;
        if (t + c.G < NT) { const int t2 = t + c.G, r2 = (t2 >> 3) * 64, c2 = (t2 & 7) * 64;
            v = *(const u32x4*)(YT + (size_t)(c2 + chl) * NTOK + r2 + e); xn = *(const u32x4*)(X0C + (size_t)(r2 + rl) * 512 + c2 + cg); }
        __syncthreads();
        { const unsigned xw[4] = {xv.x, xv.y, xv.z, xv.w}; unsigned ow[4];
#pragma unroll
            for (int p = 0; p < 4; ++p) { const float y0 = bf2f(tile[(cg + 2 * p) * 66 + rl]), y1 = bf2f(tile[(cg + 2 * p + 1) * 66 + rl]);
                ow[p] = pk2(bf2f((bf16)(xw[p] & 0xffffu)) * y0, bf2f((bf16)(xw[p] >> 16)) * y1); }
            u32x4 o; o.x = ow[0]; o.y = ow[1]; o.z = ow[2]; o.w = ow[3];
            *(u32x4*)(PROJ + (size_t)(r0 + rl) * NP + 3072 + ch0 + cg) = o; }
    }
}

DI void phase_logit(const Ctx& c, int l, int wg, int nwg) {
    const float* MOD = (const float*)(c.ws + WS_MOD); const float* ng = c.in[7] + l * 1024; const float* RSS = (const float*)(c.ws + WS_RSSP1);
    float* LOGIT = (float*)(c.ws + WS_LOGIT);
    const float* w16 = c.in[9] + (size_t)l * 1024 * IN_COLS + 2048;
    LAS float* W = (LAS float*)c.lds;
    __syncthreads();
    for (int i = c.tid; i < 4096; i += NTHR) { const int k = i >> 2, qd = i & 3; const f32x4 v = *(const f32x4*)(w16 + (size_t)k * IN_COLS + qd * 4);
        *(LAS f32x4*)(W + (((k >> 8) * 4 + (k & 3)) * 64 + ((k >> 2) & 63)) * 20 + qd * 4) = v; }
    __syncthreads();
    const int lane = c.lane;
    for (int r = wg * 8 + c.wave; r < NTOK; r += nwg * 8) {
        const int mb = mod_of_row(r); const float* mrow = MOD + (size_t)(l * 5 + mb) * 6144;
        const float rstd = rsqrtf(rss_read(RSS, r) * (1.f / D) + EPS);
        float lgv[16];
#pragma unroll
        for (int q2 = 0; q2 < 16; ++q2) lgv[q2] = 0.f;
#pragma unroll
        for (int j = 0; j < 4; ++j) { const int k0 = (lane + 64 * j) * 4;
            const f32x4 xv = *(const f32x4*)(c.X + (size_t)r * D + k0), g4 = *(const f32x4*)(ng + k0), s4 = *(const f32x4*)(mrow + 1024 + k0), sh = *(const f32x4*)(mrow + k0);
            const f32x4 hn = xv * (g4 * (s4 + 1.0f)) * rstd + sh;
#pragma unroll
            for (int e = 0; e < 4; ++e) { const LAS f32x4* wp = (const LAS f32x4*)(W + ((j * 4 + e) * 64 + lane) * 20); const float hv = hn[e];
#pragma unroll
                for (int q2 = 0; q2 < 4; ++q2) { const f32x4 w4 = wp[q2]; lgv[4 * q2] += hv * w4.x; lgv[4 * q2 + 1] += hv * w4.y; lgv[4 * q2 + 2] += hv * w4.z; lgv[4 * q2 + 3] += hv * w4.w; }
                if (e & 1) asm volatile("" ::: "memory"); } }
        float a8[8], a4[4], a2[2];
        { const bool hi = lane & 1;
#pragma unroll
          for (int i = 0; i < 8; ++i) { const float keep = hi ? lgv[8 + i] : lgv[i], send = hi ? lgv[i] : lgv[8 + i]; a8[i] = keep + shx(send, 1, lane); } }
        { const bool hi = lane & 2;
#pragma unroll
          for (int i = 0; i < 4; ++i) { const float keep = hi ? a8[4 + i] : a8[i], send = hi ? a8[i] : a8[4 + i]; a4[i] = keep + shx(send, 2, lane); } }
        { const bool hi = lane & 4;
#pragma unroll
          for (int i = 0; i < 2; ++i) { const float keep = hi ? a4[2 + i] : a4[i], send = hi ? a4[i] : a4[2 + i]; a2[i] = keep + shx(send, 4, lane); } }
        float a1; { const bool hi = lane & 8; const float keep = hi ? a2[1] : a2[0], send = hi ? a2[0] : a2[1]; a1 = keep + shx(send, 8, lane); }
        a1 += shx(a1, 16, lane); a1 += shx(a1, 32, lane);
        if (lane < 16) { const int jj = 8 * (lane & 1) + 4 * ((lane >> 1) & 1) + 2 * ((lane >> 2) & 1) + ((lane >> 3) & 1); LOGIT[(size_t)r * 16 + jj] = a1; }
    }
    __syncthreads();
}

constexpr size_t WS_TM = WS_TMQK, WS_QKM = WS_TMQK + 20 * MiB;
constexpr int PF_QS = 0, PF_KS = 17408, PF_RAW = 34816, PF_CO = PF_RAW + 52224, PF_A = PF_CO + 3 * 1024, PF_ASZ = 2112 * 4;
static_assert(PF_A + 6 * PF_ASZ <= 146944, "prep LDS");
DI int prow(int r) { const int nn = r - 1, G = nn >> 2, rem = nn & 3; return r <= 0 ? 0 : (2 * G * (G + 1) + rem * (G + 1)); }
DI float wave_sum_dpp(float v) {
    v += __builtin_bit_cast(float, __builtin_amdgcn_update_dpp(0, __builtin_bit_cast(int, v), 0xB1, 0xF, 0xF, true));
    v += __builtin_bit_cast(float, __builtin_amdgcn_update_dpp(0, __builtin_bit_cast(int, v), 0x4E, 0xF, 0xF, true));
    v += __builtin_bit_cast(float, __builtin_amdgcn_update_dpp(0, __builtin_bit_cast(int, v), 0x141, 0xF, 0xF, true));
    v += __builtin_bit_cast(float, __builtin_amdgcn_update_dpp(0, __builtin_bit_cast(int, v), 0x140, 0xF, 0xF, true));
    const int iv = __builtin_bit_cast(int, v);
    return (__builtin_bit_cast(float, __builtin_amdgcn_readlane(iv, 0)) + __builtin_bit_cast(float, __builtin_amdgcn_readlane(iv, 16))) + (__builtin_bit_cast(float, __builtin_amdgcn_readlane(iv, 32)) + __builtin_bit_cast(float, __builtin_amdgcn_readlane(iv, 48)));
}
struct PrepRegs { u32x4 v[7]; float lg[4]; };
DI void prep_load(const Ctx& c, int task, int lane, PrepRegs& pr) {
    const bf16* PROJ = (const bf16*)(c.ws + WS_R1); const float* LOGIT = (const float*)(c.ws + WS_LOGIT);
    const int tidl = c.wave * 64 + lane, chunk = task >> 2, h = task & 3, r0 = chunk * 64; int s0, s1; seg_of_row(r0, s0, s1);
#pragma unroll
    for (int it = 0; it < 7; ++it) { const int u = it * NTHR + tidl;
        if (u < 68 * 48) { const int rr = u / 48, cu = u % 48, p = cu >> 4, c16 = cu & 15; const int r = r0 - 2 + rr; const bool ok = r >= s0 && r < s1;
            pr.v[it] = *(const u32x4*)(PROJ + (size_t)(ok ? r : r0) * NP + p * 512 + h * 128 + c16 * 8);
            if (!ok) pr.v[it] = (u32x4){0u, 0u, 0u, 0u}; } }
    if (c.wave == 0) { const int r = r0 + lane;
#pragma unroll
        for (int q = 0; q < 4; ++q) pr.lg[q] = LOGIT[(size_t)r * 16 + 4 * q + h]; }
}
DI void prep_task(const Ctx& c, int l, int task, int slot, int lane, PrepRegs& pr, int next_task) {
    bf16* QKVN = (bf16*)(c.ws + WS_QKVN);
    const float* cw = c.in[10] + (size_t)l * 5 * 1536;
    const float* a_log = c.in[11] + l * 8; const float* dt_bias = c.in[12] + l * 8;
    float* GBG = (float*)(c.ws + WS_GBG); float* GBB = (float*)(c.ws + WS_GBB);
    bf16* QKM = (bf16*)(c.ws + WS_QKM);
    LAS unsigned char* lds = c.lds;
    LAS float* CO = (LAS float*)(lds + PF_CO + slot * 1024);
    LAS float* Am = (LAS float*)(lds + PF_A + slot * 2 * PF_ASZ);
    const int w = c.wave, tidl = w * 64 + lane;
    const int chunk = task >> 2, h = task & 3, r0 = chunk * 64;
    __syncthreads();
#pragma unroll
    for (int it = 0; it < 7; ++it) { const int u = it * NTHR + tidl;
        if (u < 68 * 48) { const int rr = u / 48, cu = u % 48; *(LAS u32x4*)(lds + PF_RAW + rr * 768 + cu * 16) = pr.v[it]; } }
    const float lg0 = pr.lg[0], lg1 = pr.lg[1], lg2 = pr.lg[2], lg3 = pr.lg[3];
    f32x2 cwv[3][5];
#pragma unroll
    for (int p = 0; p < 3; ++p)
#pragma unroll
        for (int j = 0; j < 5; ++j) cwv[p][j] = *(const f32x2*)(cw + j * 1536 + p * 512 + h * 128 + 2 * lane);
    asm volatile("" ::: "memory");
    if (next_task >= 0) prep_load(c, next_task, lane, pr);
    if (w == 0) {
        const int r = r0 + lane;
        const float g0 = -__expf(a_log[h]) * softplus_f(lg0 + dt_bias[h]);
        const float g1 = -__expf(a_log[4 + h]) * softplus_f(lg1 + dt_bias[4 + h]);
        const float b0 = sigmoid_f(lg2), b1 = sigmoid_f(lg3);
        float x0 = g0, x1 = g1;
#pragma unroll
        for (int o = 1; o < 64; o <<= 1) { const float y0 = shi(x0, (lane - o) & 63), y1 = shi(x1, (lane + o) & 63); if (lane >= o) x0 += y0; if (lane + o < 64) x1 += y1; }
        CO[lane] = x0; CO[64 + lane] = x1; CO[128 + lane] = b0; CO[192 + lane] = b1;
        GBG[(size_t)r * 8 + h] = x0; GBG[(size_t)r * 8 + 4 + h] = x1; GBB[(size_t)r * 8 + h] = b0; GBB[(size_t)r * 8 + 4 + h] = b1;
    }
    __syncthreads();
#pragma unroll
    for (int p = 0; p < 3; ++p) {
        const int col = p * 512 + h * 128 + 2 * lane;
        float xl[12], xh[12];
#pragma unroll
        for (int i = 0; i < 12; ++i) { const unsigned u = *(const LAS unsigned*)(lds + PF_RAW + (w * 8 + i) * 768 + p * 256 + lane * 4); xl[i] = bf2f((bf16)(u & 0xffffu)); xh[i] = bf2f((bf16)(u >> 16)); }
        float y0[8], y1[8];
#pragma unroll
        for (int t = 0; t < 8; ++t) { float a0 = 0.f, a1 = 0.f;
#pragma unroll
            for (int j = 0; j < 5; ++j) { a0 += cwv[p][j].x * xl[t + j]; a1 += cwv[p][j].y * xh[t + j]; }
            y0[t] = silu_f(a0); y1[t] = silu_f(a1); }
        if (p < 2) {
            float ss[8];
#pragma unroll
            for (int t = 0; t < 8; ++t) ss[t] = wave_sum_dpp(y0[t] * y0[t] + y1[t] * y1[t]);
#pragma unroll
            for (int t = 0; t < 8; ++t) { float sc = rsqrtf(ss[t] + EPS); if (p == 0) sc *= 0.08838834764831845f; y0[t] *= sc; y1[t] *= sc; } }
#pragma unroll
        for (int t = 0; t < 8; ++t) { const int tok = w * 8 + t; const unsigned pk = pk2(y0[t], y1[t]);
            *(unsigned*)(QKVN + (size_t)(r0 + tok) * 1536 + col) = pk;
            if (p == 0) *(LAS unsigned*)(lds + PF_QS + tok * 272 + lane * 4) = pk;
            if (p == 1) *(LAS unsigned*)(lds + PF_KS + tok * 272 + lane * 4) = pk; }
    }
    __syncthreads();
    {
        const int mat = w >> 2, ti = (w >> 1) & 1, tj = w & 1, n = lane & 31, hh = lane >> 5;
        f32x16 acc;
#pragma unroll
        for (int i = 0; i < 16; ++i) acc[i] = 0.f;
        const LAS unsigned char* ap = lds + (mat ? PF_QS : PF_KS) + (32 * ti + n) * 272 + hh * 16;
        const LAS unsigned char* bp = lds + PF_KS + (32 * tj + n) * 272 + hh * 16;
#pragma unroll
        for (int ks = 0; ks < 8; ++ks) { const bf16x8v a = *(const LAS bf16x8v*)(ap + ks * 32), b = *(const LAS bf16x8v*)(bp + ks * 32);
            acc = __builtin_amdgcn_mfma_f32_32x32x16_bf16(a, b, acc, 0, 0, 0); }
        const int col = 32 * tj + n; const float gc0c = CO[col], gc1c = CO[64 + col];
        const size_t mb0 = ((size_t)(chunk * 4 + h) * 2 + 0) * 4096, mb1 = mb0 + 4096;
#pragma unroll
        for (int i = 0; i < 16; ++i) { const int row = 32 * ti + (i & 3) + 8 * (i >> 2) + 4 * hh; const float v = acc[i];
            const float d0 = __expf(CO[row] - gc0c), d1 = __expf(CO[64 + row] - gc1c);
            if (mat == 0) { if (col < row) Am[4 * prow(row) + col] = CO[128 + row] * v * d0;
                            if (col > row) Am[2112 + 4 * prow(63 - row) + (63 - col)] = CO[192 + row] * v * d1; }
            else { QKM[mb0 + row * 64 + col] = f2bf(col <= row ? v * d0 : 0.f); QKM[mb1 + (63 - row) * 64 + (63 - col)] = f2bf(col >= row ? v * d1 : 0.f); } }
    }
}
DI void prep_invert(const Ctx& c, int task, int slot, int dir, int lane) {
    bf16* TM = (bf16*)(c.ws + WS_TM);
    const LAS float* Ad = (const LAS float*)(c.lds + PF_A + (slot * 2 + dir) * PF_ASZ);
    const int chunk = task >> 2, h = task & 3;
    bf16* Tg = TM + ((size_t)(chunk * 4 + h) * 2 + dir) * 4096;
    float t[64];
    t[0] = lane == 0 ? 1.f : 0.f; Tg[lane] = f2bf(t[0]);
#pragma unroll
    for (int i = 1; i < 64; ++i) { float a0 = lane == i ? 1.f : 0.f, a1 = 0.f, a2 = 0.f, a3 = 0.f;
        const int ro = 4 * (2 * ((i - 1) >> 2) * (((i - 1) >> 2) + 1) + ((i - 1) & 3) * (((i - 1) >> 2) + 1));
#pragma unroll
        for (int j4 = 0; j4 * 4 < i; ++j4) { const f32x4 a4 = *(const LAS f32x4*)(Ad + ro + 4 * j4);
            a0 -= a4.x * t[4 * j4];
            if (4 * j4 + 1 < i) a1 -= a4.y * t[4 * j4 + 1];
            if (4 * j4 + 2 < i) a2 -= a4.z * t[4 * j4 + 2];
            if (4 * j4 + 3 < i) a3 -= a4.w * t[4 * j4 + 3]; }
        const float a = (a0 + a1) + (a2 + a3);
        t[i] = a; Tg[i * 64 + lane] = f2bf(a); asm volatile("" ::: "memory"); }
}
DI void phase_prep_fast(const Ctx& c, int l) {
    PrepRegs pr;
    prep_load(c, c.bid, fresh_lane(), pr);
    for (int b0 = 0; b0 < 5; b0 += 3) {
        const int nb = (5 - b0) < 3 ? (5 - b0) : 3;
        for (int s = 0; s < nb; ++s) { const int task = c.bid + 256 * (b0 + s); if (task < (NTOK / 64) * 4) prep_task(c, l, task, s, fresh_lane(), pr, (b0 + s + 1 < 5) ? task + 256 : -1); }
        __syncthreads();
        if (c.wave < 2 * nb) { const int s = c.wave >> 1, task = c.bid + 256 * (b0 + s); if (task < (NTOK / 64) * 4) prep_invert(c, task, s, c.wave & 1, fresh_lane()); }
        __syncthreads();
    }
}

DI void hyprep_tile(const Ctx& c, int l, int item) {
    const bf16* PROJ = (const bf16*)(c.ws + WS_R1);
    const float* hw = c.in[14] + (size_t)l * 3 * 1536;
    bf16* X0C = (bf16*)(c.ws + WS_X0C); bf16* ZZT = (bf16*)(c.ws + WS_ZZT);
    LAS bf16* sin_ = (LAS bf16*)c.lds;
    LAS bf16* zt = (LAS bf16*)(c.lds + 3 * 66 * 64 * 2);
    const int ct = item & 7, rt0 = (item >> 3) * 4, ch0 = ct * 64;
    u32x4 v[4];
#define HP_LOAD(rt_) do { const int r0_ = (rt_) * 64; int s0_, s1_; seg_of_row(r0_, s0_, s1_); \
        _Pragma("unroll") for (int it = 0; it < 4; ++it) { const int i = it * NTHR + c.tid; \
            if (i < 3 * 66 * 8) { const int p = i / (66 * 8), rem = i % (66 * 8), rr = rem >> 3, c8 = (rem & 7) * 8; const int r = r0_ - 1 + rr; const bool ok = r >= s0_ && r < s1_; \
                v[it] = *(const u32x4*)(PROJ + (size_t)(ok ? r : r0_) * NP + 2048 + p * 512 + ch0 + c8); \
                if (!ok) v[it] = (u32x4){0u, 0u, 0u, 0u}; } } } while (0)
    HP_LOAD(rt0);
    const int rl = c.tid >> 3, cg = (c.tid & 7) * 8;
    f32x4 wA[3][3], wB[3][3];
#pragma unroll
    for (int p = 0; p < 3; ++p)
#pragma unroll
        for (int j = 0; j < 3; ++j) { wA[p][j] = *(const f32x4*)(hw + j * 1536 + p * 512 + ch0 + cg); wB[p][j] = *(const f32x4*)(hw + j * 1536 + p * 512 + ch0 + cg + 4); }
    for (int jt = 0; jt < 4; ++jt) {
        const int r0 = (rt0 + jt) * 64;
        if (jt) __syncthreads();
#pragma unroll
        for (int it = 0; it < 4; ++it) { const int i = it * NTHR + c.tid;
            if (i < 3 * 66 * 8) { const int p = i / (66 * 8), rem = i % (66 * 8), rr = rem >> 3, c8 = (rem & 7) * 8; *(LAS u32x4*)(sin_ + (p * 66 + rr) * 64 + c8) = v[it]; } }
        if (jt + 1 < 4) HP_LOAD(rt0 + jt + 1);
        __syncthreads();
        { float y[3][8];
#pragma unroll
            for (int p = 0; p < 3; ++p)
#pragma unroll
                for (int e = 0; e < 8; ++e) y[p][e] = 0.f;
#pragma unroll
            for (int p = 0; p < 3; ++p)
#pragma unroll
                for (int j = 0; j < 3; ++j) { const u32x4 xv = *(const LAS u32x4*)(sin_ + (p * 66 + rl + j) * 64 + cg);
                    const f32x4 w0 = wA[p][j], w1 = wB[p][j];
                    const unsigned xw[4] = {xv.x, xv.y, xv.z, xv.w};
#pragma unroll
                    for (int q = 0; q < 4; ++q) { const float wl = q < 2 ? w0[2 * q] : w1[2 * q - 4], wh = q < 2 ? w0[2 * q + 1] : w1[2 * q - 3];
                        y[p][2 * q] += wl * bf2f((bf16)(xw[q] & 0xffffu)); y[p][2 * q + 1] += wh * bf2f((bf16)(xw[q] >> 16)); } }
            u32x4 o; o.x = pk2(y[0][0], y[0][1]); o.y = pk2(y[0][2], y[0][3]); o.z = pk2(y[0][4], y[0][5]); o.w = pk2(y[0][6], y[0][7]);
            *(u32x4*)(X0C + (size_t)(r0 + rl) * 512 + ch0 + cg) = o;
#pragma unroll
            for (int e = 0; e < 8; ++e) zt[(cg + e) * 72 + rl] = f2bf(y[1][e] * y[2][e]); }
        __syncthreads();
        { const int chl = c.tid >> 3, e = (c.tid & 7) * 8;
            const u32x4 zv = *(const LAS u32x4*)(zt + chl * 72 + e);
            *(u32x4*)(ZZT + (size_t)(ch0 + chl) * NTOK + r0 + e) = zv; }
    }
#undef HP_LOAD
}

constexpr int SC_K = 0, SC_Q = 16384, SC_V = 32768, SC_T = 49152, SC_QK = 57344, SC_CO = 65536, SC_BUF = 66816;
static_assert(2 * SC_BUF <= 146944, "scan LDS");
typedef short v4i16_t __attribute__((ext_vector_type(4)));
typedef __bf16 bf16x2_t __attribute__((ext_vector_type(2)));
DI unsigned cvtpk(float lo, float hi) { f32x2 v = {lo, hi}; bf16x2_t b = __builtin_convertvector(v, bf16x2_t); return __builtin_bit_cast(unsigned, b); }
DI bf16x8v pack44(const f32x4& a, const f32x4& b) { u32x4 p; p.x = cvtpk(a[0], a[1]); p.y = cvtpk(a[2], a[3]); p.z = cvtpk(b[0], b[1]); p.w = cvtpk(b[2], b[3]); return __builtin_bit_cast(bf16x8v, p); }
DI s16x4v ldtr(const LAS unsigned char* p) { return __builtin_bit_cast(s16x4v, __builtin_amdgcn_ds_read_tr16_b64_v4i16((LAS v4i16_t*)p)); }
DI int kq_off(int r, int ch8) { return r * 256 + ((ch8 ^ (((r & 7) << 2) | (((r >> 3) & 1) << 1))) << 3); }
DI int t_off(int r, int ch8) { return r * 128 + ((ch8 ^ (((r >> 1) & 7) << 1)) << 3); }
DI bf16x8v ldA(const LAS unsigned char* mat, int nb, int c0) { const s16x4v lo = *(const volatile LAS s16x4v*)(mat + (nb ^ (c0 << 3))), hi = *(const volatile LAS s16x4v*)(mat + (nb ^ ((c0 + 4) << 3)));     return __builtin_shufflevector(lo, hi, 0, 1, 2, 3, 4, 5, 6, 7); }
#define MFMA16(a, b, c) __builtin_amdgcn_mfma_f32_16x16x32_bf16((a), (b), (c), 0, 0, 0)
#define SC_BAR() do { asm volatile("s_waitcnt lgkmcnt(0)" ::: "memory"); __builtin_amdgcn_s_barrier(); asm volatile("" ::: "memory"); } while (0)

DI void scan_load(const Ctx& c, u32x4 (&d)[16], float& gcv, float& be, int rowbase, int chunkid, int h, int dir, int ltid  ) {
    const bf16* QKVN = (const bf16*)(c.ws + WS_QKVN); const bf16* TM = (const bf16*)(c.ws + WS_TM); const bf16* QKM = (const bf16*)(c.ws + WS_QKM);
    const size_t mbase = ((size_t)(chunkid * 4 + h) * 2 + dir) * 4096;
#pragma unroll
    for (int it = 0; it < 16; ++it) { const int u = it * 256 + ltid, v = u & 1023;
        if (it < 12) { const int which = it >> 2; const int row = v >> 4, c16 = v & 15; const int srow = rowbase + (dir ? 63 - row : row);
            const int coff = (which == 0 ? 512 : (which == 1 ? 0 : 1024)) + h * 128 + c16 * 8;
            d[it] = *(const u32x4*)(QKVN + (size_t)srow * 1536 + coff); }
        else { const int mat = v >> 9, row = (v & 511) >> 3, c16 = v & 7;
            d[it] = *(const u32x4*)((mat ? QKM : TM) + mbase + row * 64 + c16 * 8); } }
    if (ltid < 64) { const float* GBG = (const float*)(c.ws + WS_GBG); const float* GBB = (const float*)(c.ws + WS_GBB);
        const int tok = dir ? 63 - ltid : ltid; const int ri = (rowbase + tok) * 8 + dir * 4 + h;
        gcv = GBG[ri]; be = GBB[ri]; }
}
DI void scan_store(LAS unsigned char* buf, const u32x4 (&d)[16], float gcv, float be, int ltid) {
#pragma unroll
    for (int it = 0; it < 16; ++it) { const int u = it * 256 + ltid, v = u & 1023; const u32x2 lo = {d[it].x, d[it].y}, hi = {d[it].z, d[it].w};
        if (it < 12) { const int which = it >> 2; const int row = v >> 4, c16 = v & 15; LAS unsigned char* bb = buf + (which == 0 ? SC_K : (which == 1 ? SC_Q : SC_V));
            *(LAS u32x2*)(bb + kq_off(row, 2 * c16)) = lo; *(LAS u32x2*)(bb + kq_off(row, 2 * c16 + 1)) = hi; }
        else { const int mat = v >> 9, row = (v & 511) >> 3, c16 = v & 7; LAS unsigned char* bb = buf + (mat ? SC_QK : SC_T);
            *(LAS u32x2*)(bb + t_off(row, 2 * c16)) = lo; *(LAS u32x2*)(bb + t_off(row, 2 * c16 + 1)) = hi; } }
    if (ltid < 64) { const float gl = shi(gcv, 63);
        LAS float* CO = (LAS float*)(buf + SC_CO); const float eg = __expf(gcv);
        CO[ltid] = be; CO[64 + ltid] = be * eg; CO[128 + ltid] = eg; CO[192 + ltid] = __expf(gl - gcv); if (ltid == 0) CO[256] = __expf(gl); }
}

DI void scan_chain(const Ctx& c, int l, int seq, int h, int dir, int half) {
    const bool isctx = seq < 16; const int NCH = isctx ? 4 : 64, row0 = isctx ? seq * 256 : NCTX + (seq - 16) * 4096;
    const int lane = fresh_lane();
    const int w = c.wave, n = lane & 15, g = lane >> 4, dv0 = 64 * half + 16 * (w & 3);
    LAS unsigned char* lds = c.lds;
    const int cstep = dir ? -1 : 1, cfirst = dir ? NCH - 1 : 0, chunk0 = row0 >> 6;
    __syncthreads();
    if (w >= 4) {
        u32x4 dreg[16]; float gcv_ = 0.f, be_ = 0.f;
        int lt = (w - 4) * 64 + lane; asm volatile("" : "+v"(lt));
        scan_load(c, dreg, gcv_, be_, row0 + cfirst * 64, chunk0 + cfirst, h, dir, lt);
        scan_store(lds, dreg, gcv_, be_, lt);
        if (NCH > 1) scan_load(c, dreg, gcv_, be_, row0 + (cfirst + cstep) * 64, chunk0 + cfirst + cstep, h, dir, lt);
        SC_BAR();
        for (int st = 0; st < NCH; ++st) {
            const int cn = cfirst + cstep * st;
            int lt2 = lt; asm volatile("" : "+v"(lt2));
            if (st + 1 < NCH) scan_store(lds + ((st + 1) & 1) * SC_BUF, dreg, gcv_, be_, lt2);
            if (st + 2 < NCH) { const int c2 = cn + 2 * cstep; scan_load(c, dreg, gcv_, be_, row0 + c2 * 64, chunk0 + c2, h, dir, lt2); }
            SC_BAR();
        }
    } else {
        bf16* O = (bf16*)(c.ws + (dir == 0 ? WS_OF : WS_OB));
        const int nbkq0 = (n << 8) | ((g ^ (((n & 7) << 2) | (((n >> 3) & 1) << 1))) << 3), nbt0 = (n << 7) | ((g ^ (((n >> 1) & 7) << 1)) << 3);
        const int qb_ = (lane >> 2) & 3, pp_ = lane & 3;
        const int trb0 = ((4 * g + qb_) << 8) | ((pp_ ^ (((4 * (g & 1) + qb_) << 2) | ((g >> 1) << 1))) << 3);
        f32x4 St[8];
        if (isctx) {
#pragma unroll
            for (int m = 0; m < 8; ++m) St[m] = (f32x4){0.f, 0.f, 0.f, 0.f};
        } else { const float* sp = c.in[2] + ((((size_t)(seq - 16) * 4 + l) * 2 + dir) * 4 + h) * 16384 + dv0 + n + (size_t)(4 * g) * 128; asm volatile("" : "+v"(sp));
#pragma unroll
            for (int m = 0; m < 8; ++m)
#pragma unroll
                for (int e = 0; e < 4; ++e) St[m][e] = sp[(16 * m + e) * 128]; }
        SC_BAR();
        for (int st = 0; st < NCH; ++st) {
            const int cn = cfirst + cstep * st;
            LAS unsigned char* buf = lds + (st & 1) * SC_BUF;
        int nbkq_ = nbkq0, nbt_ = nbt0, trb_ = trb0; asm volatile("" : "+v"(nbkq_), "+v"(nbt_), "+v"(trb_));
        const int nbkq = nbkq_, nbt = nbt_, trb = trb_;
        const LAS float* CO = (const LAS float*)(buf + SC_CO);
#define SB() __builtin_amdgcn_sched_barrier(0)
        bf16x8v Kf[4][4];
#pragma unroll
        for (int s4 = 0; s4 < 4; ++s4)
#pragma unroll
            for (int tt = 0; tt < 4; ++tt) Kf[s4][tt] = ldA(buf + SC_K + tt * 4096, nbkq, 8 * s4);
        SB();
        s16x4v vv[4]; f32x4 c1[4], c2[4]; bf16x8v Tf[6];
#pragma unroll
        for (int tt = 0; tt < 4; ++tt) { vv[tt] = ldtr(buf + SC_V + tt * 4096 + (trb ^ ((dv0 >> 2) << 3)));
            c1[tt] = *(const LAS f32x4*)(CO + 16 * tt + 4 * g); c2[tt] = *(const LAS f32x4*)(CO + 64 + 16 * tt + 4 * g); }
        Tf[0] = ldA(buf + SC_T + 0 * 2048, nbt, 0); Tf[1] = ldA(buf + SC_T + 1 * 2048, nbt, 0); Tf[2] = ldA(buf + SC_T + 2 * 2048, nbt, 0);
        Tf[3] = ldA(buf + SC_T + 2 * 2048, nbt, 8); Tf[4] = ldA(buf + SC_T + 3 * 2048, nbt, 0); Tf[5] = ldA(buf + SC_T + 3 * 2048, nbt, 8);
        SB();
        bf16x8v Bf[4];
#pragma unroll
        for (int s4 = 0; s4 < 4; ++s4) Bf[s4] = pack44(St[2 * s4], St[2 * s4 + 1]);
        f32x4 KS[4];
#pragma unroll
        for (int tt = 0; tt < 4; ++tt) KS[tt] = (f32x4){0.f, 0.f, 0.f, 0.f};
#pragma unroll
        for (int s4 = 0; s4 < 4; ++s4)
#pragma unroll
            for (int tt = 0; tt < 4; ++tt) KS[tt] = MFMA16(Kf[s4][tt], Bf[s4], KS[tt]);
        SB();
        bf16x8v Qf[4][4];
#pragma unroll
        for (int s4 = 0; s4 < 4; ++s4)
#pragma unroll
            for (int tt = 0; tt < 4; ++tt) Qf[s4][tt] = ldA(buf + SC_Q + tt * 4096, nbkq, 8 * s4);
        SB();
#pragma unroll
        for (int tt = 0; tt < 4; ++tt)
#pragma unroll
            for (int e = 0; e < 4; ++e) KS[tt][e] = c1[tt][e] * bf2f((bf16)vv[tt][e]) - c2[tt][e] * KS[tt][e];
        f32x4 VN[4];
        { const bf16x8v xf0 = pack44(KS[0], KS[1]), xf1 = pack44(KS[2], KS[3]);
          VN[0] = MFMA16(Tf[0], xf0, ((f32x4){0.f, 0.f, 0.f, 0.f})); VN[1] = MFMA16(Tf[1], xf0, ((f32x4){0.f, 0.f, 0.f, 0.f}));
          VN[2] = MFMA16(Tf[2], xf0, ((f32x4){0.f, 0.f, 0.f, 0.f})); VN[3] = MFMA16(Tf[4], xf0, ((f32x4){0.f, 0.f, 0.f, 0.f}));
          VN[2] = MFMA16(Tf[3], xf1, VN[2]); VN[3] = MFMA16(Tf[5], xf1, VN[3]); }
        SB();
        bf16x8v Mf[6]; f32x4 egv[4], edv[4];
        Mf[0] = ldA(buf + SC_QK + 0 * 2048, nbt, 0); Mf[1] = ldA(buf + SC_QK + 1 * 2048, nbt, 0); Mf[2] = ldA(buf + SC_QK + 2 * 2048, nbt, 0);
        Mf[3] = ldA(buf + SC_QK + 2 * 2048, nbt, 8); Mf[4] = ldA(buf + SC_QK + 3 * 2048, nbt, 0); Mf[5] = ldA(buf + SC_QK + 3 * 2048, nbt, 8);
#pragma unroll
        for (int tt = 0; tt < 4; ++tt) { egv[tt] = *(const LAS f32x4*)(CO + 128 + 16 * tt + 4 * g); edv[tt] = *(const LAS f32x4*)(CO + 192 + 16 * tt + 4 * g); }
        const float egl = CO[256];
        SB();
        f32x4 QS[4];
#pragma unroll
        for (int tt = 0; tt < 4; ++tt) QS[tt] = (f32x4){0.f, 0.f, 0.f, 0.f};
#pragma unroll
        for (int s4 = 0; s4 < 4; ++s4)
#pragma unroll
            for (int tt = 0; tt < 4; ++tt) QS[tt] = MFMA16(Qf[s4][tt], Bf[s4], QS[tt]);
#pragma unroll
        for (int tt = 0; tt < 4; ++tt) QS[tt] = QS[tt] * egv[tt];
        { const bf16x8v vf0 = pack44(VN[0], VN[1]), vf1 = pack44(VN[2], VN[3]);
          QS[0] = MFMA16(Mf[0], vf0, QS[0]); QS[1] = MFMA16(Mf[1], vf0, QS[1]); QS[2] = MFMA16(Mf[2], vf0, QS[2]); QS[3] = MFMA16(Mf[4], vf0, QS[3]);
          QS[2] = MFMA16(Mf[3], vf1, QS[2]); QS[3] = MFMA16(Mf[5], vf1, QS[3]); }
        SB();
        bf16x8v Ktf[8][2];
#pragma unroll
        for (int m = 0; m < 8; ++m) {
            { const s16x4v lo = ldtr(buf + SC_K + 0 * 256 + (trb ^ ((4 * m) << 3))), hi = ldtr(buf + SC_K + 16 * 256 + (trb ^ ((4 * m) << 3))); Ktf[m][0] = __builtin_shufflevector(lo, hi, 0, 1, 2, 3, 4, 5, 6, 7); }
            { const s16x4v lo = ldtr(buf + SC_K + 32 * 256 + (trb ^ ((4 * m) << 3))), hi = ldtr(buf + SC_K + 48 * 256 + (trb ^ ((4 * m) << 3))); Ktf[m][1] = __builtin_shufflevector(lo, hi, 0, 1, 2, 3, 4, 5, 6, 7); } }
        SB();
        { const int crow0 = row0 + cn * 64;
#pragma unroll
          for (int tt = 0; tt < 4; ++tt)
#pragma unroll
            for (int e = 0; e < 4; ++e) { const int ip = 16 * tt + 4 * g + e; const int tok = dir ? 63 - ip : ip;
                O[(size_t)(crow0 + tok) * 512 + h * 128 + dv0 + n] = f2bf(QS[tt][e]); } }
        { const bf16x8v vs0 = pack44(VN[0] * edv[0], VN[1] * edv[1]), vs1 = pack44(VN[2] * edv[2], VN[3] * edv[3]);
#pragma unroll
          for (int m = 0; m < 8; ++m) { St[m] = St[m] * egl; St[m] = MFMA16(Ktf[m][0], vs0, St[m]); St[m] = MFMA16(Ktf[m][1], vs1, St[m]); } }
            SC_BAR();
        }
        if (isctx) { const int l2 = fresh_lane();
            float* sp = c.out + (size_t)NTOK * D + ((((size_t)seq * 4 + l) * 2 + dir) * 4 + h) * 16384 + dv0 + (l2 & 15) + (size_t)(4 * (l2 >> 4)) * 128;
#pragma unroll
            for (int m = 0; m < 8; ++m)
#pragma unroll
                for (int e = 0; e < 4; ++e) sp[(16 * m + e) * 128] = St[m][e]; }
    }
}

DI void phase_gdn_out(const Ctx& c, int l) {
    const bf16* OF = (const bf16*)(c.ws + WS_OF); const bf16* OB = (const bf16*)(c.ws + WS_OB);
    bf16* PROJ = (bf16*)(c.ws + WS_R1); const float* gn = c.in[13] + l * 128;
    const int gw = c.bid * NWAVES + c.wave, NGW = c.G * NWAVES;
    const int col = 8 * c.lane;
    const f32x4 gA = *(const f32x4*)(gn + (col & 127)), gB = *(const f32x4*)(gn + (col & 127) + 4);
#define GO_ROW(uf, ub, ug, r_) do { \
        const unsigned wf[4] = {uf.x, uf.y, uf.z, uf.w}, wb[4] = {ub.x, ub.y, ub.z, ub.w}, wg[4] = {ug.x, ug.y, ug.z, ug.w}; \
        float o[8]; float ss = 0.f; \
        _Pragma("unroll") for (int q = 0; q < 4; ++q) { o[2 * q] = bf2f((bf16)(wf[q] & 0xffffu)) + bf2f((bf16)(wb[q] & 0xffffu)); o[2 * q + 1] = bf2f((bf16)(wf[q] >> 16)) + bf2f((bf16)(wb[q] >> 16)); ss += o[2 * q] * o[2 * q] + o[2 * q + 1] * o[2 * q + 1]; } \
        ss += __builtin_bit_cast(float, __builtin_amdgcn_update_dpp(0, __builtin_bit_cast(int, ss), 0xB1, 0xF, 0xF, true)); \
        ss += __builtin_bit_cast(float, __builtin_amdgcn_update_dpp(0, __builtin_bit_cast(int, ss), 0x4E, 0xF, 0xF, true)); \
        ss += __builtin_bit_cast(float, __builtin_amdgcn_update_dpp(0, __builtin_bit_cast(int, ss), 0x141, 0xF, 0xF, true)); \
        ss += __builtin_bit_cast(float, __builtin_amdgcn_update_dpp(0, __builtin_bit_cast(int, ss), 0x140, 0xF, 0xF, true)); \
        const float rstd = rsqrtf(ss * (1.f / 128.f) + EPS); \
        unsigned ow[4]; \
        _Pragma("unroll") for (int q = 0; q < 4; ++q) { const float g0 = bf2f((bf16)(wg[q] & 0xffffu)), g1 = bf2f((bf16)(wg[q] >> 16)); \
            const float s0 = q < 2 ? gA[2 * q] : gB[2 * q - 4], s1 = q < 2 ? gA[2 * q + 1] : gB[2 * q - 3]; \
            ow[q] = pk2(o[2 * q] * rstd * s0 * silu_f(g0), o[2 * q + 1] * rstd * s1 * silu_f(g1)); } \
        u32x4 ov; ov.x = ow[0]; ov.y = ow[1]; ov.z = ow[2]; ov.w = ow[3]; \
        *(u32x4*)(PROJ + (size_t)(r_) * NP + 2560 + col) = ov; } while (0)
    for (int r = gw; r < NTOK; r += 2 * NGW) {
        const int r1 = r + NGW; const bool has1 = r1 < NTOK; const int r1c = has1 ? r1 : r;
        const u32x4 f0 = *(const u32x4*)(OF + (size_t)r * 512 + col), b0 = *(const u32x4*)(OB + (size_t)r * 512 + col), g0v = *(const u32x4*)(PROJ + (size_t)r * NP + 1536 + col);
        const u32x4 f1 = *(const u32x4*)(OF + (size_t)r1c * 512 + col), b1 = *(const u32x4*)(OB + (size_t)r1c * 512 + col), g1v = *(const u32x4*)(PROJ + (size_t)r1c * NP + 1536 + col);
        GO_ROW(f0, b0, g0v, r);
        if (has1) GO_ROW(f1, b1, g1v, r1);
    }
#undef GO_ROW
}

DI void phase_final(const Ctx& c) {
    const float* fg = c.in[26];
    const int gw = c.bid * NWAVES + c.wave, NGW = c.G * NWAVES;
    f32x4 g4[4];
#pragma unroll
    for (int j = 0; j < 4; ++j) g4[j] = *(const f32x4*)(fg + (c.lane + 64 * j) * 4);
    for (int r = gw; r < NTOK; r += 2 * NGW) {
        const int r1 = (r + NGW < NTOK) ? r + NGW : r;
        f32x4* xr = (f32x4*)(c.X + (size_t)r * D); f32x4* xs = (f32x4*)(c.X + (size_t)r1 * D);
        f32x4 v[4], u[4]; float ss = 0.f, st = 0.f;
#pragma unroll
        for (int j = 0; j < 4; ++j) { v[j] = xr[c.lane + 64 * j]; u[j] = xs[c.lane + 64 * j]; }
#pragma unroll
        for (int j = 0; j < 4; ++j) { ss += (v[j].x * v[j].x + v[j].y * v[j].y) + (v[j].z * v[j].z + v[j].w * v[j].w); st += (u[j].x * u[j].x + u[j].y * u[j].y) + (u[j].z * u[j].z + u[j].w * u[j].w); }
        ss = wave_sum(ss, c.lane); st = wave_sum(st, c.lane);
        const float rstd = rsqrtf(ss * (1.f / D) + EPS), rstd1 = rsqrtf(st * (1.f / D) + EPS);
#pragma unroll
        for (int j = 0; j < 4; ++j) xr[c.lane + 64 * j] = v[j] * rstd * g4[j];
        if (r1 != r) {
#pragma unroll
            for (int j = 0; j < 4; ++j) xs[c.lane + 64 * j] = u[j] * rstd1 * g4[j]; }
    }
}

#define XB_TMO      128
#define XB_XCNT(j)  (256  + 64 * (j))
#define XB_XSUB(j)  (1280 + 64 * (j))
#define XB_XGEN(j)  (2304 + 64 * (j))
#define XB_TOP      3328
#define XB_TOPGEN   3392
#define XCD_BAR_WORDS 3456
#define XB_SPIN_CAP (1u << 22)
DI unsigned xb_ld(unsigned* p) { return __hip_atomic_load(p, __ATOMIC_RELAXED, __HIP_MEMORY_SCOPE_AGENT); }
DI unsigned xb_add(unsigned* p, unsigned v) { return __hip_atomic_fetch_add(p, v, __ATOMIC_RELAXED, __HIP_MEMORY_SCOPE_AGENT); }
DI unsigned xb_xcc_id() { return (unsigned)__builtin_amdgcn_s_getreg((3 << 11) | 20) & 0xFu; }
#define XB_SPIN(cond, bar) do { unsigned _sp = 0; while (cond) { __builtin_amdgcn_s_sleep(1); \
    if ((++_sp & 255u) == 0u) { if (xb_ld(&(bar)[XB_TMO])) break; if (_sp > XB_SPIN_CAP) { atomicAdd(&(bar)[XB_TMO], 1u); break; } } } } while (0)
struct XcdBarrier { unsigned* bar; unsigned x; volatile LAS unsigned* st; };
DI XcdBarrier xcd_barrier_post(unsigned* bar, volatile LAS unsigned* st, int tid) {
    XcdBarrier b; b.bar = bar; b.x = xb_xcc_id(); b.st = st;
    if (tid == 0) (void)xb_add(&bar[XB_XCNT(b.x)], 1u);
    return b;
}
DI void xcd_barrier_complete(unsigned* bar, unsigned x, unsigned& nloc, unsigned& nx) {
    const unsigned G = gridDim.x * gridDim.y * gridDim.z;
    unsigned sum, cnt, mine, sp = 0u;
    for (;;) {
        sum = 0u; cnt = 0u; mine = 0u;
#pragma unroll
        for (unsigned j = 0; j < 16; ++j) { const unsigned cc = xb_ld(&bar[XB_XCNT(j)]); sum += cc; cnt += (cc > 0u) ? 1u : 0u; mine = (j == x) ? cc : mine; }
        if (sum == G) break;
        __builtin_amdgcn_s_sleep(1);
        if ((++sp & 255u) == 0u) { if (xb_ld(&bar[XB_TMO])) break; if (sp > XB_SPIN_CAP) { atomicAdd(&bar[XB_TMO], 1u); break; } }
    }
    nloc = mine > 0u ? mine : 1u; nx = cnt > 0u ? cnt : 1u;
}
DI void xcd_barrier(const XcdBarrier& b, int tid) {
    asm volatile("s_waitcnt vmcnt(0)" ::: "memory");
    __syncthreads();
    if (tid == 0) {
        unsigned* bar = b.bar;
        __builtin_amdgcn_s_waitcnt(0);
        unsigned nloc = b.st[0], nx = b.st[1];
        if (nloc == 0u) { xcd_barrier_complete(bar, b.x, nloc, nx); b.st[0] = nloc; b.st[1] = nx; }
        const unsigned old = xb_add(&bar[XB_XSUB(b.x)], 1u);
        const unsigned gen = old / nloc;
        if (old + 1u == (gen + 1u) * nloc) {
            __builtin_amdgcn_fence(__ATOMIC_RELEASE, "agent");
            asm volatile("s_waitcnt vmcnt(0)" ::: "memory");
            const unsigned og = xb_add(&bar[XB_TOP], 1u);
            const unsigned tg = og / nx;
            if (og + 1u == (tg + 1u) * nx) xb_add(&bar[XB_TOPGEN], 1u);
            else XB_SPIN(xb_ld(&bar[XB_TOPGEN]) == tg, bar);
            __builtin_amdgcn_fence(__ATOMIC_ACQUIRE, "agent");
            xb_add(&bar[XB_XGEN(b.x)], 1u);
            asm volatile("s_waitcnt vmcnt(0)" ::: "memory");
        } else {
            XB_SPIN(xb_ld(&bar[XB_XGEN(b.x)]) == gen, bar);
            __builtin_amdgcn_fence(__ATOMIC_ACQUIRE, "agent");
            asm volatile("s_waitcnt vmcnt(0)" ::: "memory");
        }
    }
    __syncthreads();
}

constexpr int MISC_OFF = 146944;
__global__ void __launch_bounds__(NTHR, 2) fwd_kernel(KP p) {
    extern __shared__ __attribute__((aligned(16))) unsigned char lds_raw[];
    LAS unsigned char* lds0 = (LAS unsigned char*)lds_raw;
    const int wave0 = __builtin_amdgcn_readfirstlane((int)(threadIdx.x >> 6));
#define CUR_TID() ({ unsigned z_ = 0u; asm volatile("" : "+s"(z_)); wave0 * 64 + (int)__builtin_amdgcn_mbcnt_hi(~0u, __builtin_amdgcn_mbcnt_lo(~0u, z_)); })
    { const int t0 = CUR_TID(); volatile LAS unsigned* M0 = (volatile LAS unsigned*)(lds0 + MISC_OFF); if (t0 < 32) M0[t0] = 0u; }
    __syncthreads();
    const bool multi = (p.ph_hi - p.ph_lo) < 2;
    if (!multi) { KPc kp0 = (KPc)__builtin_amdgcn_kernarg_segment_ptr(); (void)xcd_barrier_post((unsigned*)(kp0->ws + WS_CTL) + 4096, (volatile LAS unsigned*)(lds0 + MISC_OFF) + 8, CUR_TID()); }
    for (int ph = p.ph_lo; ph < p.ph_hi; ++ph) {
        for (int rep = 0; rep < 2; ++rep) {
        KPc kp = (KPc)__builtin_amdgcn_kernarg_segment_ptr(); asm volatile("" : "+s"(kp));
        int tid = CUR_TID(); asm volatile("" : "+v"(tid));
        int bid = blockIdx.x; asm volatile("" : "+s"(bid));
        Ctx c;
        c.in = kp->in; c.X = kp->out; c.out = kp->out; c.ws = kp->ws; c.lds = lds0;
        c.tid = tid; c.lane = tid & 63; c.wave = __builtin_amdgcn_readfirstlane(tid >> 6); c.bid = bid; c.G = gridDim.x;
        if (ph == 0) { if (rep == 0 || (DUP_MASK & 32)) phase_mod(c); }
        else if (ph == 1) { if (rep == 0 || (DUP_MASK & 32)) { phase_sw(c); phase_rowprep<1, true>(c, 0); phase_filters(c, 0); phase_wconv_in(c, 0); } }
        else if (ph == NPH - 1) { if (rep == 0) phase_final(c); }
        else {
            const int l = (ph - 2) >> 3, sub = (ph - 2) & 7;
            if (rep == 1) break;
            switch (sub) {
                case 0: phase_gemm_fast<EPI_PROJ>(c, l); break;
                case 1: phase_prep_fast(c, l); break;
                case 2: phase_queue(c, l); break;
                case 3: phase_gdn_out(c, l); phase_hyena_out(c); break;
                case 4: phase_gemm_fast<EPI_RES1>(c, l); break;
                case 5: phase_gemm_fast<EPI_H>(c, l); break;
                case 6: phase_g4_main(c, l); break;
                default: phase_g4_combine(c, l); break;
            }
        }
        if (DUP_MASK == 0) break;
        __syncthreads();
        }
        KPc kpb = (KPc)__builtin_amdgcn_kernarg_segment_ptr();
        if (DUP_MASK & 64) { XcdBarrier bar; bar.bar = (unsigned*)(kpb->ws + WS_CTL) + 4096; bar.x = xb_xcc_id(); bar.st = (volatile LAS unsigned*)(lds0 + MISC_OFF) + 8; xcd_barrier(bar, CUR_TID()); }
        if (ph + 1 < kpb->ph_hi) { XcdBarrier bar; bar.bar = (unsigned*)(kpb->ws + WS_CTL) + 4096; bar.x = xb_xcc_id(); bar.st = (volatile LAS unsigned*)(lds0 + MISC_OFF) + 8; xcd_barrier(bar, CUR_TID()); }
    }
}

extern "C" void kernel_launch(void* const* d_in, const int* in_sizes, int n_in, void* d_out, int out_size, void* d_ws, size_t ws_size, hipStream_t stream) {
    static int grid = 0;
    if (grid == 0) {
        if (n_in != 27 || out_size != NTOK * D + 16 * 4 * 2 * 4 * 128 * 128 || ws_size < WS_END) {
            fprintf(stderr, "kernel_launch: unexpected problem: n_in %d out %d ws %zu (need %zu)\n", n_in, out_size, ws_size, (size_t)WS_END); grid = -1; return; }
        int dev = 0, cus = 0;
        if (hipGetDevice(&dev) != hipSuccess || hipDeviceGetAttribute(&cus, hipDeviceAttributeMultiprocessorCount, dev) != hipSuccess) { grid = -1; return; }
        if (hipFuncSetAttribute((const void*)fwd_kernel, hipFuncAttributeMaxDynamicSharedMemorySize, LDS_BYTES) != hipSuccess) { fprintf(stderr, "kernel_launch: hipFuncSetAttribute failed\n"); grid = -1; return; }
        int per_cu = 0;
        if (hipOccupancyMaxActiveBlocksPerMultiprocessor(&per_cu, (const void*)fwd_kernel, NTHR, LDS_BYTES) != hipSuccess || per_cu < 1)
            fprintf(stderr, "kernel_launch: occupancy query says %d blocks per CU\n", per_cu);
        (void)hipGetLastError();
        grid = cus;
    }
    if (grid < 0) return;
    (void)hipMemsetAsync((char*)d_ws + WS_CTL, 0, CTL_ZERO_BYTES, stream);
    KP p{};
    for (int i = 0; i < 27; ++i) p.in[i] = (const float*)d_in[i];
    p.out = (float*)d_out; p.ws = (unsigned char*)d_ws;
#if MK_MULTI
    for (int ph = 0; ph < NPH; ++ph) { p.ph_lo = ph; p.ph_hi = ph + 1; hipLaunchKernelGGL(fwd_kernel, dim3(grid), dim3(NTHR), LDS_BYTES, stream, p); }
#else
    p.ph_lo = 0; p.ph_hi = NPH; hipLaunchKernelGGL(fwd_kernel, dim3(grid), dim3(NTHR), LDS_BYTES, stream, p);
#endif
}
```

```cpp
#include <hip/hip_runtime.h>
#include <cstdio>
#include <cstdint>

#define GAS __attribute__((address_space(1)))
#define LAS __attribute__((address_space(3)))
#define DI __device__ __forceinline__
typedef unsigned short bf16;
typedef float f32x4 __attribute__((ext_vector_type(4)));
typedef float f32x2 __attribute__((ext_vector_type(2)));
typedef unsigned u32x4 __attribute__((ext_vector_type(4)));
typedef unsigned u32x2 __attribute__((ext_vector_type(2)));
typedef short bf16x8v __attribute__((ext_vector_type(8)));
typedef float f32x16 __attribute__((ext_vector_type(16)));
typedef short s16x4v __attribute__((ext_vector_type(4)));

#ifndef DUP_MASK
#define DUP_MASK 0
#endif
#ifndef MK_MULTI
#define MK_MULTI 0
#endif

constexpr int D = 1024, FF = 4096, DEPTH = 4;
constexpr int NCTX = 4096, NTOK = 20480;
constexpr int NP = 3584;
constexpr int IN_COLS = 3600;
constexpr int NWAVES = 8, NTHR = 512;
constexpr float EPS = 1e-6f;
constexpr int NPH = 2 + 7 * DEPTH + 1;

constexpr size_t MiB = 1u << 20;
constexpr size_t WS_CTL = 0, CTL_ZERO_BYTES = 32 * 1024;
constexpr size_t WS_MOD = 1 * MiB;
constexpr size_t WS_SWIN = 1 * MiB + 512 * 1024;
constexpr size_t WS_SW1 = 2 * MiB;
constexpr size_t WS_RSS1 = 2 * MiB + 512 * 1024;
constexpr size_t WS_RSS2 = WS_RSS1 + 128 * 1024;
constexpr size_t WS_LOGIT = 3 * MiB;
constexpr size_t WS_GBG = 4 * MiB + 512 * 1024;
constexpr size_t WS_GBB = WS_GBG + 640 * 1024;
constexpr size_t WS_WT = 6 * MiB;
constexpr size_t WS_FILT = 32 * MiB;
constexpr size_t WS_A = 50 * MiB;
constexpr size_t WS_OF = WS_A, WS_OB = WS_A + 20 * MiB;
constexpr size_t WS_R1 = 90 * MiB;
constexpr size_t WS_ZZT = WS_R1 + 140 * MiB;
constexpr size_t WS_QKVN = 250 * MiB;
constexpr size_t WS_TMQK = 310 * MiB;
constexpr size_t WS_X0C = 350 * MiB;
constexpr size_t WS_RSSP1 = 370 * MiB;
constexpr size_t WS_RSSP2 = 372 * MiB;
constexpr size_t WS_END = 374 * MiB;

constexpr int LDS_BYTES = 147456;

#define NTL(T, p) __builtin_nontemporal_load((const T*)(p))
typedef __bf16 bf16x2_hwt __attribute__((ext_vector_type(2)));
DI unsigned cvtpk_hw(float lo, float hi) { f32x2 v = {lo, hi}; return __builtin_bit_cast(unsigned, __builtin_convertvector(v, bf16x2_hwt)); }
DI float bf2f(bf16 h) { return __builtin_bit_cast(float, (unsigned)h << 16); }
DI bf16 f2bf(float f) { unsigned u = __builtin_bit_cast(unsigned, f); return (bf16)((u + 0x7fffu + ((u >> 16) & 1u)) >> 16); }
DI unsigned pk2(float lo, float hi) { return (unsigned)f2bf(lo) | ((unsigned)f2bf(hi) << 16); }
DI float shx(float v, int o, int lane) { return __builtin_bit_cast(float, __builtin_amdgcn_ds_bpermute((lane ^ o) << 2, __builtin_bit_cast(int, v))); }
DI float shi(float v, int src) { return __builtin_bit_cast(float, __builtin_amdgcn_ds_bpermute(src << 2, __builtin_bit_cast(int, v))); }
DI int fresh_lane() { unsigned z_ = 0u; asm volatile("" : "+s"(z_)); return (int)__builtin_amdgcn_mbcnt_hi(~0u, __builtin_amdgcn_mbcnt_lo(~0u, z_)); }
DI float wave_sum(float v, int lane) {
#pragma unroll
    for (int o = 1; o < 64; o <<= 1) v += shx(v, o, lane);
    return v;
}
DI float silu_f(float x) { return x * __builtin_amdgcn_rcpf(1.f + __expf(-x)); }
DI float sigmoid_f(float x) { return __builtin_amdgcn_rcpf(1.f + __expf(-x)); }
DI float softplus_f(float x) { return x > 15.f ? x : __logf(1.f + __expf(x)); }
DI float sin_rev(float rev) { return __builtin_amdgcn_sinf(rev); }
DI float cos_rev(float rev) { return __builtin_amdgcn_cosf(rev); }
DI float rss_read(const float* P, int r) { const f32x4* p = (const f32x4*)(P + (size_t)r * 16); const f32x4 a = p[0], b = p[1], c2 = p[2], d = p[3]; const f32x4 t = (a + b) + (c2 + d); return (t.x + t.y) + (t.z + t.w); }
DI int mod_of_row(int r) { return r < NCTX ? 4 : ((r - NCTX) >> 12); }

struct KP {
    const float* in[27];
    float* out;
    unsigned char* ws;
    int ph_lo, ph_hi;
};

#define CAS __attribute__((address_space(4)))
typedef const KP CAS* KPc;
typedef const float* const CAS* InTab;
struct Ctx {
    InTab in;
    float* X;
    float* out;
    unsigned char* ws;
    LAS unsigned char* lds;
    int tid, lane, wave, bid, G;
};

DI void gemv5_block(const Ctx& c, const float* W, int N, int j0, LAS const float* sc, LAS float* red) {
    const int lane = c.tid & 63, ks = c.tid >> 6, j = j0 + 2 * lane; const bool ok = j < N;
    float acc[5][2];
#pragma unroll
    for (int m = 0; m < 5; ++m) { acc[m][0] = 0.f; acc[m][1] = 0.f; }
    if (ok) { const float* wp = W + (size_t)(ks * 128) * N + j;
        f32x2 wn[16];
#pragma unroll
        for (int i = 0; i < 16; ++i) wn[i] = __builtin_nontemporal_load((const f32x2*)(wp + (size_t)i * N));
        for (int kb = 0; kb < 8; ++kb) {
            f32x2 w[16];
#pragma unroll
            for (int i = 0; i < 16; ++i) w[i] = wn[i];
            if (kb + 1 < 8) {
#pragma unroll
                for (int i = 0; i < 16; ++i) wn[i] = __builtin_nontemporal_load((const f32x2*)(wp + (size_t)((kb + 1) * 16 + i) * N)); }
#pragma unroll
            for (int i4 = 0; i4 < 4; ++i4)
#pragma unroll
                for (int m = 0; m < 5; ++m) { const f32x4 s4 = *(const LAS f32x4*)(sc + m * 1024 + ks * 128 + kb * 16 + 4 * i4);
#pragma unroll
                    for (int e = 0; e < 4; ++e) { acc[m][0] += s4[e] * w[4 * i4 + e].x; acc[m][1] += s4[e] * w[4 * i4 + e].y; } } } }
#pragma unroll
    for (int m = 0; m < 5; ++m) *(LAS f32x2*)(red + (ks * 5 + m) * 128 + 2 * lane) = (f32x2){acc[m][0], acc[m][1]};
    __syncthreads();
    for (int idx = c.tid; idx < 640; idx += NTHR) { const int m = idx >> 7, col = idx & 127; float sum = 0.f;
#pragma unroll
        for (int q = 0; q < 8; ++q) sum += red[(q * 5 + m) * 128 + col];
        red[5120 + idx] = sum; }
    __syncthreads();
}
DI void phase_mod(const Ctx& c) {
    const float* cin = c.in[3]; const float* cctx = c.in[4]; const float* w_ada = c.in[5]; const float* b_ada = c.in[6];
    LAS float* sc = (LAS float*)c.lds;
    LAS float* red = sc + 5 * 1024;
    for (int i = c.tid; i < 5 * 1024; i += NTHR) { const int m = i >> 10, k = i & 1023; const float v = (m < 4) ? cin[m * 1024 + k] : cctx[k]; sc[i] = silu_f(v); }
    __syncthreads();
    float* MOD = (float*)(c.ws + WS_MOD);
    for (int task = c.bid; task < 4 * 48; task += c.G) {
        const int l = task / 48, cb = task % 48;
        gemv5_block(c, w_ada + (size_t)l * 1024 * 6144, 6144, cb * 128, sc, red);
        for (int idx = c.tid; idx < 640; idx += NTHR) { const int m = idx >> 7, j = cb * 128 + (idx & 127);
            MOD[(size_t)(l * 5 + m) * 6144 + j] = red[5120 + idx] + b_ada[l * 6144 + j]; }
        __syncthreads();
    }
}

DI void phase_sw(const Ctx& c) {
    const float* MOD = (const float*)(c.ws + WS_MOD);
    LAS float* sc = (LAS float*)c.lds;
    LAS float* red = sc + 5 * 1024;
    float* SWIN = (float*)(c.ws + WS_SWIN); float* SW1 = (float*)(c.ws + WS_SW1);
    constexpr int NB_IN = 29, NB_1 = 32, PER_L = NB_IN + NB_1;
    int cur_key = -1;
    for (int task = c.bid; task < 4 * PER_L; task += c.G) {
        const int l = task / PER_L, t = task % PER_L; const bool is1 = t >= NB_IN; const int cb = is1 ? t - NB_IN : t;
        const int key = l * 2 + (is1 ? 1 : 0);
        if (key != cur_key) {
            __syncthreads();
            for (int i = c.tid; i < 5 * 1024; i += NTHR) { const int m = i >> 10, k = i & 1023; sc[i] = MOD[(size_t)(l * 5 + m) * 6144 + (is1 ? 3 : 0) * 1024 + k]; }
            __syncthreads(); cur_key = key;
        }
        const int N = is1 ? FF : IN_COLS; const float* W = (is1 ? c.in[24] : c.in[9]) + (size_t)l * 1024 * N;
        gemv5_block(c, W, N, cb * 128, sc, red);
        for (int idx = c.tid; idx < 640; idx += NTHR) { const int m = idx >> 7, j = cb * 128 + (idx & 127);
            if (j < N) (is1 ? SW1 : SWIN)[(size_t)(l * 5 + m) * N + j] = red[5120 + idx]; }
        __syncthreads();
    }
}

template <int WHICH, bool FIRST>
DI void phase_rowprep(const Ctx& c, int l) {
    const float* MOD = (const float*)(c.ws + WS_MOD);
    const float* ng = (WHICH == 1 ? c.in[7] : c.in[8]) + l * 1024;
    float* RSS = (float*)(c.ws + (WHICH == 1 ? WS_RSSP1 : WS_RSSP2));
    bf16* A = (bf16*)(c.ws + WS_A);
    float* LOGIT = (float*)(c.ws + WS_LOGIT);
    const float* w_in = c.in[9] + (size_t)l * 1024 * IN_COLS;
    const int gw = c.bid * NWAVES + c.wave, NGW = c.G * NWAVES;
#define RP_XROW(r_) (FIRST ? (const f32x4*)(((r_) < NCTX ? c.in[0] : c.in[1] - (size_t)NCTX * D) + (size_t)(r_) * D) : (const f32x4*)(c.X + (size_t)(r_) * D))
    f32x4 vn[4];
#pragma unroll
    for (int j = 0; j < 4; ++j) vn[j] = NTL(f32x4, RP_XROW(gw) + c.lane + 64 * j);
    for (int r = gw; r < NTOK; r += NGW) {
        const int mb = mod_of_row(r);
        const float* mrow = MOD + (size_t)(l * 5 + mb) * 6144;
        const float* shift = mrow + (WHICH == 1 ? 0 : 3) * 1024; const float* scale = mrow + (WHICH == 1 ? 1 : 4) * 1024;
        f32x4 v[4]; float ss = 0.f;
#pragma unroll
        for (int j = 0; j < 4; ++j) v[j] = vn[j];
        if (r + NGW < NTOK) {
#pragma unroll
            for (int j = 0; j < 4; ++j) vn[j] = NTL(f32x4, RP_XROW(r + NGW) + c.lane + 64 * j); }
#pragma unroll
        for (int j = 0; j < 4; ++j) ss += (v[j].x * v[j].x + v[j].y * v[j].y) + (v[j].z * v[j].z + v[j].w * v[j].w);
        ss = wave_sum(ss, c.lane);
        if (!FIRST) ss = rss_read(RSS, r);
        if (FIRST && c.lane < 16) RSS[(size_t)r * 16 + c.lane] = c.lane == 0 ? ss : 0.f;
        const float rstd = rsqrtf(ss * (1.f / D) + EPS);
        if (FIRST)
#pragma unroll
        for (int j = 0; j < 4; ++j) {
            const int k0 = (c.lane + 64 * j) * 4;
            const f32x4 g4 = *(const f32x4*)(ng + k0), s4 = *(const f32x4*)(scale + k0);
            const f32x4 a = v[j] * (g4 * (s4 + 1.0f));
            u32x2 w; w.x = pk2(a.x, a.y); w.y = pk2(a.z, a.w);
            *(u32x2*)(A + (size_t)r * D + k0) = w;
        }
        float lg[16];
#pragma unroll
        for (int q = 0; q < 16; ++q) lg[q] = 0.f;
        if (WHICH == 1 && !FIRST) {
#pragma unroll 1
            for (int j = 0; j < 4; ++j) {
                const int k0 = (c.lane + 64 * j) * 4;
                const f32x4 xv = RP_XROW(r)[c.lane + 64 * j];
                const f32x4 g4 = *(const f32x4*)(ng + k0), s4 = *(const f32x4*)(scale + k0), sh = *(const f32x4*)(shift + k0);
                const f32x4 hn = xv * (g4 * (s4 + 1.0f)) * rstd + sh;
#pragma unroll
                for (int e = 0; e < 4; ++e) { const float h = hn[e]; const f32x4* wp = (const f32x4*)(w_in + (size_t)(k0 + e) * IN_COLS + 2048);
#pragma unroll
                    for (int q = 0; q < 4; ++q) { const f32x4 w4 = wp[q]; lg[4 * q] += h * w4.x; lg[4 * q + 1] += h * w4.y; lg[4 * q + 2] += h * w4.z; lg[4 * q + 3] += h * w4.w; }
                    asm volatile("" ::: "memory"); }
            }
        }
        if (WHICH == 1 && !FIRST) {
#pragma unroll
            for (int q = 0; q < 16; ++q) { const float s = wave_sum(lg[q], c.lane); if (c.lane == q) LOGIT[(size_t)r * 16 + q] = s; }
        }
    }
}

constexpr size_t FILT_SLOT = 9 * MiB;
DI float rdl(float x, int i) { return __builtin_bit_cast(float, __builtin_amdgcn_readlane(__builtin_bit_cast(int, x), i)); }
DI void filters_task(const Ctx& c, int l, int task) {
    const float* w1 = c.in[15] + l * 33 * 64; const float* b1 = c.in[16] + l * 64; const float* fr = c.in[17] + l * 64;
    const float* w2 = c.in[18] + l * 64 * 64; const float* b2 = c.in[19] + l * 64; const float* w3 = c.in[20] + (size_t)l * 64 * 1024; const float* b3 = c.in[21] + l * 1024;
    bf16* RL = (bf16*)(c.ws + WS_FILT + (l & 1) * FILT_SLOT);
    bf16* RC = RL + 8 * MiB / 2;
    const float* skip = c.in[22] + l * 512;
    LAS float* H2 = (LAS float*)c.lds;
    const float min_decay = -3.0701134573253945f, max_decay = -15.350567286626972f;
    {
        const bool isL = task < 64; const int L = isL ? 4096 : 256, tb = isL ? task * 64 : (task - 64) * 64;
        float w1c[33], w2c[64];
#pragma unroll
        for (int i = 0; i < 33; ++i) w1c[i] = w1[i * 64 + c.lane];
#pragma unroll
        for (int i = 0; i < 64; ++i) w2c[i] = w2[i * 64 + c.lane];
        const float b1v = b1[c.lane], b2v = b2[c.lane], frv = fr[c.lane] * 0.15915494309189535f;
        for (int k = 0; k < 8; ++k) {
            const int tl = c.wave * 8 + k, t = tb + tl;
            const float tn = (float)t / (float)(L - 1), trev = (float)t / (float)L;
            float z = 0.f;
            if (c.lane == 0) z = tn;
            else if (c.lane <= 32) { const int i = (c.lane - 1) & 15; const float f = 1e-4f + (float)i * ((15.0f - 1e-4f) / 15.0f); z = (c.lane <= 16) ? cos_rev(f * trev) : -sin_rev(f * trev); }
            float a = b1v;
#pragma unroll
            for (int i = 0; i < 33; ++i) a += rdl(z, i) * w1c[i];
            const float h1 = sin_rev(frv * a);
            float a2 = b2v;
#pragma unroll
            for (int i = 0; i < 64; ++i) a2 += rdl(h1, i) * w2c[i];
            H2[tl * 68 + c.lane] = sin_rev(frv * a2);
        }
        __syncthreads();
        const int n = c.lane & 31, hh = c.lane >> 5;
        for (int ot = 0; ot < 4; ++ot) {
            const int o0 = c.wave * 128 + ot * 32;
            f32x16 acc[2];
#pragma unroll
            for (int tt = 0; tt < 2; ++tt)
#pragma unroll
                for (int i = 0; i < 16; ++i) acc[tt][i] = 0.f;
            float wall[4][8];
#pragma unroll
            for (int ks = 0; ks < 4; ++ks)
#pragma unroll
                for (int j = 0; j < 8; ++j) wall[ks][j] = w3[(16 * ks + 8 * hh + j) * 1024 + o0 + n];
            __builtin_amdgcn_sched_barrier(0);
#pragma unroll
            for (int ks = 0; ks < 4; ++ks) {
                u32x4 ah, al;
#pragma unroll
                for (int j = 0; j < 4; ++j) { const float x0 = wall[ks][2 * j], x1 = wall[ks][2 * j + 1]; const bf16 h0 = f2bf(x0), h1 = f2bf(x1);
                    ah[j] = (unsigned)h0 | ((unsigned)h1 << 16); al[j] = pk2(x0 - bf2f(h0), x1 - bf2f(h1)); }
#pragma unroll
                for (int tt = 0; tt < 2; ++tt) {
                    const LAS f32x4* hp = (const LAS f32x4*)(H2 + (32 * tt + n) * 68 + 16 * ks + 8 * hh); const f32x4 p0 = hp[0], p1 = hp[1];
                    const float hv[8] = {p0.x, p0.y, p0.z, p0.w, p1.x, p1.y, p1.z, p1.w};
                    u32x4 bh, bl;
#pragma unroll
                    for (int j = 0; j < 4; ++j) { const float x0 = hv[2 * j], x1 = hv[2 * j + 1]; const bf16 h0 = f2bf(x0), h1 = f2bf(x1);
                        bh[j] = (unsigned)h0 | ((unsigned)h1 << 16); bl[j] = pk2(x0 - bf2f(h0), x1 - bf2f(h1)); }
                    const bf16x8v Ah = __builtin_bit_cast(bf16x8v, ah), Al = __builtin_bit_cast(bf16x8v, al), Bh = __builtin_bit_cast(bf16x8v, bh), Bl = __builtin_bit_cast(bf16x8v, bl);
                    acc[tt] = __builtin_amdgcn_mfma_f32_32x32x16_bf16(Ah, Bh, acc[tt], 0, 0, 0);
                    acc[tt] = __builtin_amdgcn_mfma_f32_32x32x16_bf16(Ah, Bl, acc[tt], 0, 0, 0);
                    acc[tt] = __builtin_amdgcn_mfma_f32_32x32x16_bf16(Al, Bh, acc[tt], 0, 0, 0);
                }
            }
            float b3v[16], skv[16];
#pragma unroll
            for (int i = 0; i < 16; ++i) { const int oo = o0 + (i & 3) + 8 * (i >> 2) + 4 * hh; b3v[i] = b3[oo]; skv[i] = skip[oo & 511]; }
            __builtin_amdgcn_sched_barrier(0);
#pragma unroll
            for (int tt = 0; tt < 2; ++tt) { const int t = tb + 32 * tt + n; const float tn = (float)t / (float)(L - 1);
#pragma unroll
                for (int i = 0; i < 16; ++i) { const int oo = o0 + (i & 3) + 8 * (i >> 2) + 4 * hh, dir = oo >> 9, ch = oo & 511;
                    const float delta = fabsf(min_decay + (float)ch * ((max_decay - min_decay) / 511.0f));
                    float val = (acc[tt][i] + b3v[i]) * __expf(-tn * delta);
                    if (t == 0) val = dir == 0 ? val + skv[i] : 0.f;
                    const int q = dir == 0 ? L - t : (t == 0 ? 0 : L + t);
                    if (isL) RL[(size_t)ch * 8192 + q] = f2bf(val); else RC[(size_t)ch * 512 + q] = f2bf(val); } }
        }
    }
}
DI void phase_filters(const Ctx& c, int l) {
    for (int task = c.bid; task < 68; task += c.G) { __syncthreads(); Ctx cf = c; { const int lq = fresh_lane(); cf.lane = lq; cf.tid = c.wave * 64 + lq; } filters_task(cf, l, task); }
    __syncthreads();
}

enum { EPI_PROJ = 0, EPI_RES1 = 1, EPI_H = 2, EPI_RES2 = 3 };
template <int EPI>
DI void phase_gemm_naive(const Ctx& c, int l) {
    const bf16* A; int lda, K, N, ldw; const float* W;
    if (EPI == EPI_PROJ) { A = (const bf16*)(c.ws + WS_A); lda = D; K = D; N = NP; ldw = IN_COLS; W = c.in[9] + (size_t)l * D * IN_COLS; }
    else if (EPI == EPI_RES1) { A = (const bf16*)(c.ws + WS_R1) + 2560; lda = NP; K = D; N = D; ldw = D; W = c.in[23] + (size_t)l * D * D; }
    else if (EPI == EPI_H) { A = (const bf16*)(c.ws + WS_A); lda = D; K = D; N = FF; ldw = FF; W = c.in[24] + (size_t)l * D * FF; }
    else { A = (const bf16*)(c.ws + WS_R1); lda = FF; K = FF; N = D; ldw = D; W = c.in[25] + (size_t)l * FF * D; }
    const float* MOD = (const float*)(c.ws + WS_MOD);
    const float* RSS1 = (const float*)(c.ws + WS_RSS1); const float* RSS2 = (const float*)(c.ws + WS_RSS2);
    const float* SWIN = (const float*)(c.ws + WS_SWIN); const float* SW1 = (const float*)(c.ws + WS_SW1);
    bf16* PROJ = (bf16*)(c.ws + WS_R1); bf16* Hb = (bf16*)(c.ws + WS_R1);
    LAS float* As = (LAS float*)c.lds;
    LAS float* Bs = As + 16 * 68;
    const int ty = c.tid >> 5, tx = c.tid & 31;
    const int nMt = NTOK / 64, nNt = N / 128;
    for (int tile = c.bid; tile < nMt * nNt; tile += c.G) {
        const int tm = tile / nNt, tn = tile % nNt, row0 = tm * 64, col0 = tn * 128;
        float acc[4][4];
#pragma unroll
        for (int i = 0; i < 4; ++i)
#pragma unroll
            for (int j = 0; j < 4; ++j) acc[i][j] = 0.f;
        for (int k0 = 0; k0 < K; k0 += 16) {
            { const int ar = c.tid >> 3, kp = (c.tid & 7) * 2; const unsigned u = *(const unsigned*)(A + (size_t)(row0 + ar) * lda + k0 + kp);
              As[kp * 68 + ar] = bf2f((bf16)(u & 0xffffu)); As[(kp + 1) * 68 + ar] = bf2f((bf16)(u >> 16)); }
            { const int kr = c.tid >> 5, c4 = (c.tid & 31) * 4; int col = col0 + c4; if (EPI == EPI_PROJ && col >= 2048) col += 16;
              const f32x4 w = *(const f32x4*)(W + (size_t)(k0 + kr) * ldw + col); *(LAS f32x4*)(Bs + kr * 128 + c4) = w; }
            __syncthreads();
#pragma unroll
            for (int kk = 0; kk < 16; ++kk) { const f32x4 a = *(const LAS f32x4*)(As + kk * 68 + ty * 4); const f32x4 b = *(const LAS f32x4*)(Bs + kk * 128 + tx * 4);
#pragma unroll
                for (int i = 0; i < 4; ++i)
#pragma unroll
                    for (int j = 0; j < 4; ++j) acc[i][j] += a[i] * b[j]; }
            __syncthreads();
        }
#pragma unroll
        for (int i = 0; i < 4; ++i) {
            const int r = row0 + ty * 4 + i, mb = mod_of_row(r), n = col0 + tx * 4;
            if (EPI == EPI_PROJ) {
                const float rstd = rsqrtf(RSS1[r] * (1.f / D) + EPS); const int oc = n >= 2048 ? n + 16 : n;
                const f32x4 sw = *(const f32x4*)(SWIN + (size_t)(l * 5 + mb) * IN_COLS + oc);
                u32x2 w; w.x = pk2(acc[i][0] * rstd + sw.x, acc[i][1] * rstd + sw.y); w.y = pk2(acc[i][2] * rstd + sw.z, acc[i][3] * rstd + sw.w);
                *(u32x2*)(PROJ + (size_t)r * NP + n) = w;
            } else if (EPI == EPI_H) {
                const float rstd = rsqrtf(RSS2[r] * (1.f / D) + EPS);
                const f32x4 sw = *(const f32x4*)(SW1 + (size_t)(l * 5 + mb) * FF + n);
                float v[4];
#pragma unroll
                for (int j = 0; j < 4; ++j) { float t = acc[i][j] * rstd + sw[j]; t = t > 0.f ? t : 0.f; v[j] = t * t; }
                u32x2 w; w.x = pk2(v[0], v[1]); w.y = pk2(v[2], v[3]);
                *(u32x2*)(Hb + (size_t)r * FF + n) = w;
            } else {
                const f32x4 gate = *(const f32x4*)(MOD + (size_t)(l * 5 + mb) * 6144 + (EPI == EPI_RES1 ? 2 : 5) * 1024 + n);
                f32x4* xp = (f32x4*)(c.X + (size_t)r * D + n); f32x4 x = *xp;
                x.x += gate.x * acc[i][0]; x.y += gate.y * acc[i][1]; x.z += gate.z * acc[i][2]; x.w += gate.w * acc[i][3];
                *xp = x;
            }
        }
    }
}


namespace pg8 {
#define PG8_LAS __attribute__((address_space(3)))
typedef unsigned short bf16_t;
typedef short bf16x8 __attribute__((ext_vector_type(8)));
typedef float f32x4 __attribute__((ext_vector_type(4)));
typedef unsigned u32x4 __attribute__((ext_vector_type(4)));
constexpr int BM = 256, BK = 64, HALF = 128, HTB = HALF * BK * 2  , STAGE_BYTES = 8 * HTB, NXCD = 8, WGM = 8;

__host__ __device__ __forceinline__ int lds_byte(int r, int c) { const int st = (r >> 4) * 2 + (c >> 5), rr = r & 15, cc = c & 31, ob = rr * 64 + cc * 2; return st * 1024 + (ob ^ (((ob >> 9) & 1) << 5)); }
__host__ __device__ __forceinline__ void stage_rc(int b, int& R, int& C) { const int st = b / 1024, sb = b % 1024, swz = sb ^ (((sb >> 9) & 1) << 5); R = (st >> 1) * 16 + swz / 64; C = (st & 1) * 32 + (swz % 64) / 2; }
__host__ __device__ __forceinline__ int perm32(int rho) { const int n = rho >> 4, i = rho & 15; return 8 * (i >> 2) + 4 * n + (i & 3); }

struct Unit { int pm, pn; };
struct Gemm { const bf16_t* A; const bf16_t* Bt; int M, N, K, lda; };

struct StaticOrder {
    int nM, nN, nwg, G, c;
    __host__ __device__ void init(int M, int N, int G_, int c_) { nM = M / BM; nN = N / BM; nwg = nM * nN; G = G_; c = c_; }
    __host__ __device__ bool next(int i, Unit& u) const {
        const long L = (long)i * G + c; if (L >= nwg) return false;
        int wgid = (int)L; { const int q = nwg / NXCD, r = nwg % NXCD, xcd = wgid % NXCD, off = wgid / NXCD; wgid = (xcd < r ? xcd * (q + 1) : r * (q + 1) + (xcd - r) * q) + off; }
        const int nig = WGM * nN, gid = wgid / nig, fm = gid * WGM, gsz = (nM - fm) < WGM ? (nM - fm) : WGM;
        u.pm = fm + ((wgid % nig) % gsz); u.pn = (wgid % nig) / gsz; return true;
    }
    __device__ __forceinline__ void a_ready(const Unit&) const {}
    __device__ __forceinline__ void done(const Unit&) const {}
};

template <int N_, int K_, int LDA_, int LDB_ = K_> struct GemmT { const bf16_t* A; const bf16_t* Bt; static constexpr int M = 20480, N = N_, K = K_, lda = LDA_, ldb = LDB_; };
template <int N_> struct StaticOrderT {
    static constexpr int nM = 20480 / BM, nN = N_ / BM, nwg = nM * nN; int G, c;
    __device__ __forceinline__ bool next(int i, Unit& u) const {
        const int L = i * G + c; if (L >= nwg) return false;
        int wgid = L; { constexpr int q = nwg / NXCD, r = nwg % NXCD; const int xcd = wgid % NXCD, off = wgid / NXCD; wgid = (xcd < r ? xcd * (q + 1) : r * (q + 1) + (xcd - r) * q) + off; }
        constexpr int nig = WGM * nN; const int gid = wgid / nig, fm = gid * WGM, gsz = (nM - fm) < WGM ? (nM - fm) : WGM;
        u.pm = fm + ((wgid % nig) % gsz); u.pn = (wgid % nig) / gsz; return true;
    }
    __device__ __forceinline__ void a_ready(const Unit&) const {}
    __device__ __forceinline__ void done(const Unit&) const {}
};
template <class Epi, class Sched, class GemmX, bool ALIGN_EPI = false, bool SP2 = false>
__device__ __forceinline__ void gemm_phase(PG8_LAS unsigned char* lds, const GemmX g, const Sched& S, const Epi& E, const int tid) {
    const int wid = __builtin_amdgcn_readfirstlane(tid >> 6), lane = tid & 63, wr = wid >> 2, wc = wid & 3, fr = lane & 15, fq = lane >> 4;
    constexpr int K = GemmX::K, nt = K / BK;
    unsigned voffA[2], voffB[2];
#pragma unroll
    for (int i = 0; i < 2; ++i) { int R, C; stage_rc(tid * 16 + i * 8192, R, C); const int Rb = Epi::PERM ? ((R & ~31) + perm32(R & 31)) : R;
        voffA[i] = (unsigned)(R * GemmX::lda + C) * 2u; voffB[i] = (unsigned)(Rb * GemmX::ldb + C) * 2u; }
    constexpr size_t kstep = (size_t)(BK * 2);
    constexpr size_t hstepA = (size_t)HALF * GemmX::lda * 2, hstepB = (size_t)HALF * GemmX::ldb * 2;
    constexpr size_t tstepA = 2 * hstepA, tstepB = 2 * hstepB;
    const unsigned ldsw = (unsigned)wid * 1024u;
    const int aoff = lds_byte(wr * 64 + fr, fq * 8), boff = lds_byte(wc * 32 + fr, fq * 8);
#define PG8_SA(b, h) (((b) * 2 + (h)) * HTB)
#define PG8_SB(b, h) ((4 + (b) * 2 + (h)) * HTB)
#define PG8_STAGE(bufoff, gbase, voff) do { _Pragma("unroll") for (int _i = 0; _i < 2; ++_i) \
        __builtin_amdgcn_global_load_lds((const unsigned*)((const char*)(gbase) + (voff)[_i]), (PG8_LAS unsigned*)(lds + (bufoff) + ldsw + _i * 8192), 16, 0, 0); } while (0)
#define PG8_LDA(dst, b, h) do { _Pragma("unroll") for (int m = 0; m < 4; ++m) _Pragma("unroll") for (int k = 0; k < 2; ++k) dst[m][k] = *(const PG8_LAS bf16x8*)(lds + PG8_SA(b, h) + aoff + m * 2048 + k * 1024); } while (0)
#define PG8_LDB(dst, b, h) do { _Pragma("unroll") for (int n = 0; n < 2; ++n) _Pragma("unroll") for (int k = 0; k < 2; ++k) dst[n][k] = *(const PG8_LAS bf16x8*)(lds + PG8_SB(b, h) + boff + n * 2048 + k * 1024); } while (0)
#define PG8_MMA(ai, bj, At, Bt) do { __builtin_amdgcn_s_setprio(1); _Pragma("unroll") for (int m = 0; m < 4; ++m) _Pragma("unroll") for (int n = 0; n < 2; ++n) _Pragma("unroll") for (int k = 0; k < 2; ++k) \
        acc[ai][bj][m][n] = __builtin_amdgcn_mfma_f32_16x16x32_bf16(Bt[n][k], At[m][k], acc[ai][bj][m][n], 0, 0, 0); __builtin_amdgcn_s_setprio(0); } while (0)
#define PG8_WAIT_V(n) asm volatile("s_waitcnt vmcnt(" #n ")" ::: "memory")
#define PG8_WAIT_L(n) asm volatile("s_waitcnt lgkmcnt(" #n ")" ::: "memory")
#define PG8_BAR __builtin_amdgcn_s_barrier()
#define PG8_SCHED __builtin_amdgcn_sched_barrier(0)
    Unit cur, nxt; int ui = 0;
    if (!S.next(0, cur)) return;
    f32x4 acc[2][2][4][2];
#pragma unroll
    for (int a = 0; a < 2; ++a)
#pragma unroll
        for (int b = 0; b < 2; ++b)
#pragma unroll
            for (int m = 0; m < 4; ++m)
#pragma unroll
                for (int n = 0; n < 2; ++n) acc[a][b][m][n] = (f32x4){0.f, 0.f, 0.f, 0.f};
    bf16x8 At[4][2], B0[2][2], B1[2][2];
    const char* cA = (const char*)g.A + (size_t)cur.pm * tstepA; const char* cB = (const char*)g.Bt + (size_t)cur.pn * tstepB;
    S.a_ready(cur);
    if constexpr (SP2) {
        PG8_STAGE(PG8_SB(0, 0), cB, voffB); PG8_STAGE(PG8_SB(0, 1), cB + hstepB, voffB); PG8_STAGE(PG8_SA(0, 0), cA, voffA); PG8_STAGE(PG8_SA(0, 1), cA + hstepA, voffA);
        if (wr == 1) PG8_BAR;
        PG8_WAIT_V(2); PG8_BAR;
        PG8_STAGE(PG8_SB(1, 0), cB + kstep, voffB); PG8_STAGE(PG8_SA(1, 0), cA + kstep, voffA); PG8_STAGE(PG8_SB(1, 1), cB + hstepB + kstep, voffB);
        PG8_WAIT_V(6); PG8_BAR;
    } else {
        PG8_STAGE(PG8_SB(0, 0), cB, voffB); PG8_STAGE(PG8_SA(0, 0), cA, voffA); PG8_STAGE(PG8_SB(0, 1), cB + hstepB, voffB); PG8_STAGE(PG8_SA(0, 1), cA + hstepA, voffA);
        if (wr == 1) PG8_BAR;
        PG8_WAIT_V(4); PG8_BAR;
        PG8_STAGE(PG8_SB(1, 0), cB + kstep, voffB); PG8_STAGE(PG8_SA(1, 0), cA + kstep, voffA); PG8_STAGE(PG8_SB(1, 1), cB + hstepB + kstep, voffB);
        PG8_WAIT_V(6); PG8_BAR;
    }
    for (;;) {
        const bool has_next = S.next(ui + 1, nxt);
        const char* nA = has_next ? (const char*)g.A + (size_t)nxt.pm * tstepA : cA; const char* nB = has_next ? (const char*)g.Bt + (size_t)nxt.pn * tstepB : cB;
        for (int t = 0; t < nt; t += 2) {
            const bool last = (t == nt - 2);
            const char* a1 = cA + (size_t)(t + 1) * kstep;
            const char* a2 = last ? nA : cA + (size_t)(t + 2) * kstep; const char* b2 = last ? nB : cB + (size_t)(t + 2) * kstep;
            const char* a3 = a2 + kstep; const char* b3 = b2 + kstep;
            if (last && has_next) S.a_ready(nxt);
            if constexpr (SP2) {
            PG8_LDB(B0, 0, 0); PG8_LDB(B1, 0, 1); PG8_SCHED; PG8_LDA(At, 0, 0); PG8_STAGE(PG8_SA(1, 1), a1 + hstepA, voffA);
            PG8_WAIT_V(8); PG8_WAIT_L(0); PG8_BAR; PG8_MMA(0, 0, At, B0); PG8_MMA(0, 1, At, B1); PG8_BAR; PG8_SCHED;
            PG8_LDA(At, 0, 1); PG8_STAGE(PG8_SB(0, 0), b2, voffB); PG8_STAGE(PG8_SB(0, 1), b2 + hstepB, voffB); PG8_STAGE(PG8_SA(0, 0), a2, voffA);
            PG8_WAIT_V(8); PG8_WAIT_L(0); PG8_BAR; PG8_MMA(1, 0, At, B0); PG8_MMA(1, 1, At, B1); PG8_BAR; PG8_SCHED;
            PG8_LDB(B0, 1, 0); PG8_LDB(B1, 1, 1); PG8_SCHED; PG8_LDA(At, 1, 0); PG8_STAGE(PG8_SA(0, 1), a2 + hstepA, voffA);
            PG8_WAIT_V(8); PG8_WAIT_L(0); PG8_BAR; PG8_MMA(0, 0, At, B0); PG8_MMA(0, 1, At, B1); PG8_BAR; PG8_SCHED;
            PG8_LDA(At, 1, 1); PG8_STAGE(PG8_SB(1, 0), b3, voffB); PG8_STAGE(PG8_SB(1, 1), b3 + hstepB, voffB); PG8_STAGE(PG8_SA(1, 0), a3, voffA);
            PG8_WAIT_V(8); PG8_WAIT_L(0); PG8_BAR; PG8_MMA(1, 0, At, B0); PG8_MMA(1, 1, At, B1); PG8_BAR; PG8_SCHED;
            } else {
            PG8_LDB(B0, 0, 0); PG8_SCHED; PG8_LDA(At, 0, 0); PG8_STAGE(PG8_SA(1, 1), a1 + hstepA, voffA);
            PG8_WAIT_L(8); PG8_BAR; PG8_WAIT_L(0); PG8_MMA(0, 0, At, B0); PG8_BAR; PG8_SCHED;
            PG8_LDB(B1, 0, 1); PG8_STAGE(PG8_SB(0, 0), b2, voffB);
            PG8_BAR; PG8_WAIT_L(0); PG8_MMA(0, 1, At, B1); PG8_BAR;
            PG8_LDA(At, 0, 1); PG8_STAGE(PG8_SA(0, 0), a2, voffA);
            PG8_BAR; PG8_WAIT_L(0); PG8_MMA(1, 0, At, B0); PG8_BAR; PG8_SCHED;
            PG8_STAGE(PG8_SB(0, 1), b2 + hstepB, voffB);
            PG8_WAIT_V(6); PG8_BAR; PG8_MMA(1, 1, At, B1); PG8_BAR;
            PG8_LDB(B0, 1, 0); PG8_SCHED; PG8_LDA(At, 1, 0); PG8_STAGE(PG8_SA(0, 1), a2 + hstepA, voffA);
            PG8_WAIT_L(8); PG8_BAR; PG8_WAIT_L(0); PG8_MMA(0, 0, At, B0); PG8_BAR; PG8_SCHED;
            PG8_LDB(B1, 1, 1); PG8_STAGE(PG8_SB(1, 0), b3, voffB);
            PG8_BAR; PG8_WAIT_L(0); PG8_MMA(0, 1, At, B1); PG8_BAR;
            PG8_LDA(At, 1, 1); PG8_STAGE(PG8_SA(1, 0), a3, voffA);
            PG8_BAR; PG8_WAIT_L(0); PG8_MMA(1, 0, At, B0); PG8_BAR; PG8_SCHED;
            PG8_STAGE(PG8_SB(1, 1), b3 + hstepB, voffB);
            PG8_WAIT_V(6); PG8_BAR; PG8_MMA(1, 1, At, B1); PG8_BAR;
            }
        }
        if constexpr (ALIGN_EPI) { if (wr == 0) PG8_BAR; }
        if constexpr (!Epi::AFTER_DRAIN) { E(acc, cur, wr, wc, fr, fq); S.done(cur); }
        if (!has_next) break;
#pragma unroll
        for (int a = 0; a < 2; ++a)
#pragma unroll
            for (int b = 0; b < 2; ++b)
#pragma unroll
                for (int m = 0; m < 4; ++m)
#pragma unroll
                    for (int n = 0; n < 2; ++n) acc[a][b][m][n] = (f32x4){0.f, 0.f, 0.f, 0.f};
        cur = nxt; cA = nA; cB = nB; ++ui;
        if constexpr (ALIGN_EPI) { if (wr == 1) PG8_BAR; }
    }
    PG8_WAIT_V(0);
    if constexpr (!ALIGN_EPI) { if (wr == 0) PG8_BAR; }
    PG8_BAR;
    if constexpr (Epi::AFTER_DRAIN) { E.fused(acc, cur, wr, wc, fr, fq, lds, wid, lane); S.done(cur); }
#undef PG8_SA
#undef PG8_SB
#undef PG8_STAGE
#undef PG8_LDA
#undef PG8_LDB
#undef PG8_MMA
#undef PG8_WAIT_V
#undef PG8_WAIT_L
#undef PG8_BAR
#undef PG8_SCHED
}
}
namespace pg8 {
__device__ __forceinline__ unsigned cvt_pk_bf16(float lo, float hi) { unsigned r; asm volatile("v_cvt_pk_bf16_f32 %0, %1, %2" : "=v"(r) : "v"(lo), "v"(hi)); return r; }
DI int tile_mb(int pm) { return pm < 16 ? 4 : ((pm - 16) >> 4); }
#define RSTD_ROWS(rs, RSS, row0, fr, fq) float rs[2][4]; do { \
        _Pragma("unroll") for (int ai_ = 0; ai_ < 2; ++ai_) _Pragma("unroll") for (int m_ = 0; m_ < 4; ++m_) { \
            const f32x4 p_ = *(const f32x4*)((RSS) + (size_t)((row0) + ai_ * HALF + m_ * 16) * 16 + 4 * (fq)); rs[ai_][m_] = (p_.x + p_.y) + (p_.z + p_.w); } \
        _Pragma("unroll") for (int ai_ = 0; ai_ < 2; ++ai_) _Pragma("unroll") for (int m_ = 0; m_ < 4; ++m_) { float s_ = rs[ai_][m_]; \
            s_ += shx(s_, 16, (fr) + 16 * (fq)); s_ += shx(s_, 32, (fr) + 16 * (fq)); rs[ai_][m_] = rsqrtf(s_ * (1.f / D) + EPS); } } while (0)
struct EpiProj {
    static constexpr bool PERM = true, AFTER_DRAIN = false;
    int l; const PG8_LAS float* rsl; mutable int k;
    __device__ __forceinline__ void operator()(const f32x4 (&acc)[2][2][4][2], const Unit& u, int wr, int wc, int fr, int fq) const {
        const PG8_LAS float* tb = rsl + (k++) * 512; const PG8_LAS float* rsu = tb + wr * 64 + fr;
        KPc kp = (KPc)__builtin_amdgcn_kernarg_segment_ptr(); asm volatile("" : "+s"(kp));
        unsigned char* ws = kp->ws; bf16_t* O = (bf16_t*)(ws + WS_R1); const float* RSS = (const float*)(ws + WS_RSSP1);
        const int row0 = u.pm * BM + wr * 64 + fr, col0 = u.pn * BM + wc * 32 + 8 * fq;
        const float* sw = (const float*)(ws + WS_SWIN) + (size_t)(l * 5 + tile_mb(u.pm)) * IN_COLS;
        if (u.pn == 14) {
            if (wc == 0) {
                float* LOGIT = (float*)(ws + WS_LOGIT); const int lane = fr + 16 * fq;
                const f32x4 s0 = *(const f32x4*)(sw + 2048 + 8 * (fq & 1)), s1 = *(const f32x4*)(sw + 2048 + 8 * (fq & 1) + 4);
#pragma unroll
                for (int ai = 0; ai < 2; ++ai)
#pragma unroll
                    for (int m = 0; m < 4; ++m) { const int r = row0 + ai * HALF + m * 16; const float rstd = rsu[ai * HALF + m * 16];
                        f32x4 v0 = acc[ai][0][m][0], v1 = acc[ai][0][m][1];
#pragma unroll
                        for (int e = 0; e < 4; ++e) { v0[e] += shx(v0[e], 32, lane); v1[e] += shx(v1[e], 32, lane); }
                        if (fq < 2) { *(f32x4*)(LOGIT + (size_t)r * 16 + 8 * fq) = v0 * rstd + s0; *(f32x4*)(LOGIT + (size_t)r * 16 + 8 * fq + 4) = v1 * rstd + s1; } }
            }
            return;
        }
        f32x4 bv[2][2];
#pragma unroll
        for (int bj = 0; bj < 2; ++bj)
#pragma unroll
            for (int n = 0; n < 2; ++n) bv[bj][n] = *(const PG8_LAS f32x4*)(tb + 256 + wc * 32 + 8 * fq + bj * HALF + 4 * n);
        float rs[2][4];
#pragma unroll
        for (int ai = 0; ai < 2; ++ai)
#pragma unroll
            for (int m = 0; m < 4; ++m) rs[ai][m] = rsu[ai * HALF + m * 16];
#pragma unroll
        for (int ai = 0; ai < 2; ++ai)
#pragma unroll
            for (int m = 0; m < 4; ++m) { const int r = row0 + ai * HALF + m * 16; const float rstd = rs[ai][m]; bf16_t* rowp = O + (size_t)r * NP + col0;
#pragma unroll
                for (int bj = 0; bj < 2; ++bj) { const f32x4 v0 = acc[ai][bj][m][0] * rstd + bv[bj][0], v1 = acc[ai][bj][m][1] * rstd + bv[bj][1];
                    u32x4 w; w.x = cvt_pk_bf16(v0[0], v0[1]); w.y = cvt_pk_bf16(v0[2], v0[3]); w.z = cvt_pk_bf16(v1[0], v1[1]); w.w = cvt_pk_bf16(v1[2], v1[3]);
                    *(u32x4*)(rowp + bj * HALF) = w; } }
    }
};
struct EpiH {
    static constexpr bool PERM = true, AFTER_DRAIN = false;
    int l; const PG8_LAS float* rsl; mutable int k;
    __device__ __forceinline__ void operator()(const f32x4 (&acc)[2][2][4][2], const Unit& u, int wr, int wc, int fr, int fq) const {
        const PG8_LAS float* tb = rsl + (k++) * 512; const PG8_LAS float* rsu = tb + wr * 64 + fr;
        KPc kp = (KPc)__builtin_amdgcn_kernarg_segment_ptr(); asm volatile("" : "+s"(kp));
        unsigned char* ws = kp->ws; bf16_t* O = (bf16_t*)(ws + WS_R1);
        const int row0 = u.pm * BM + wr * 64 + fr, col0 = u.pn * BM + wc * 32 + 8 * fq;
        const float* sw = (const float*)(ws + WS_SW1) + (size_t)(l * 5 + tile_mb(u.pm)) * FF;
        f32x4 bv[2][2];
#pragma unroll
        for (int bj = 0; bj < 2; ++bj)
#pragma unroll
            for (int n = 0; n < 2; ++n) bv[bj][n] = *(const PG8_LAS f32x4*)(tb + 256 + wc * 32 + 8 * fq + bj * HALF + 4 * n);
        float rs[2][4];
#pragma unroll
        for (int ai = 0; ai < 2; ++ai)
#pragma unroll
            for (int m = 0; m < 4; ++m) rs[ai][m] = rsu[ai * HALF + m * 16];
#pragma unroll
        for (int ai = 0; ai < 2; ++ai)
#pragma unroll
            for (int m = 0; m < 4; ++m) { const int r = row0 + ai * HALF + m * 16; const float rstd = rs[ai][m]; bf16_t* rowp = O + (size_t)r * FF + col0;
#pragma unroll
                for (int bj = 0; bj < 2; ++bj) { f32x4 v0 = acc[ai][bj][m][0] * rstd + bv[bj][0], v1 = acc[ai][bj][m][1] * rstd + bv[bj][1];
                    v0 = __builtin_elementwise_max(v0, (f32x4){0.f, 0.f, 0.f, 0.f}); v1 = __builtin_elementwise_max(v1, (f32x4){0.f, 0.f, 0.f, 0.f}); v0 = v0 * v0; v1 = v1 * v1;
                    u32x4 w; w.x = cvt_pk_bf16(v0[0], v0[1]); w.y = cvt_pk_bf16(v0[2], v0[3]); w.z = cvt_pk_bf16(v1[0], v1[1]); w.w = cvt_pk_bf16(v1[2], v1[3]);
                    *(u32x4*)(rowp + bj * HALF) = w; } }
    }
};
template <int WHICH>
struct EpiRes {
    static constexpr bool PERM = true, AFTER_DRAIN = false;
    int l;
    struct Cols { f32x4 gt[2][2], gs[2][2]; float* X; const float* Xin; bf16_t* An; float* RSS; bool has_next; int row0, col0, pn, wc; };
    __device__ __forceinline__ void prepare(Cols& q, const Unit& u, int wr, int wc, int fr, int fq) const {
        KPc kp = (KPc)__builtin_amdgcn_kernarg_segment_ptr(); asm volatile("" : "+s"(kp));
        unsigned char* ws = kp->ws; q.X = kp->out; const float* MOD = (const float*)(ws + WS_MOD);
        q.Xin = (WHICH == 1 && l == 0) ? (u.pm < 16 ? kp->in[0] : kp->in[1] - (size_t)NCTX * D) : (const float*)kp->out;
        q.has_next = (WHICH == 1) || (l + 1 < DEPTH); const int ln = (WHICH == 1) ? l : (q.has_next ? l + 1 : l);
        const int mb = tile_mb(u.pm);
        const float* gateb = MOD + (size_t)(l * 5 + mb) * 6144 + (WHICH == 1 ? 2 : 5) * 1024;
        const float* scaleb = MOD + (size_t)(ln * 5 + mb) * 6144 + (WHICH == 1 ? 4 : 1) * 1024;
        const float* ng = (WHICH == 1 ? kp->in[8] : kp->in[7]) + ln * 1024;
        q.An = (bf16_t*)(ws + WS_A); q.RSS = (float*)(ws + (WHICH == 1 ? WS_RSSP2 : WS_RSSP1));
        q.row0 = u.pm * BM + wr * 64 + fr; q.col0 = u.pn * BM + wc * 32 + 8 * fq; q.pn = u.pn; q.wc = wc;
#pragma unroll
        for (int bj = 0; bj < 2; ++bj)
#pragma unroll
            for (int n = 0; n < 2; ++n) { const int cc = q.col0 + bj * HALF + 4 * n; q.gt[bj][n] = *(const f32x4*)(gateb + cc);
                q.gs[bj][n] = *(const f32x4*)(ng + cc) * (*(const f32x4*)(scaleb + cc) + 1.0f); }
    }
    struct RowX { f32x4 x[2][2]; };
    template <bool FIRST> __device__ __forceinline__ void rowload(const Cols& q, int ai, int m, RowX& o) const {
        const int r = q.row0 + ai * HALF + m * 16;
        if constexpr (FIRST) { const float* xi = q.Xin + (size_t)r * D + q.col0;
#pragma unroll
            for (int bj = 0; bj < 2; ++bj) { o.x[bj][0] = NTL(f32x4, xi + bj * HALF); o.x[bj][1] = NTL(f32x4, xi + bj * HALF + 4); } }
        else { const bf16_t* xb = (const bf16_t*)((const char*)q.X + (size_t)r * (D * 4) + D * 2) + q.col0;
            const u32x4 w0 = NTL(u32x4, xb), w1 = NTL(u32x4, xb + HALF);
            o.x[0][0] = (f32x4){__builtin_bit_cast(float, w0.x << 16), __builtin_bit_cast(float, w0.x & 0xffff0000u), __builtin_bit_cast(float, w0.y << 16), __builtin_bit_cast(float, w0.y & 0xffff0000u)};
            o.x[0][1] = (f32x4){__builtin_bit_cast(float, w0.z << 16), __builtin_bit_cast(float, w0.z & 0xffff0000u), __builtin_bit_cast(float, w0.w << 16), __builtin_bit_cast(float, w0.w & 0xffff0000u)};
            o.x[1][0] = (f32x4){__builtin_bit_cast(float, w1.x << 16), __builtin_bit_cast(float, w1.x & 0xffff0000u), __builtin_bit_cast(float, w1.y << 16), __builtin_bit_cast(float, w1.y & 0xffff0000u)};
            o.x[1][1] = (f32x4){__builtin_bit_cast(float, w1.z << 16), __builtin_bit_cast(float, w1.z & 0xffff0000u), __builtin_bit_cast(float, w1.w << 16), __builtin_bit_cast(float, w1.w & 0xffff0000u)}; }
    }
    __device__ __forceinline__ void rowcompute(const Cols& q, int ai, int m, const f32x4 (&v)[2][2], const RowX& xin, int fr, int fq) const {
        const int r = q.row0 + ai * HALF + m * 16; float ss = 0.f;
        bf16_t* xb = (bf16_t*)((char*)q.X + (size_t)r * (D * 4) + D * 2) + q.col0;
#pragma unroll
        for (int bj = 0; bj < 2; ++bj) { f32x4 x0 = xin.x[bj][0], x1 = xin.x[bj][1];
            x0 = x0 + q.gt[bj][0] * v[bj][0]; x1 = x1 + q.gt[bj][1] * v[bj][1];
            { u32x4 xs; xs.x = cvt_pk_bf16(x0[0], x0[1]); xs.y = cvt_pk_bf16(x0[2], x0[3]); xs.z = cvt_pk_bf16(x1[0], x1[1]); xs.w = cvt_pk_bf16(x1[2], x1[3]); *(u32x4*)(xb + bj * HALF) = xs; }
            ss += (x0[0] * x0[0] + x0[1] * x0[1]) + (x0[2] * x0[2] + x0[3] * x0[3]) + (x1[0] * x1[0] + x1[1] * x1[1]) + (x1[2] * x1[2] + x1[3] * x1[3]);
            if (q.has_next) { const f32x4 a0 = x0 * q.gs[bj][0], a1 = x1 * q.gs[bj][1];
                u32x4 w; w.x = cvt_pk_bf16(a0[0], a0[1]); w.y = cvt_pk_bf16(a0[2], a0[3]); w.z = cvt_pk_bf16(a1[0], a1[1]); w.w = cvt_pk_bf16(a1[2], a1[3]);
                *(u32x4*)(q.An + (size_t)r * D + q.col0 + bj * HALF) = w; } }
        ss += shx(ss, 16, fr + 16 * fq); ss += shx(ss, 32, fr + 16 * fq);
        if (fq == 0) q.RSS[(size_t)r * 16 + q.pn * 4 + q.wc] = ss;
    }
    __device__ __forceinline__ void rowgroup(const Cols& q, int ai, int m, const f32x4 (&v)[2][2], int fr, int fq) const { RowX xin; rowload<false>(q, ai, m, xin); rowcompute(q, ai, m, v, xin, fr, fq); }
    template <bool FIRST> __device__ __forceinline__ void tile(const Cols& q, const f32x4 (&acc)[2][2][4][2], int fr, int fq) const {
#pragma unroll
        for (int ai = 0; ai < 2; ++ai)
#pragma unroll
            for (int mp = 0; mp < 4; mp += 2) { RowX xa, xb2;
                rowload<FIRST>(q, ai, mp, xa); if constexpr (!FIRST) rowload<FIRST>(q, ai, mp + 1, xb2);
                { const f32x4 v[2][2] = {{acc[ai][0][mp][0], acc[ai][0][mp][1]}, {acc[ai][1][mp][0], acc[ai][1][mp][1]}}; rowcompute(q, ai, mp, v, xa, fr, fq); }
                if constexpr (FIRST) rowload<FIRST>(q, ai, mp + 1, xb2);
                { const f32x4 v[2][2] = {{acc[ai][0][mp + 1][0], acc[ai][0][mp + 1][1]}, {acc[ai][1][mp + 1][0], acc[ai][1][mp + 1][1]}}; rowcompute(q, ai, mp + 1, v, xb2, fr, fq); }
                asm volatile("" ::: "memory"); }
    }
    __device__ __forceinline__ void operator()(const f32x4 (&acc)[2][2][4][2], const Unit& u, int wr, int wc, int fr, int fq) const {
        Cols q; prepare(q, u, wr, wc, fr, fq);
        if ((WHICH == 1) && (l == 0)) tile<true>(q, acc, fr, fq); else tile<false>(q, acc, fr, fq);
    }
};
struct FirstRoundOrder {
    int c;
    __device__ __forceinline__ bool next(int i, Unit& u) const { if (i > 0) return false; StaticOrderT<1024> S{256, c}; return S.next(0, u); }
    __device__ __forceinline__ void a_ready(const Unit&) const {}
    __device__ __forceinline__ void done(const Unit&) const {}
};
struct TailOrder {
    int c;
    __device__ __forceinline__ bool next(int i, Unit& u) const { if (i > 0) return false; StaticOrderT<1024> S{256, c >> 2}; return S.next(1, u); }
    __device__ __forceinline__ void a_ready(const Unit&) const {}
    __device__ __forceinline__ void done(const Unit&) const {}
};
struct EpiSlab {
    static constexpr bool PERM = true, AFTER_DRAIN = false;
    float* slab; int tid;
    __device__ __forceinline__ void operator()(const f32x4 (&acc)[2][2][4][2], const Unit&, int, int, int, int) const {
        u32x4* p = (u32x4*)slab + tid;
#pragma unroll
        for (int ai = 0; ai < 2; ++ai)
#pragma unroll
            for (int bj = 0; bj < 2; ++bj)
#pragma unroll
                for (int m = 0; m < 4; ++m) { const f32x4 a = acc[ai][bj][m][0], b = acc[ai][bj][m][1];
                    u32x4 w; w.x = cvt_pk_bf16(a[0], a[1]); w.y = cvt_pk_bf16(a[2], a[3]); w.z = cvt_pk_bf16(b[0], b[1]); w.w = cvt_pk_bf16(b[2], b[3]);
                    p[((ai * 2 + bj) * 4 + m) * 512] = w; }
    }
};
}

constexpr int NPL = 3840;
constexpr size_t WT_IN = WS_WT, WT_OUT = WS_WT + 8 * MiB, WT_1 = WS_WT + 10 * MiB, WT_2 = WS_WT + 18 * MiB;

template <int EPI, class Sched>
DI void phase_rstd_lds(const Ctx& c, const Sched& S, const float* RSS, LAS float* rsl, int l) {
    f32x4 pv[3][4]; float bias[3]; bool live[3], nobias[3];
#pragma unroll
    for (int j = 0; j < 3; ++j) { const int idx = c.tid + NTHR * j, i = idx >> 8, row = idx & 255; pg8::Unit u; u.pm = 0; u.pn = 0;
        live[j] = (idx < 5 * 256) && S.next(i, u);
        const int r = live[j] ? u.pm * pg8::BM + row : 0; const f32x4* p = (const f32x4*)(RSS + (size_t)r * 16);
#pragma unroll
        for (int q = 0; q < 4; ++q) pv[j][q] = p[q];
        const int mb = pg8::tile_mb(u.pm), cc = u.pn * pg8::BM + row;
        const float* bp = (EPI == EPI_PROJ) ? (const float*)(c.ws + WS_SWIN) + (size_t)(l * 5 + mb) * IN_COLS + ((live[j] && u.pn < 14) ? (cc >= 2048 ? cc + 16 : cc) : 0)
                                            : (const float*)(c.ws + WS_SW1) + (size_t)(l * 5 + mb) * FF + (live[j] ? cc : 0);
        bias[j] = *bp; nobias[j] = (EPI == EPI_PROJ) && (u.pn >= 14); }
#pragma unroll
    for (int j = 0; j < 3; ++j) { const int idx = c.tid + NTHR * j, i = idx >> 8, row = idx & 255;
        if (live[j]) { const f32x4 t = (pv[j][0] + pv[j][1]) + (pv[j][2] + pv[j][3]);
            rsl[i * 512 + row] = rsqrtf(((t.x + t.y) + (t.z + t.w)) * (1.f / D) + EPS); rsl[i * 512 + 256 + row] = nobias[j] ? 0.f : bias[j]; } }
    __syncthreads();
}
template <int EPI>
DI void phase_gemm_fast(const Ctx& c, int l) {
    if (EPI == EPI_PROJ) {
        pg8::GemmT<NPL, D, D> g{(const bf16*)(c.ws + WS_A), (const bf16*)(c.ws + WT_IN)}; pg8::StaticOrderT<NPL> S{c.G, c.bid};
        LAS float* rsl = (LAS float*)(c.lds + pg8::STAGE_BYTES); phase_rstd_lds<EPI_PROJ>(c, S, (const float*)(c.ws + WS_RSSP1), rsl, l); pg8::EpiProj E{l, rsl, 0};
        pg8::gemm_phase<pg8::EpiProj, pg8::StaticOrderT<NPL>, pg8::GemmT<NPL, D, D>, true, true>(c.lds, g, S, E, c.tid);
    } else if (EPI == EPI_H) {
        pg8::GemmT<FF, D, D> g{(const bf16*)(c.ws + WS_A), (const bf16*)(c.ws + WT_1)}; pg8::StaticOrderT<FF> S{c.G, c.bid};
        LAS float* rsl = (LAS float*)(c.lds + pg8::STAGE_BYTES); phase_rstd_lds<EPI_H>(c, S, (const float*)(c.ws + WS_RSSP2), rsl, l); pg8::EpiH E{l, rsl, 0};
        pg8::gemm_phase<pg8::EpiH, pg8::StaticOrderT<FF>, pg8::GemmT<FF, D, D>, true, true>(c.lds, g, S, E, c.tid);
    } else if (EPI == EPI_RES1) {
        pg8::GemmT<D, D, NP> g{(const bf16*)(c.ws + WS_R1) + 2560, (const bf16*)(c.ws + WT_OUT)}; pg8::StaticOrderT<D> S{c.G, c.bid}; pg8::EpiRes<1> E{l};
        pg8::gemm_phase<pg8::EpiRes<1>, pg8::StaticOrderT<D>, pg8::GemmT<D, D, NP>, true, true>(c.lds, g, S, E, c.tid);
    } else {
        pg8::GemmT<D, FF, FF> g{(const bf16*)(c.ws + WS_R1), (const bf16*)(c.ws + WT_2)}; pg8::StaticOrderT<D> S{c.G, c.bid}; pg8::EpiRes<2> E{l};
        pg8::gemm_phase<pg8::EpiRes<2>, pg8::StaticOrderT<D>, pg8::GemmT<D, FF, FF>, true, true>(c.lds, g, S, E, c.tid);
    }
}

constexpr size_t WS_SLAB = WS_QKVN;
DI void phase_g4_main(const Ctx& c, int l) {
    { pg8::GemmT<D, FF, FF> g{(const bf16*)(c.ws + WS_R1), (const bf16*)(c.ws + WT_2)}; pg8::FirstRoundOrder S{c.bid}; pg8::EpiRes<2> E{l};
      pg8::gemm_phase<pg8::EpiRes<2>, pg8::FirstRoundOrder, pg8::GemmT<D, FF, FF>, true, true>(c.lds, g, S, E, c.tid); }
    { const int kq = c.bid & 3;
      pg8::GemmT<D, 1024, FF, FF> g{(const bf16*)(c.ws + WS_R1) + kq * 1024, (const bf16*)(c.ws + WT_2) + kq * 1024}; pg8::TailOrder S{c.bid};
      pg8::EpiSlab E{(float*)(c.ws + WS_SLAB) + (size_t)c.bid * 65536, c.tid};
      pg8::gemm_phase<pg8::EpiSlab, pg8::TailOrder, pg8::GemmT<D, 1024, FF, FF>, true, true>(c.lds, g, S, E, c.tid); }
}
DI void phase_g4_combine(const Ctx& c, int l) {
    pg8::Unit u; { pg8::StaticOrderT<1024> S{256, c.bid >> 2}; S.next(1, u); }
    const char* ub = (const char*)(c.ws + WS_SLAB) + (size_t)(c.bid >> 2) * 4 * 262144;
    const unsigned lo = (unsigned)c.tid * 16u;
    const int wid = c.wave, lane = c.tid & 63, fr = lane & 15, fq = lane >> 4, part = c.bid & 3;
    pg8::EpiRes<2> E{l}; pg8::EpiRes<2>::Cols q; E.prepare(q, u, wid >> 2, wid & 3, fr, fq);
    pg8::EpiRes<2>::RowX xin[2];
#pragma unroll
    for (int g2 = 0; g2 < 2; ++g2) { const int rg = part * 2 + g2; E.rowload<false>(q, rg >> 2, rg & 3, xin[g2]); }
    f32x4 v[2][2][2];
#pragma unroll
    for (int g2 = 0; g2 < 2; ++g2) { const int rg = part * 2 + g2;
#pragma unroll
        for (int bj = 0; bj < 2; ++bj)
            { const int e = (((rg >> 2) * 2 + bj) * 4 + (rg & 3)) * 8192;
                const u32x4 a0 = NTL(u32x4, ub + e + lo), a1 = NTL(u32x4, ub + 262144 + e + lo), a2 = NTL(u32x4, ub + 2 * 262144 + e + lo), a3 = NTL(u32x4, ub + 3 * 262144 + e + lo);
#define SLB_LO(w) __builtin_bit_cast(float, (w) << 16)
#define SLB_HI(w) __builtin_bit_cast(float, (w) & 0xffff0000u)
#define SLB_V0(a) ((f32x4){SLB_LO(a.x), SLB_HI(a.x), SLB_LO(a.y), SLB_HI(a.y)})
#define SLB_V1(a) ((f32x4){SLB_LO(a.z), SLB_HI(a.z), SLB_LO(a.w), SLB_HI(a.w)})
                v[g2][bj][0] = (SLB_V0(a0) + SLB_V0(a1)) + (SLB_V0(a2) + SLB_V0(a3));
                v[g2][bj][1] = (SLB_V1(a0) + SLB_V1(a1)) + (SLB_V1(a2) + SLB_V1(a3)); } }
#pragma unroll
    for (int g2 = 0; g2 < 2; ++g2) { const int rg = part * 2 + g2; E.rowcompute(q, rg >> 2, rg & 3, v[g2], xin[g2], fr, fq); }
}

DI void wconv_item(const float* W, int ldw, int K, int nblk, bf16* WT, LAS float* scr, int item, int lane, bool remap) {
    const int kb = item / nblk, nb = item % nblk, k0 = 64 * kb, n0 = 32 * nb; const int ns = (remap && n0 >= 2048) ? n0 + 16 : n0;
    { const int rr = lane >> 3, c4 = (lane & 7) * 4;
        f32x4 v[8];
#pragma unroll
        for (int i = 0; i < 8; ++i) v[i] = __builtin_nontemporal_load((const f32x4*)(W + (size_t)(k0 + rr + 8 * i) * ldw + ns + c4));
#pragma unroll
        for (int i = 0; i < 8; ++i) { LAS float* sp = scr + (rr + 8 * i) * 33 + c4; sp[0] = v[i][0]; sp[1] = v[i][1]; sp[2] = v[i][2]; sp[3] = v[i][3]; } }
    asm volatile("s_waitcnt lgkmcnt(0)" ::: "memory");
    const int cch = lane & 7;
#pragma unroll
    for (int j = 0; j < 4; ++j) { const int n = (lane >> 3) + 8 * j; const LAS float* sp = scr + (8 * cch) * 33 + n;
        u32x4 o; o.x = pk2(sp[0 * 33], sp[1 * 33]); o.y = pk2(sp[2 * 33], sp[3 * 33]); o.z = pk2(sp[4 * 33], sp[5 * 33]); o.w = pk2(sp[6 * 33], sp[7 * 33]);
        *(u32x4*)(WT + (size_t)(n0 + n) * K + k0 + 8 * cch) = o; }
    asm volatile("s_waitcnt lgkmcnt(0)" ::: "memory");
}
DI void wconv_logit_item(const Ctx& c, int l, int kb) {
    const float* W = c.in[9] + (size_t)l * D * IN_COLS + 2048; bf16* WT = (bf16*)(c.ws + WT_IN);
    const int n = c.lane & 31, kh = c.lane >> 5, k0 = 64 * kb + 32 * kh;
    unsigned pk[16]; float xw[32];
#pragma unroll
    for (int i = 0; i < 32; ++i) xw[i] = __builtin_nontemporal_load(W + (size_t)(k0 + i) * IN_COLS + (n & 15));
    __builtin_amdgcn_sched_barrier(0);
#pragma unroll
    for (int i = 0; i < 16; ++i) { const float x0 = xw[2 * i], x1 = xw[2 * i + 1];
        const bf16 h0 = f2bf(x0), h1 = f2bf(x1);
        pk[i] = n < 16 ? ((unsigned)h0 | ((unsigned)h1 << 16)) : pk2(x0 - bf2f(h0), x1 - bf2f(h1)); }
    u32x4* dst = (u32x4*)(WT + (size_t)(NP + n) * D + k0);
#pragma unroll
    for (int q = 0; q < 4; ++q) { u32x4 o; o.x = pk[4 * q]; o.y = pk[4 * q + 1]; o.z = pk[4 * q + 2]; o.w = pk[4 * q + 3]; dst[q] = o; }
}
DI void wconv_zero_rows(const Ctx& c) {
    u32x4* z = (u32x4*)((bf16*)(c.ws + WT_IN) + (size_t)(NP + 32) * D); const u32x4 zero4 = {0u, 0u, 0u, 0u};
    for (int i = c.bid * NTHR + c.tid; i < (NPL - NP - 32) * D / 8; i += c.G * NTHR) z[i] = zero4;
}
DI void wconv_wave_item(const Ctx& c, int l, int set, int r) {
    LAS float* scr = (LAS float*)(c.lds + c.wave * 16384);
    if (set == 0) { if (r < 16 * 112) wconv_item(c.in[9] + (size_t)l * D * IN_COLS, IN_COLS, D, 112, (bf16*)(c.ws + WT_IN), scr, r, c.lane, true); else if (r < 16 * 112 + 16) wconv_logit_item(c, l, r - 16 * 112); return; }
    constexpr int I_OUT = 16 * 32, I_1 = 16 * 128, I_2 = 64 * 32;
    if (r < I_OUT) { wconv_item(c.in[23] + (size_t)l * D * D, D, D, 32, (bf16*)(c.ws + WT_OUT), scr, r, c.lane, false); return; } r -= I_OUT;
    if (r < I_1) { wconv_item(c.in[24] + (size_t)l * D * FF, FF, D, 128, (bf16*)(c.ws + WT_1), scr, r, c.lane, false); return; } r -= I_1;
    if (r < I_2) wconv_item(c.in[25] + (size_t)l * FF * D, D, FF, 32, (bf16*)(c.ws + WT_2), scr, r, c.lane, false);
}
constexpr int WC_BLK_IN = 226, WC_BLK_REST = 576;
DI void phase_wconv_in(const Ctx& c, int l) {
    for (int bi = c.bid; bi < WC_BLK_IN; bi += c.G) wconv_wave_item(c, l, 0, bi * 8 + c.wave);
    wconv_zero_rows(c);
    __syncthreads();
}
DI void phase_zero(const Ctx& c, size_t off, int nfloats) {
    float* p = (float*)(c.ws + off);
    for (int i = c.bid * NTHR + c.tid; i < nfloats; i += c.G * NTHR) p[i] = 0.f;
}

DI void seg_of_row(int r, int& s0, int& s1) { if (r < NCTX) { s0 = r & ~255; s1 = s0 + 256; } else { s0 = r & ~63; s1 = s0 + 64; } }

DI void phase_prep_naive(const Ctx& c, int l) {
    const bf16* PROJ = (const bf16*)(c.ws + WS_R1);
    bf16* QKVN = (bf16*)(c.ws + WS_QKVN);
    const float* cw = c.in[10] + (size_t)l * 5 * 1536;
    const float* a_log = c.in[11] + l * 8; const float* dt_bias = c.in[12] + l * 8;
    const float* LOGIT = (const float*)(c.ws + WS_LOGIT);
    float* GBG = (float*)(c.ws + WS_GBG); float* GBB = (float*)(c.ws + WS_GBB);
    const int gw = c.bid * NWAVES + c.wave, NGW = c.G * NWAVES;
    for (int task = gw; task < NTOK * 4; task += NGW) {
        const int r = task >> 2, h = task & 3; int s0, s1; seg_of_row(r, s0, s1);
#pragma unroll
        for (int p = 0; p < 3; ++p) {
            const int col = p * 512 + h * 128 + 2 * c.lane;
            float y0 = 0.f, y1 = 0.f;
#pragma unroll
            for (int j = 0; j < 5; ++j) { const int rr = r + j - 2;
                if (rr >= s0 && rr < s1) { const unsigned u = *(const unsigned*)(PROJ + (size_t)rr * NP + col); const f32x2 w = *(const f32x2*)(cw + j * 1536 + col);
                    y0 += w.x * bf2f((bf16)(u & 0xffffu)); y1 += w.y * bf2f((bf16)(u >> 16)); } }
            y0 = silu_f(y0); y1 = silu_f(y1);
            if (p < 2) { const float ss = wave_sum(y0 * y0 + y1 * y1, c.lane); float sc = rsqrtf(ss + EPS); if (p == 0) sc *= 0.08838834764831845f; y0 *= sc; y1 *= sc; }
            *(unsigned*)(QKVN + (size_t)r * 1536 + col) = pk2(y0, y1);
        }
        if (c.lane < 2) { const int dir = c.lane, idx = dir * 4 + h;
            const float al = LOGIT[(size_t)r * 16 + idx], bl = LOGIT[(size_t)r * 16 + 8 + idx];
            GBG[(size_t)r * 8 + idx] = -__expf(a_log[idx]) * softplus_f(al + dt_bias[idx]);
            GBB[(size_t)r * 8 + idx] = sigmoid_f(bl); }
    }
}
DI void phase_hyprep_naive(const Ctx& c, int l) {
    const bf16* PROJ = (const bf16*)(c.ws + WS_R1);
    const float* hw = c.in[14] + (size_t)l * 3 * 1536;
    bf16* X0C = (bf16*)(c.ws + WS_X0C); bf16* ZZT = (bf16*)(c.ws + WS_ZZT);
    for (size_t i = (size_t)c.bid * NTHR + c.tid; i < (size_t)NTOK * 512; i += (size_t)c.G * NTHR) {
        const int r = (int)(i >> 9), ch = (int)(i & 511); int s0, s1; seg_of_row(r, s0, s1);
        float y[3] = {0.f, 0.f, 0.f};
#pragma unroll
        for (int j = 0; j < 3; ++j) { const int rr = r + j - 1;
            if (rr >= s0 && rr < s1) {
#pragma unroll
                for (int p = 0; p < 3; ++p) y[p] += hw[j * 1536 + p * 512 + ch] * bf2f(PROJ[(size_t)rr * NP + 2048 + p * 512 + ch]); } }
        X0C[(size_t)r * 512 + ch] = f2bf(y[0]);
        ZZT[(size_t)ch * NTOK + r] = f2bf(y[1] * y[2]);
    }
}

DI void phase_scan_naive(const Ctx& c, int l) {
    const bf16* QKVN = (const bf16*)(c.ws + WS_QKVN);
    const float* GBG = (const float*)(c.ws + WS_GBG); const float* GBB = (const float*)(c.ws + WS_GBB);
    bf16* OF = (bf16*)(c.ws + WS_OF); bf16* OB = (bf16*)(c.ws + WS_OB);
    const float* state_in = c.in[2]; float* state_out = c.out + (size_t)NTOK * D;
    constexpr int TB = 32;
    LAS float* qs = (LAS float*)c.lds;
    LAS float* ks = qs + TB * 256;
    LAS float* vs = ks + TB * 256;
    LAS float* gs = vs + TB * 256;
    LAS float* bs = gs + TB * 2;
    const int half = c.lane >> 5, dv = (c.wave & 3) * 32 + (c.lane & 31), hl = c.wave >> 2;
    for (int task = c.bid; task < 80; task += c.G) {
        const int s = task >> 2, dir = (task >> 1) & 1, hp = task & 1, h = hp * 2 + hl;
        const bool isctx = s < 16; const int L = isctx ? 256 : 4096, row0 = isctx ? s * 256 : NCTX + (s - 16) * 4096;
        float S[64];
        if (isctx) {
#pragma unroll
            for (int k = 0; k < 64; ++k) S[k] = 0.f;
        } else { const float* sp = state_in + ((((size_t)(s - 16) * 4 + l) * 2 + dir) * 4 + h) * 16384 + (size_t)(half * 64) * 128 + dv;
#pragma unroll
            for (int k = 0; k < 64; ++k) S[k] = sp[(size_t)k * 128]; }
        bf16* O = dir == 0 ? OF : OB;
        for (int i0 = 0; i0 < L; i0 += TB) {
            __syncthreads();
            { const int cc = c.tid & 255, jj = c.tid >> 8;
#pragma unroll 4
              for (int j = jj; j < TB; j += 2) { const int i = i0 + j, t = dir == 0 ? i : L - 1 - i, r = row0 + t; const bf16* src = QKVN + (size_t)r * 1536 + hp * 256 + cc;
                qs[j * 256 + cc] = bf2f(src[0]); ks[j * 256 + cc] = bf2f(src[512]); vs[j * 256 + cc] = bf2f(src[1024]); } }
            if (c.tid < TB * 2) { const int j = c.tid >> 1, hh = c.tid & 1, i = i0 + j, t = dir == 0 ? i : L - 1 - i, r = row0 + t;
                gs[c.tid] = __expf(GBG[(size_t)r * 8 + dir * 4 + hp * 2 + hh]); bs[c.tid] = GBB[(size_t)r * 8 + dir * 4 + hp * 2 + hh]; }
            __syncthreads();
            for (int j = 0; j < TB; ++j) {
                const float a = gs[j * 2 + hl], be = bs[j * 2 + hl];
                const LAS f32x4* kp = (const LAS f32x4*)(ks + j * 256 + hl * 128 + half * 64); const LAS f32x4* qp = (const LAS f32x4*)(qs + j * 256 + hl * 128 + half * 64);
                float rr = 0.f;
#pragma unroll
                for (int k4 = 0; k4 < 16; ++k4) { const f32x4 kk = kp[k4]; rr += kk.x * S[4 * k4] + kk.y * S[4 * k4 + 1] + kk.z * S[4 * k4 + 2] + kk.w * S[4 * k4 + 3]; }
                rr += shx(rr, 32, c.lane);
                const float delta = be * (vs[j * 256 + hl * 128 + dv] - a * rr);
                float o = 0.f;
#pragma unroll
                for (int k4 = 0; k4 < 16; ++k4) { const f32x4 kk = kp[k4], qq = qp[k4];
                    S[4 * k4] = a * S[4 * k4] + kk.x * delta; S[4 * k4 + 1] = a * S[4 * k4 + 1] + kk.y * delta; S[4 * k4 + 2] = a * S[4 * k4 + 2] + kk.z * delta; S[4 * k4 + 3] = a * S[4 * k4 + 3] + kk.w * delta;
                    o += qq.x * S[4 * k4] + qq.y * S[4 * k4 + 1] + qq.z * S[4 * k4 + 2] + qq.w * S[4 * k4 + 3]; }
                o += shx(o, 32, c.lane);
                const int i = i0 + j, t = dir == 0 ? i : L - 1 - i, r = row0 + t;
                if (half == 0) O[(size_t)r * 512 + h * 128 + dv] = f2bf(o);
            }
        }
        if (isctx) { float* sp = state_out + ((((size_t)s * 4 + l) * 2 + dir) * 4 + h) * 16384 + (size_t)(half * 64) * 128 + dv;
#pragma unroll
            for (int k = 0; k < 64; ++k) sp[(size_t)k * 128] = S[k]; }
    }
}

constexpr int HY_R4L = 0, HY_CSL = 8192 * 2 + 64, HY_R4C = 4 * HY_CSL, HY_CSC = 512 * 2 + 64, HY_ZL = HY_R4C + 4 * HY_CSC, HY_ZLS = (4096 + 1024) * 2 + 80 * 16 + 64  , HY_ZC = HY_ZL + 4 * HY_ZLS, HY_ZCS = (256 + 256) * 2 + 32, HY_END = HY_ZC + 16 * HY_ZCS;
static_assert(HY_END <= 146944 && HY_ZLS % 256 == 64 && HY_R4C % 16 == 0 && HY_ZL % 16 == 0 && HY_ZC % 16 == 0 && HY_ZLS % 16 == 0 && HY_ZCS % 16 == 0, "hyena LDS map");

template <int L, int NB>
DI void toep_wave(LAS const unsigned char* R4, const int cstride, LAS const unsigned char* Z, const int zstride, const int w, const int lane, bf16* outb) {
    constexpr int BPW = 32 / NB, ZPAD = (BPW == 8) ? 512 : 128;
    const int n = lane & 31, hh = lane >> 5;
    const int d_lo = 64 * BPW * w - (L - 16), d_hi = 64 * (BPW * w + BPW - 1), nst = (d_hi - d_lo) / 16 + 1;
    const int rb = n % NB, rblk = BPW * w + n / NB;
    constexpr bool PADZ = (L == 4096);
    const int E0 = ZPAD + 64 * rblk - d_lo + 8 * hh;
    const int abase = rb * zstride + E0 * 2 + (PADZ ? 16 * (E0 >> 6) : 0);
#define HY_AOFF(m) (-(32 * (m) + (PADZ ? 16 * ((m) >> 2) : 0)))
    const int Q0 = L - n - d_lo + 8 * hh, sh = Q0 & 3;
    int baddr = sh * cstride + (Q0 - sh) * 2;
    const int bmin = sh * cstride;
    f32x16 acc0, acc1;
#pragma unroll
    for (int i = 0; i < 16; ++i) { acc0[i] = 0.f; acc1[i] = 0.f; }
#define HY_LDB(dst, off) do { const s16x4v lo_ = *(const volatile LAS s16x4v*)(R4 + baddr + (off)); const s16x4v hi_ = *(const volatile LAS s16x4v*)(R4 + baddr + (off) + 8);     dst = __builtin_shufflevector(lo_, hi_, 0, 1, 2, 3, 4, 5, 6, 7); } while (0)
    bf16x8v F[6], A[3];
    HY_LDB(F[0], 0); HY_LDB(F[1], -32); HY_LDB(F[2], -64); HY_LDB(F[3], -96); HY_LDB(F[4], -128);
    A[0] = *(const LAS bf16x8v*)(Z + abase + HY_AOFF(0)); A[1] = *(const LAS bf16x8v*)(Z + abase + HY_AOFF(1));
    baddr = max(baddr - 160, bmin);
#define HY_STEP(j) do { \
        A[((j) + 2) % 3] = *(const LAS bf16x8v*)(Z + abase + HY_AOFF(k + (j) + 2));        \
        HY_LDB(F[((j) + 5) % 6], 0);                                                        \
        baddr = max(baddr - 32, bmin); \
        __builtin_amdgcn_sched_barrier(0); \
        acc0 = __builtin_amdgcn_mfma_f32_32x32x16_bf16(A[(j) % 3], F[(j) % 6], acc0, 0, 0, 0); \
        acc1 = __builtin_amdgcn_mfma_f32_32x32x16_bf16(A[(j) % 3], F[((j) + 2) % 6], acc1, 0, 0, 0); \
        __builtin_amdgcn_sched_barrier(0); } while (0)
    int k = 0;
    for (; k + 6 <= nst; k += 6) { HY_STEP(0); HY_STEP(1); HY_STEP(2); HY_STEP(3); HY_STEP(4); HY_STEP(5); }
    if (k + 0 < nst) HY_STEP(0);
    if (k + 1 < nst) HY_STEP(1);
    if (k + 2 < nst) HY_STEP(2);
    if (k + 3 < nst) HY_STEP(3);
    if (k + 4 < nst) HY_STEP(4);
#undef HY_STEP
#undef HY_AOFF
#undef HY_LDB
#pragma unroll
    for (int i = 0; i < 16; ++i) { const int ri = (i & 3) + 8 * (i >> 2) + 4 * hh, ob = ri % NB, oblk = BPW * w + ri / NB;
        bf16* op = outb + (size_t)ob * L + 64 * oblk + n;
        op[0] = f2bf(acc0[i]); op[32] = f2bf(acc1[i]); }
}

DI void hyena_channel(const Ctx& c, int l, int ch) {
    bf16* ZZT = (bf16*)(c.ws + WS_ZZT);
    const bf16* RL = (const bf16*)(c.ws + WS_FILT + (l & 1) * FILT_SLOT); const bf16* RC = RL + 8 * MiB / 2;
    LAS unsigned char* lds = c.lds;
    {
        u32x4 zv[4], zc; bf16 rcv;
#pragma unroll
        for (int j = 0; j < 4; ++j) { const int e = c.tid * 8; zv[j] = NTL(u32x4, ZZT + (size_t)ch * NTOK + NCTX + j * 4096 + e); }
        { const int b = c.tid >> 5, e = (c.tid & 31) * 8; zc = NTL(u32x4, ZZT + (size_t)ch * NTOK + b * 256 + e); }
        rcv = RC[(size_t)ch * 512 + c.tid];
        { u32x4 rv[2]; u32x2 rn[2];
#pragma unroll
          for (int i = 0; i < 2; ++i) { const int p0 = (c.tid + NTHR * i) * 8; rv[i] = NTL(u32x4, RL + (size_t)ch * 8192 + p0);
              rn[i] = NTL(u32x2, RL + (size_t)ch * 8192 + ((p0 + 8 < 8192) ? p0 + 8 : p0)); if (p0 + 8 >= 8192) rn[i] = (u32x2){0u, 0u}; }
          __builtin_amdgcn_sched_barrier(0);
#pragma unroll
          for (int i = 0; i < 2; ++i) { const int p0 = (c.tid + NTHR * i) * 8;
              const unsigned w0 = rv[i].x, w1 = rv[i].y, w2 = rv[i].z, w3 = rv[i].w, w4 = rn[i].x, w5 = rn[i].y;
#define HY_AB(hi, lo) __builtin_amdgcn_alignbit((hi), (lo), 16u)
              *(LAS u32x4*)(lds + HY_R4L + 0 * HY_CSL + p0 * 2) = rv[i];
              *(LAS u32x4*)(lds + HY_R4L + 1 * HY_CSL + p0 * 2) = (u32x4){HY_AB(w1, w0), HY_AB(w2, w1), HY_AB(w3, w2), HY_AB(w4, w3)};
              *(LAS u32x4*)(lds + HY_R4L + 2 * HY_CSL + p0 * 2) = (u32x4){w1, w2, w3, w4};
              *(LAS u32x4*)(lds + HY_R4L + 3 * HY_CSL + p0 * 2) = (u32x4){HY_AB(w2, w1), HY_AB(w3, w2), HY_AB(w4, w3), HY_AB(w5, w4)};
#undef HY_AB
          } }
        { const int q = c.tid; const bf16 v = rcv;
#pragma unroll
            for (int sft = 0; sft < 4; ++sft) if (q - sft >= 0) *(LAS bf16*)(lds + HY_R4C + sft * HY_CSC + (q - sft) * 2) = v; }
        const u32x4 zero4 = {0u, 0u, 0u, 0u};
#pragma unroll
        for (int b = 0; b < 4; ++b) { const int e = c.tid * 8;
            *(LAS u32x4*)(lds + HY_ZL + b * HY_ZLS + (512 + e) * 2 + 16 * ((512 + e) >> 6)) = zv[b]; }
        { const int b = c.tid >> 7, side = (c.tid >> 6) & 1, e = (c.tid & 63) * 8; const int el = side ? 512 + 4096 + e : e;
            *(LAS u32x4*)(lds + HY_ZL + b * HY_ZLS + el * 2 + 16 * (el >> 6)) = zero4; }
        { const int b = c.tid >> 5, e = (c.tid & 31) * 8;
            *(LAS u32x4*)(lds + HY_ZC + b * HY_ZCS + (128 + e) * 2) = zc;
            const int side = (c.tid >> 4) & 1, e2 = (c.tid & 15) * 8;
            *(LAS u32x4*)(lds + HY_ZC + b * HY_ZCS + (side ? 128 + 256 + e2 : e2) * 2) = zero4; }
        __syncthreads();
        toep_wave<4096, 4>(lds + HY_R4L, HY_CSL, lds + HY_ZL, HY_ZLS, c.wave, c.lane, ZZT + (size_t)ch * NTOK + NCTX);
        if (c.wave < 2) toep_wave<256, 16>(lds + HY_R4C, HY_CSC, lds + HY_ZC, HY_ZCS, c.wave, c.lane, ZZT + (size_t)ch * NTOK);
    }
}
DI void hyprep_tile(const Ctx& c, int l, int t);
DI void scan_chain(const Ctx& c, int l, int seq, int h, int dir, int half);
DI void phase_queue(const Ctx& c, int l) {
    LAS unsigned char* lds = c.lds;
    unsigned* qhead = (unsigned*)(c.ws + WS_CTL) + 2048 + 64 * l;
    volatile LAS unsigned* qslot = (volatile LAS unsigned*)(lds + 146944 + 64);
    const bool nx = l + 1 < DEPTH;
    constexpr int N_LAT = 64, N_CTX = 256;
    constexpr int N_HP = (NTOK / 64) * 8;
    const int n_f = nx ? 68 : 0, n_wr = 64, n_wi = 0;
    const int e_lat = N_LAT, e_hp = e_lat + N_HP / 4, e_f = e_hp + n_f, e_w = e_f + n_wr, e_hy = e_w + 512, e_ctx = e_hy + N_CTX;
    unsigned* hpdone = (unsigned*)(c.ws + WS_CTL) + 3072 + 64 * l;
    int my_hp = 0; bool gated = false, published = false;
    unsigned nxt = 0u; int qk = 0;
    if (c.wave == 0 && fresh_lane() == 0) nxt = __hip_atomic_fetch_add(qhead, 1u, __ATOMIC_RELAXED, __HIP_MEMORY_SCOPE_AGENT);
    for (;;) {
        if (c.wave == 0 && fresh_lane() == 0) qslot[qk] = nxt;
        __syncthreads();
        const int it = (int)qslot[qk]; qk ^= 1;
        const bool chain_item = (it < e_lat) || (it >= e_hy && it < e_ctx);
        if (!chain_item && c.wave == 0 && fresh_lane() == 0) nxt = __hip_atomic_fetch_add(qhead, 1u, __ATOMIC_RELAXED, __HIP_MEMORY_SCOPE_AGENT);
        Ctx cq = c; { const int lq = fresh_lane(); cq.lane = lq; cq.tid = c.wave * 64 + lq; }
        if (it < e_lat) { const int ch = it >> 1;
            scan_chain(cq, l, 16 + (ch >> 3), (ch >> 1) & 3, ch & 1, it & 1);
            if (c.wave == 0 && fresh_lane() == 0) nxt = __hip_atomic_fetch_add(qhead, 1u, __ATOMIC_RELAXED, __HIP_MEMORY_SCOPE_AGENT);
            continue; }
        if (it < e_hp) { hyprep_tile(cq, l, it - e_lat); my_hp += 4; continue; }
        if (!published) {
            asm volatile("s_waitcnt vmcnt(0)" ::: "memory");
            __syncthreads();
            if (cq.tid == 0 && my_hp > 0) { __builtin_amdgcn_fence(__ATOMIC_RELEASE, "agent"); asm volatile("s_waitcnt vmcnt(0)" ::: "memory");
                (void)__hip_atomic_fetch_add(hpdone, (unsigned)my_hp, __ATOMIC_RELAXED, __HIP_MEMORY_SCOPE_AGENT); }
            published = true;
        }
        if (it < e_f) { filters_task(cq, l + 1, it - e_hp); continue; }
        if (it < e_w) { wconv_wave_item(cq, l, 1, (it - e_f) * 8 + c.wave); continue; }
        if (!gated) {
            if (cq.tid == 0) {
                unsigned spins = 0;
                while (__hip_atomic_load(hpdone, __ATOMIC_RELAXED, __HIP_MEMORY_SCOPE_AGENT) < (unsigned)N_HP) { __builtin_amdgcn_s_sleep(8); if (++spins > (1u << 24)) break; }
                __builtin_amdgcn_fence(__ATOMIC_ACQUIRE, "agent"); asm volatile("s_waitcnt vmcnt(0)" ::: "memory");
            }
            __syncthreads();
            gated = true;
        }
        if (it < e_hy) { hyena_channel(cq, l, it - e_w); continue; }
        if (it < e_ctx) { const int j = it - e_hy, ch = j >> 1;
            scan_chain(cq, l, ch >> 3, (ch >> 1) & 3, ch & 1, j & 1);
            if (c.wave == 0 && fresh_lane() == 0) nxt = __hip_atomic_fetch_add(qhead, 1u, __ATOMIC_RELAXED, __HIP_MEMORY_SCOPE_AGENT);
            continue; }
        break;
    }
}

DI void phase_hyena_out(const Ctx& c) {
    const bf16* YT = (const bf16*)(c.ws + WS_ZZT); const bf16* X0C = (const bf16*)(c.ws + WS_X0C); bf16* PROJ = (bf16*)(c.ws + WS_R1);
    LAS bf16* tile = (LAS bf16*)c.lds;
    const int chl = c.tid >> 3, e = (c.tid & 7) * 8;
    const int rl = c.tid >> 3, cg = (c.tid & 7) * 8;
    constexpr int NT = (NTOK / 64) * 8;
    u32x4 v = {0u, 0u, 0u, 0u}, xn = {0u, 0u, 0u, 0u};
    if (c.bid < NT) { const int r0 = (c.bid >> 3) * 64, ch0 = (c.bid & 7) * 64;
        v = NTL(u32x4, YT + (size_t)(ch0 + chl) * NTOK + r0 + e); xn = NTL(u32x4, X0C + (size_t)(r0 + rl) * 512 + ch0 + cg); }
    for (int t = c.bid; t < NT; t += c.G) {
        const int rt = t >> 3, ct = t & 7, r0 = rt * 64, ch0 = ct * 64;
        __syncthreads();
        { LAS unsigned* tp = (LAS unsigned*)(tile + chl * 66 + e); tp[0] = v.x; tp[1] = v.y; tp[2] = v.z; tp[3] = v.w; }
        const u32x4 xv = xn;
        if (t + c.G < NT) { const int t2 = t + c.G, r2 = (t2 >> 3) * 64, c2 = (t2 & 7) * 64;
            v = NTL(u32x4, YT + (size_t)(c2 + chl) * NTOK + r2 + e); xn = NTL(u32x4, X0C + (size_t)(r2 + rl) * 512 + c2 + cg); }
        __syncthreads();
        { const unsigned xw[4] = {xv.x, xv.y, xv.z, xv.w}; unsigned ow[4];
#pragma unroll
            for (int p = 0; p < 4; ++p) { const f32x2 yv = {bf2f(tile[(cg + 2 * p) * 66 + rl]), bf2f(tile[(cg + 2 * p + 1) * 66 + rl])};
                const f32x2 pr2 = (f32x2){__builtin_bit_cast(float, xw[p] << 16), __builtin_bit_cast(float, xw[p] & 0xffff0000u)} * yv; ow[p] = cvtpk_hw(pr2.x, pr2.y); }
            u32x4 o; o.x = ow[0]; o.y = ow[1]; o.z = ow[2]; o.w = ow[3];
            *(u32x4*)(PROJ + (size_t)(r0 + rl) * NP + 3072 + ch0 + cg) = o; }
    }
}

DI void phase_logit(const Ctx& c, int l, int wg, int nwg) {
    const float* MOD = (const float*)(c.ws + WS_MOD); const float* ng = c.in[7] + l * 1024; const float* RSS = (const float*)(c.ws + WS_RSSP1);
    float* LOGIT = (float*)(c.ws + WS_LOGIT);
    const float* w16 = c.in[9] + (size_t)l * 1024 * IN_COLS + 2048;
    LAS float* W = (LAS float*)c.lds;
    __syncthreads();
    for (int i = c.tid; i < 4096; i += NTHR) { const int k = i >> 2, qd = i & 3; const f32x4 v = *(const f32x4*)(w16 + (size_t)k * IN_COLS + qd * 4);
        *(LAS f32x4*)(W + (((k >> 8) * 4 + (k & 3)) * 64 + ((k >> 2) & 63)) * 20 + qd * 4) = v; }
    __syncthreads();
    const int lane = c.lane;
    for (int r = wg * 8 + c.wave; r < NTOK; r += nwg * 8) {
        const int mb = mod_of_row(r); const float* mrow = MOD + (size_t)(l * 5 + mb) * 6144;
        const float rstd = rsqrtf(rss_read(RSS, r) * (1.f / D) + EPS);
        float lgv[16];
#pragma unroll
        for (int q2 = 0; q2 < 16; ++q2) lgv[q2] = 0.f;
#pragma unroll
        for (int j = 0; j < 4; ++j) { const int k0 = (lane + 64 * j) * 4;
            const f32x4 xv = *(const f32x4*)(c.X + (size_t)r * D + k0), g4 = *(const f32x4*)(ng + k0), s4 = *(const f32x4*)(mrow + 1024 + k0), sh = *(const f32x4*)(mrow + k0);
            const f32x4 hn = xv * (g4 * (s4 + 1.0f)) * rstd + sh;
#pragma unroll
            for (int e = 0; e < 4; ++e) { const LAS f32x4* wp = (const LAS f32x4*)(W + ((j * 4 + e) * 64 + lane) * 20); const float hv = hn[e];
#pragma unroll
                for (int q2 = 0; q2 < 4; ++q2) { const f32x4 w4 = wp[q2]; lgv[4 * q2] += hv * w4.x; lgv[4 * q2 + 1] += hv * w4.y; lgv[4 * q2 + 2] += hv * w4.z; lgv[4 * q2 + 3] += hv * w4.w; }
                if (e & 1) asm volatile("" ::: "memory"); } }
        float a8[8], a4[4], a2[2];
        { const bool hi = lane & 1;
#pragma unroll
          for (int i = 0; i < 8; ++i) { const float keep = hi ? lgv[8 + i] : lgv[i], send = hi ? lgv[i] : lgv[8 + i]; a8[i] = keep + shx(send, 1, lane); } }
        { const bool hi = lane & 2;
#pragma unroll
          for (int i = 0; i < 4; ++i) { const float keep = hi ? a8[4 + i] : a8[i], send = hi ? a8[i] : a8[4 + i]; a4[i] = keep + shx(send, 2, lane); } }
        { const bool hi = lane & 4;
#pragma unroll
          for (int i = 0; i < 2; ++i) { const float keep = hi ? a4[2 + i] : a4[i], send = hi ? a4[i] : a4[2 + i]; a2[i] = keep + shx(send, 4, lane); } }
        float a1; { const bool hi = lane & 8; const float keep = hi ? a2[1] : a2[0], send = hi ? a2[0] : a2[1]; a1 = keep + shx(send, 8, lane); }
        a1 += shx(a1, 16, lane); a1 += shx(a1, 32, lane);
        if (lane < 16) { const int jj = 8 * (lane & 1) + 4 * ((lane >> 1) & 1) + 2 * ((lane >> 2) & 1) + ((lane >> 3) & 1); LOGIT[(size_t)r * 16 + jj] = a1; }
    }
    __syncthreads();
}

constexpr size_t WS_TM = WS_TMQK, WS_QKM = WS_TMQK + 20 * MiB;
constexpr int PF_QS = 0, PF_KS = 17408, PF_RAW = 34816, PF_CO = PF_RAW + 52224, PF_A = PF_CO + 3 * 1024, PF_ASZ = 2112 * 4;
static_assert(PF_A + 6 * PF_ASZ <= 146944, "prep LDS");
DI int prow(int r) { const int nn = r - 1, G = nn >> 2, rem = nn & 3; return r <= 0 ? 0 : (2 * G * (G + 1) + rem * (G + 1)); }
DI float wave_sum_dpp(float v) {
    v += __builtin_bit_cast(float, __builtin_amdgcn_update_dpp(0, __builtin_bit_cast(int, v), 0xB1, 0xF, 0xF, true));
    v += __builtin_bit_cast(float, __builtin_amdgcn_update_dpp(0, __builtin_bit_cast(int, v), 0x4E, 0xF, 0xF, true));
    v += __builtin_bit_cast(float, __builtin_amdgcn_update_dpp(0, __builtin_bit_cast(int, v), 0x141, 0xF, 0xF, true));
    v += __builtin_bit_cast(float, __builtin_amdgcn_update_dpp(0, __builtin_bit_cast(int, v), 0x140, 0xF, 0xF, true));
    const int iv = __builtin_bit_cast(int, v);
    return (__builtin_bit_cast(float, __builtin_amdgcn_readlane(iv, 0)) + __builtin_bit_cast(float, __builtin_amdgcn_readlane(iv, 16))) + (__builtin_bit_cast(float, __builtin_amdgcn_readlane(iv, 32)) + __builtin_bit_cast(float, __builtin_amdgcn_readlane(iv, 48)));
}
struct PrepRegs { u32x4 v[7]; float lg[4]; float ag[4]; };
DI void prep_load(const Ctx& c, int task, int lane, PrepRegs& pr, const float* al, const float* db) {
    const bf16* PROJ = (const bf16*)(c.ws + WS_R1); const float* LOGIT = (const float*)(c.ws + WS_LOGIT);
    const int tidl = c.wave * 64 + lane, chunk = task >> 2, h = task & 3, r0 = chunk * 64; int s0, s1; seg_of_row(r0, s0, s1);
#pragma unroll
    for (int it = 0; it < 7; ++it) { const int u = it * NTHR + tidl;
        if (u < 68 * 48) { const int rr = u / 48, cu = u % 48, p = cu >> 4, c16 = cu & 15; const int r = r0 - 2 + rr; const bool ok = r >= s0 && r < s1;
            const bf16* src = ok ? PROJ + (size_t)r * NP + p * 512 + h * 128 + c16 * 8 : (const bf16*)(c.ws + WS_CTL);
            pr.v[it] = NTL(u32x4, src); } }
    if (c.wave == 0) { const int r = r0 + lane;
#pragma unroll
        for (int q = 0; q < 4; ++q) pr.lg[q] = LOGIT[(size_t)r * 16 + 4 * q + h];
        pr.ag[0] = al[h]; pr.ag[1] = al[4 + h]; pr.ag[2] = db[h]; pr.ag[3] = db[4 + h]; }
}
DI void prep_task(const Ctx& c, int l, int task, int slot, int lane, PrepRegs& pr, int next_task) {
    bf16* QKVN = (bf16*)(c.ws + WS_QKVN);
    const float* cw = c.in[10] + (size_t)l * 5 * 1536;
    const float* a_log = c.in[11] + l * 8; const float* dt_bias = c.in[12] + l * 8;
    float* GBG = (float*)(c.ws + WS_GBG); float* GBB = (float*)(c.ws + WS_GBB);
    bf16* QKM = (bf16*)(c.ws + WS_QKM);
    LAS unsigned char* lds = c.lds;
    LAS float* CO = (LAS float*)(lds + PF_CO + slot * 1024);
    LAS float* Am = (LAS float*)(lds + PF_A + slot * 2 * PF_ASZ);
    const int w = c.wave, tidl = w * 64 + lane;
    const int chunk = task >> 2, h = task & 3, r0 = chunk * 64;
    __syncthreads();
#pragma unroll
    for (int it = 0; it < 7; ++it) { const int u = it * NTHR + tidl;
        if (u < 68 * 48) { const int rr = u / 48, cu = u % 48; *(LAS u32x4*)(lds + PF_RAW + rr * 768 + cu * 16) = pr.v[it]; } }
    const float lg0 = pr.lg[0], lg1 = pr.lg[1], lg2 = pr.lg[2], lg3 = pr.lg[3];
    const float al0 = pr.ag[0], al1 = pr.ag[1], db0 = pr.ag[2], db1 = pr.ag[3];
    f32x2 cwv[3][5];
#pragma unroll
    for (int p = 0; p < 3; ++p)
#pragma unroll
        for (int j = 0; j < 5; ++j) cwv[p][j] = *(const f32x2*)(cw + j * 1536 + p * 512 + h * 128 + 2 * lane);
    asm volatile("" ::: "memory");
    if (next_task >= 0) prep_load(c, next_task, lane, pr, a_log, dt_bias);
    if (w == 0) {
        const int r = r0 + lane;
        const float g0 = -__expf(al0) * softplus_f(lg0 + db0);
        const float g1 = -__expf(al1) * softplus_f(lg1 + db1);
        const float b0 = sigmoid_f(lg2), b1 = sigmoid_f(lg3);
        float x0 = g0, x1 = g1;
#pragma unroll
        for (int o = 1; o < 64; o <<= 1) { const float y0 = shi(x0, (lane - o) & 63), y1 = shi(x1, (lane + o) & 63); if (lane >= o) x0 += y0; if (lane + o < 64) x1 += y1; }
        CO[lane] = x0; CO[64 + lane] = x1; CO[128 + lane] = b0; CO[192 + lane] = b1;
        GBG[(size_t)r * 8 + h] = x0; GBG[(size_t)r * 8 + 4 + h] = x1; GBB[(size_t)r * 8 + h] = b0; GBB[(size_t)r * 8 + 4 + h] = b1;
    }
    __syncthreads();
#pragma unroll
    for (int p = 0; p < 3; ++p) {
        const int col = p * 512 + h * 128 + 2 * lane;
        f32x2 xv[12];
#pragma unroll
        for (int i = 0; i < 12; ++i) { const unsigned u = *(const LAS unsigned*)(lds + PF_RAW + (w * 8 + i) * 768 + p * 256 + lane * 4); xv[i] = (f32x2){__builtin_bit_cast(float, u << 16), __builtin_bit_cast(float, u & 0xffff0000u)}; }
        float y0[8], y1[8];
#pragma unroll
        for (int t = 0; t < 8; ++t) { f32x2 a = {0.f, 0.f};
#pragma unroll
            for (int j = 0; j < 5; ++j) a = __builtin_elementwise_fma(cwv[p][j], xv[t + j], a);
            y0[t] = silu_f(a.x); y1[t] = silu_f(a.y); }
        if (p < 2) {
            float ss[8];
#pragma unroll
            for (int t = 0; t < 8; ++t) ss[t] = wave_sum_dpp(y0[t] * y0[t] + y1[t] * y1[t]);
#pragma unroll
            for (int t = 0; t < 8; ++t) { float sc = rsqrtf(ss[t] + EPS); if (p == 0) sc *= 0.08838834764831845f; y0[t] *= sc; y1[t] *= sc; } }
#pragma unroll
        for (int t = 0; t < 8; ++t) { const int tok = w * 8 + t; const unsigned pk = cvtpk_hw(y0[t], y1[t]);
            *(unsigned*)(QKVN + (size_t)(r0 + tok) * 1536 + col) = pk;
            if (p == 0) *(LAS unsigned*)(lds + PF_QS + tok * 272 + lane * 4) = pk;
            if (p == 1) *(LAS unsigned*)(lds + PF_KS + tok * 272 + lane * 4) = pk; }
    }
    __syncthreads();
    {
        const int mat = w >> 2, ti = (w >> 1) & 1, tj = w & 1, n = lane & 31, hh = lane >> 5;
        f32x16 acc;
#pragma unroll
        for (int i = 0; i < 16; ++i) acc[i] = 0.f;
        const LAS unsigned char* ap = lds + (mat ? PF_QS : PF_KS) + (32 * ti + n) * 272 + hh * 16;
        const LAS unsigned char* bp = lds + PF_KS + (32 * tj + n) * 272 + hh * 16;
#pragma unroll
        for (int ks = 0; ks < 8; ++ks) { const bf16x8v a = *(const LAS bf16x8v*)(ap + ks * 32), b = *(const LAS bf16x8v*)(bp + ks * 32);
            acc = __builtin_amdgcn_mfma_f32_32x32x16_bf16(a, b, acc, 0, 0, 0); }
        const int col = 32 * tj + n; const float gc0c = CO[col], gc1c = CO[64 + col];
        const size_t mb0 = ((size_t)(chunk * 4 + h) * 2 + 0) * 4096, mb1 = mb0 + 4096;
#pragma unroll
        for (int i = 0; i < 16; ++i) { const int row = 32 * ti + (i & 3) + 8 * (i >> 2) + 4 * hh; const float v = acc[i];
            const float d0 = __expf(CO[row] - gc0c), d1 = __expf(CO[64 + row] - gc1c);
            if (mat == 0) { if (col < row) Am[4 * prow(row) + col] = CO[128 + row] * v * d0;
                            if (col > row) Am[2112 + 4 * prow(63 - row) + (63 - col)] = CO[192 + row] * v * d1; }
            else { QKM[mb0 + row * 64 + col] = f2bf(col <= row ? v * d0 : 0.f); QKM[mb1 + (63 - row) * 64 + (63 - col)] = f2bf(col >= row ? v * d1 : 0.f); } }
    }
}
DI void prep_invert(const Ctx& c, int task, int slot, int dir, int lane) {
    bf16* TM = (bf16*)(c.ws + WS_TM);
    const LAS float* Ad = (const LAS float*)(c.lds + PF_A + (slot * 2 + dir) * PF_ASZ);
    const int chunk = task >> 2, h = task & 3;
    bf16* Tg = TM + ((size_t)(chunk * 4 + h) * 2 + dir) * 4096;
    float t[64];
    t[0] = lane == 0 ? 1.f : 0.f; Tg[lane] = f2bf(t[0]);
    f32x4 rowbuf[2][16];
#define PI_RO(i) (4 * (2 * (((i) - 1) >> 2) * ((((i) - 1) >> 2) + 1) + (((i) - 1) & 3) * ((((i) - 1) >> 2) + 1)))
    rowbuf[1][0] = *(const LAS f32x4*)(Ad + PI_RO(1));
#pragma unroll
    for (int i = 1; i < 64; ++i) {
#pragma unroll
        for (int j4 = 8; j4 * 4 < i; ++j4) rowbuf[i & 1][j4] = *(const LAS f32x4*)(Ad + PI_RO(i) + 4 * j4);
        if (i + 1 < 64) {
#pragma unroll
            for (int j4 = 0; j4 * 4 < i + 1 && j4 < 8; ++j4) rowbuf[(i + 1) & 1][j4] = *(const LAS f32x4*)(Ad + PI_RO(i + 1) + 4 * j4); }
        __builtin_amdgcn_sched_barrier(0);
        float a0 = lane == i ? 1.f : 0.f, a1 = 0.f, a2 = 0.f, a3 = 0.f;
#pragma unroll
        for (int j4 = 0; j4 * 4 < i; ++j4) { const f32x4 a4 = rowbuf[i & 1][j4];
            a0 -= a4.x * t[4 * j4];
            if (4 * j4 + 1 < i) a1 -= a4.y * t[4 * j4 + 1];
            if (4 * j4 + 2 < i) a2 -= a4.z * t[4 * j4 + 2];
            if (4 * j4 + 3 < i) a3 -= a4.w * t[4 * j4 + 3]; }
        const float a = (a0 + a1) + (a2 + a3);
        t[i] = a; Tg[i * 64 + lane] = f2bf(a);
        __builtin_amdgcn_sched_barrier(0); }
#undef PI_RO
}
DI void phase_prep_fast(const Ctx& c, int l) {
    PrepRegs pr;
    prep_load(c, c.bid, fresh_lane(), pr, c.in[11] + l * 8, c.in[12] + l * 8);
    for (int b0 = 0; b0 < 5; b0 += 3) {
        const int nb = (5 - b0) < 3 ? (5 - b0) : 3;
        for (int s = 0; s < nb; ++s) { const int task = c.bid + 256 * (b0 + s); if (task < (NTOK / 64) * 4) prep_task(c, l, task, s, fresh_lane(), pr, (b0 + s + 1 < 5) ? task + 256 : -1); }
        __syncthreads();
        if (c.wave < 2 * nb) { const int s = c.wave >> 1, task = c.bid + 256 * (b0 + s); if (task < (NTOK / 64) * 4) prep_invert(c, task, s, c.wave & 1, fresh_lane()); }
        __syncthreads();
    }
}

DI void hyprep_tile(const Ctx& c, int l, int item) {
    const bf16* PROJ = (const bf16*)(c.ws + WS_R1);
    const float* hw = c.in[14] + (size_t)l * 3 * 1536;
    bf16* X0C = (bf16*)(c.ws + WS_X0C); bf16* ZZT = (bf16*)(c.ws + WS_ZZT);
    LAS bf16* sin_ = (LAS bf16*)c.lds;
    LAS bf16* zt = (LAS bf16*)(c.lds + 3 * 66 * 64 * 2);
    const int ct = item & 7, rt0 = (item >> 3) * 4, ch0 = ct * 64;
    u32x4 v[4];
#define HP_LOAD(rt_) do { const int r0_ = (rt_) * 64; int s0_, s1_; seg_of_row(r0_, s0_, s1_); \
        _Pragma("unroll") for (int it = 0; it < 4; ++it) { const int i = it * NTHR + c.tid; \
            if (i < 3 * 66 * 8) { const int p = i / (66 * 8), rem = i % (66 * 8), rr = rem >> 3, c8 = (rem & 7) * 8; const int r = r0_ - 1 + rr; const bool ok = r >= s0_ && r < s1_; \
                const bf16* src_ = ok ? PROJ + (size_t)r * NP + 2048 + p * 512 + ch0 + c8 : (const bf16*)(c.ws + WS_CTL);     \
                v[it] = NTL(u32x4, src_); } } } while (0)
    HP_LOAD(rt0);
    const int rl = c.tid >> 3, cg = (c.tid & 7) * 8;
    f32x4 wA[3][3], wB[3][3];
#pragma unroll
    for (int p = 0; p < 3; ++p)
#pragma unroll
        for (int j = 0; j < 3; ++j) { wA[p][j] = *(const f32x4*)(hw + j * 1536 + p * 512 + ch0 + cg); wB[p][j] = *(const f32x4*)(hw + j * 1536 + p * 512 + ch0 + cg + 4); }
    for (int jt = 0; jt < 4; ++jt) {
        const int r0 = (rt0 + jt) * 64;
        if (jt) __syncthreads();
#pragma unroll
        for (int it = 0; it < 4; ++it) { const int i = it * NTHR + c.tid;
            if (i < 3 * 66 * 8) { const int p = i / (66 * 8), rem = i % (66 * 8), rr = rem >> 3, c8 = (rem & 7) * 8; *(LAS u32x4*)(sin_ + (p * 66 + rr) * 64 + c8) = v[it]; } }
        if (jt + 1 < 4) HP_LOAD(rt0 + jt + 1);
        __syncthreads();
        { float y[3][8];
#pragma unroll
            for (int p = 0; p < 3; ++p)
#pragma unroll
                for (int e = 0; e < 8; ++e) y[p][e] = 0.f;
#pragma unroll
            for (int p = 0; p < 3; ++p)
#pragma unroll
                for (int j = 0; j < 3; ++j) { const u32x4 xv = *(const LAS u32x4*)(sin_ + (p * 66 + rl + j) * 64 + cg);
                    const f32x4 w0 = wA[p][j], w1 = wB[p][j];
                    const unsigned xw[4] = {xv.x, xv.y, xv.z, xv.w};
#pragma unroll
                    for (int q = 0; q < 4; ++q) { const float wl = q < 2 ? w0[2 * q] : w1[2 * q - 4], wh = q < 2 ? w0[2 * q + 1] : w1[2 * q - 3];
                        y[p][2 * q] += wl * bf2f((bf16)(xw[q] & 0xffffu)); y[p][2 * q + 1] += wh * bf2f((bf16)(xw[q] >> 16)); } }
            u32x4 o; o.x = pk2(y[0][0], y[0][1]); o.y = pk2(y[0][2], y[0][3]); o.z = pk2(y[0][4], y[0][5]); o.w = pk2(y[0][6], y[0][7]);
            *(u32x4*)(X0C + (size_t)(r0 + rl) * 512 + ch0 + cg) = o;
#pragma unroll
            for (int e = 0; e < 8; ++e) zt[(cg + e) * 72 + rl] = f2bf(y[1][e] * y[2][e]); }
        __syncthreads();
        { const int chl = c.tid >> 3, e = (c.tid & 7) * 8;
            const u32x4 zv = *(const LAS u32x4*)(zt + chl * 72 + e);
            *(u32x4*)(ZZT + (size_t)(ch0 + chl) * NTOK + r0 + e) = zv; }
    }
#undef HP_LOAD
}

constexpr int SC_K = 0, SC_Q = 16384, SC_V = 32768, SC_T = 49152, SC_QK = 57344, SC_CO = 65536, SC_BUF = 66816;
static_assert(2 * SC_BUF <= 146944, "scan LDS");
typedef short v4i16_t __attribute__((ext_vector_type(4)));
typedef __bf16 bf16x2_t __attribute__((ext_vector_type(2)));
DI unsigned cvtpk(float lo, float hi) { f32x2 v = {lo, hi}; bf16x2_t b = __builtin_convertvector(v, bf16x2_t); return __builtin_bit_cast(unsigned, b); }
DI bf16x8v pack44(const f32x4& a, const f32x4& b) { u32x4 p; p.x = cvtpk(a[0], a[1]); p.y = cvtpk(a[2], a[3]); p.z = cvtpk(b[0], b[1]); p.w = cvtpk(b[2], b[3]); return __builtin_bit_cast(bf16x8v, p); }
DI s16x4v ldtr(const LAS unsigned char* p) { return __builtin_bit_cast(s16x4v, __builtin_amdgcn_ds_read_tr16_b64_v4i16((LAS v4i16_t*)p)); }
DI int kq_off(int r, int ch8) { return r * 256 + ((ch8 ^ (((r & 7) << 2) | (((r >> 3) & 1) << 1))) << 3); }
DI int t_off(int r, int ch8) { return r * 128 + ((ch8 ^ (((r >> 1) & 7) << 1)) << 3); }
DI bf16x8v ldA(const LAS unsigned char* mat, int nb, int c0) { const s16x4v lo = *(const volatile LAS s16x4v*)(mat + (nb ^ (c0 << 3))), hi = *(const volatile LAS s16x4v*)(mat + (nb ^ ((c0 + 4) << 3)));     return __builtin_shufflevector(lo, hi, 0, 1, 2, 3, 4, 5, 6, 7); }
#define MFMA16(a, b, c) __builtin_amdgcn_mfma_f32_16x16x32_bf16((a), (b), (c), 0, 0, 0)
#define SC_BAR() do { asm volatile("s_waitcnt lgkmcnt(0)" ::: "memory"); __builtin_amdgcn_s_barrier(); asm volatile("" ::: "memory"); } while (0)

DI void scan_load(const Ctx& c, u32x4 (&d)[16], float& gcv, float& be, int rowbase, int chunkid, int h, int dir, int ltid  ) {
    const bf16* QKVN = (const bf16*)(c.ws + WS_QKVN); const bf16* TM = (const bf16*)(c.ws + WS_TM); const bf16* QKM = (const bf16*)(c.ws + WS_QKM);
    const size_t mbase = ((size_t)(chunkid * 4 + h) * 2 + dir) * 4096;
#pragma unroll
    for (int it = 0; it < 16; ++it) { const int u = it * 256 + ltid, v = u & 1023;
        if (it < 12) { const int which = it >> 2; const int row = v >> 4, c16 = v & 15; const int srow = rowbase + (dir ? 63 - row : row);
            const int coff = (which == 0 ? 512 : (which == 1 ? 0 : 1024)) + h * 128 + c16 * 8;
            d[it] = *(const u32x4*)(QKVN + (size_t)srow * 1536 + coff); }
        else { const int mat = v >> 9, row = (v & 511) >> 3, c16 = v & 7;
            d[it] = *(const u32x4*)((mat ? QKM : TM) + mbase + row * 64 + c16 * 8); } }
    if (ltid < 64) { const float* GBG = (const float*)(c.ws + WS_GBG); const float* GBB = (const float*)(c.ws + WS_GBB);
        const int tok = dir ? 63 - ltid : ltid; const int ri = (rowbase + tok) * 8 + dir * 4 + h;
        gcv = GBG[ri]; be = GBB[ri]; }
}
DI void scan_store(LAS unsigned char* buf, const u32x4 (&d)[16], float gcv, float be, int ltid) {
#pragma unroll
    for (int it = 0; it < 16; ++it) { const int u = it * 256 + ltid, v = u & 1023; const u32x2 lo = {d[it].x, d[it].y}, hi = {d[it].z, d[it].w};
        if (it < 12) { const int which = it >> 2; const int row = v >> 4, c16 = v & 15; LAS unsigned char* bb = buf + (which == 0 ? SC_K : (which == 1 ? SC_Q : SC_V));
            *(LAS u32x2*)(bb + kq_off(row, 2 * c16)) = lo; *(LAS u32x2*)(bb + kq_off(row, 2 * c16 + 1)) = hi; }
        else { const int mat = v >> 9, row = (v & 511) >> 3, c16 = v & 7; LAS unsigned char* bb = buf + (mat ? SC_QK : SC_T);
            *(LAS u32x2*)(bb + t_off(row, 2 * c16)) = lo; *(LAS u32x2*)(bb + t_off(row, 2 * c16 + 1)) = hi; } }
    if (ltid < 64) { const float gl = shi(gcv, 63);
        LAS float* CO = (LAS float*)(buf + SC_CO); const float eg = __expf(gcv);
        CO[ltid] = be; CO[64 + ltid] = be * eg; CO[128 + ltid] = eg; CO[192 + ltid] = __expf(gl - gcv); if (ltid == 0) CO[256] = __expf(gl); }
}

DI void scan_chain(const Ctx& c, int l, int seq, int h, int dir, int half) {
    const bool isctx = seq < 16; const int NCH = isctx ? 4 : 64, row0 = isctx ? seq * 256 : NCTX + (seq - 16) * 4096;
    const int lane = fresh_lane();
    const int w = c.wave, n = lane & 15, g = lane >> 4, dv0 = 64 * half + 16 * (w & 3);
    LAS unsigned char* lds = c.lds;
    const int cstep = dir ? -1 : 1, cfirst = dir ? NCH - 1 : 0, chunk0 = row0 >> 6;
    __syncthreads();
    if (w >= 4) {
        u32x4 dreg[16]; float gcv_ = 0.f, be_ = 0.f;
        int lt = (w - 4) * 64 + lane; asm volatile("" : "+v"(lt));
        scan_load(c, dreg, gcv_, be_, row0 + cfirst * 64, chunk0 + cfirst, h, dir, lt);
        scan_store(lds, dreg, gcv_, be_, lt);
        if (NCH > 1) scan_load(c, dreg, gcv_, be_, row0 + (cfirst + cstep) * 64, chunk0 + cfirst + cstep, h, dir, lt);
        SC_BAR();
        for (int st = 0; st < NCH; ++st) {
            const int cn = cfirst + cstep * st;
            int lt2 = lt; asm volatile("" : "+v"(lt2));
            if (st + 1 < NCH) scan_store(lds + ((st + 1) & 1) * SC_BUF, dreg, gcv_, be_, lt2);
            if (st + 2 < NCH) { const int c2 = cn + 2 * cstep; scan_load(c, dreg, gcv_, be_, row0 + c2 * 64, chunk0 + c2, h, dir, lt2); }
            SC_BAR();
        }
    } else {
        bf16* O = (bf16*)(c.ws + (dir == 0 ? WS_OF : WS_OB));
        const int nbkq0 = (n << 8) | ((g ^ (((n & 7) << 2) | (((n >> 3) & 1) << 1))) << 3), nbt0 = (n << 7) | ((g ^ (((n >> 1) & 7) << 1)) << 3);
        const int qb_ = (lane >> 2) & 3, pp_ = lane & 3;
        const int trb0 = ((4 * g + qb_) << 8) | ((pp_ ^ (((4 * (g & 1) + qb_) << 2) | ((g >> 1) << 1))) << 3);
        f32x4 St[8];
        if (isctx) {
#pragma unroll
            for (int m = 0; m < 8; ++m) St[m] = (f32x4){0.f, 0.f, 0.f, 0.f};
        } else { const float* sp = c.in[2] + ((((size_t)(seq - 16) * 4 + l) * 2 + dir) * 4 + h) * 16384 + dv0 + n + (size_t)(4 * g) * 128; asm volatile("" : "+v"(sp));
#pragma unroll
            for (int m = 0; m < 8; ++m)
#pragma unroll
                for (int e = 0; e < 4; ++e) St[m][e] = sp[(16 * m + e) * 128]; }
        SC_BAR();
        for (int st = 0; st < NCH; ++st) {
            const int cn = cfirst + cstep * st;
            LAS unsigned char* buf = lds + (st & 1) * SC_BUF;
        int nbkq_ = nbkq0, nbt_ = nbt0, trb_ = trb0; asm volatile("" : "+v"(nbkq_), "+v"(nbt_), "+v"(trb_));
        const int nbkq = nbkq_, nbt = nbt_, trb = trb_;
        const LAS float* CO = (const LAS float*)(buf + SC_CO);
#define SB() __builtin_amdgcn_sched_barrier(0)
        bf16x8v Kf[4][4];
#pragma unroll
        for (int s4 = 0; s4 < 4; ++s4)
#pragma unroll
            for (int tt = 0; tt < 4; ++tt) Kf[s4][tt] = ldA(buf + SC_K + tt * 4096, nbkq, 8 * s4);
        SB();
        s16x4v vv[4]; f32x4 c1[4], c2[4]; bf16x8v Tf[6];
#pragma unroll
        for (int tt = 0; tt < 4; ++tt) { vv[tt] = ldtr(buf + SC_V + tt * 4096 + (trb ^ ((dv0 >> 2) << 3)));
            c1[tt] = *(const LAS f32x4*)(CO + 16 * tt + 4 * g); c2[tt] = *(const LAS f32x4*)(CO + 64 + 16 * tt + 4 * g); }
        Tf[0] = ldA(buf + SC_T + 0 * 2048, nbt, 0); Tf[1] = ldA(buf + SC_T + 1 * 2048, nbt, 0); Tf[2] = ldA(buf + SC_T + 2 * 2048, nbt, 0);
        Tf[3] = ldA(buf + SC_T + 2 * 2048, nbt, 8); Tf[4] = ldA(buf + SC_T + 3 * 2048, nbt, 0); Tf[5] = ldA(buf + SC_T + 3 * 2048, nbt, 8);
        SB();
        bf16x8v Bf[4];
#pragma unroll
        for (int s4 = 0; s4 < 4; ++s4) Bf[s4] = pack44(St[2 * s4], St[2 * s4 + 1]);
        f32x4 KS[4];
#pragma unroll
        for (int tt = 0; tt < 4; ++tt) KS[tt] = (f32x4){0.f, 0.f, 0.f, 0.f};
#pragma unroll
        for (int s4 = 0; s4 < 4; ++s4)
#pragma unroll
            for (int tt = 0; tt < 4; ++tt) KS[tt] = MFMA16(Kf[s4][tt], Bf[s4], KS[tt]);
        SB();
        bf16x8v Qf[4][4];
#pragma unroll
        for (int s4 = 0; s4 < 4; ++s4)
#pragma unroll
            for (int tt = 0; tt < 4; ++tt) Qf[s4][tt] = ldA(buf + SC_Q + tt * 4096, nbkq, 8 * s4);
        SB();
#pragma unroll
        for (int tt = 0; tt < 4; ++tt)
#pragma unroll
            for (int e = 0; e < 4; ++e) KS[tt][e] = c1[tt][e] * bf2f((bf16)vv[tt][e]) - c2[tt][e] * KS[tt][e];
        f32x4 VN[4];
        { const bf16x8v xf0 = pack44(KS[0], KS[1]), xf1 = pack44(KS[2], KS[3]);
          VN[0] = MFMA16(Tf[0], xf0, ((f32x4){0.f, 0.f, 0.f, 0.f})); VN[1] = MFMA16(Tf[1], xf0, ((f32x4){0.f, 0.f, 0.f, 0.f}));
          VN[2] = MFMA16(Tf[2], xf0, ((f32x4){0.f, 0.f, 0.f, 0.f})); VN[3] = MFMA16(Tf[4], xf0, ((f32x4){0.f, 0.f, 0.f, 0.f}));
          VN[2] = MFMA16(Tf[3], xf1, VN[2]); VN[3] = MFMA16(Tf[5], xf1, VN[3]); }
        SB();
        bf16x8v Mf[6]; f32x4 egv[4], edv[4];
        Mf[0] = ldA(buf + SC_QK + 0 * 2048, nbt, 0); Mf[1] = ldA(buf + SC_QK + 1 * 2048, nbt, 0); Mf[2] = ldA(buf + SC_QK + 2 * 2048, nbt, 0);
        Mf[3] = ldA(buf + SC_QK + 2 * 2048, nbt, 8); Mf[4] = ldA(buf + SC_QK + 3 * 2048, nbt, 0); Mf[5] = ldA(buf + SC_QK + 3 * 2048, nbt, 8);
#pragma unroll
        for (int tt = 0; tt < 4; ++tt) { egv[tt] = *(const LAS f32x4*)(CO + 128 + 16 * tt + 4 * g); edv[tt] = *(const LAS f32x4*)(CO + 192 + 16 * tt + 4 * g); }
        const float egl = CO[256];
        SB();
        f32x4 QS[4];
#pragma unroll
        for (int tt = 0; tt < 4; ++tt) QS[tt] = (f32x4){0.f, 0.f, 0.f, 0.f};
#pragma unroll
        for (int s4 = 0; s4 < 4; ++s4)
#pragma unroll
            for (int tt = 0; tt < 4; ++tt) QS[tt] = MFMA16(Qf[s4][tt], Bf[s4], QS[tt]);
#pragma unroll
        for (int tt = 0; tt < 4; ++tt) QS[tt] = QS[tt] * egv[tt];
        { const bf16x8v vf0 = pack44(VN[0], VN[1]), vf1 = pack44(VN[2], VN[3]);
          QS[0] = MFMA16(Mf[0], vf0, QS[0]); QS[1] = MFMA16(Mf[1], vf0, QS[1]); QS[2] = MFMA16(Mf[2], vf0, QS[2]); QS[3] = MFMA16(Mf[4], vf0, QS[3]);
          QS[2] = MFMA16(Mf[3], vf1, QS[2]); QS[3] = MFMA16(Mf[5], vf1, QS[3]); }
        SB();
        bf16x8v Ktf[8][2];
#pragma unroll
        for (int m = 0; m < 8; ++m) {
            { const s16x4v lo = ldtr(buf + SC_K + 0 * 256 + (trb ^ ((4 * m) << 3))), hi = ldtr(buf + SC_K + 16 * 256 + (trb ^ ((4 * m) << 3))); Ktf[m][0] = __builtin_shufflevector(lo, hi, 0, 1, 2, 3, 4, 5, 6, 7); }
            { const s16x4v lo = ldtr(buf + SC_K + 32 * 256 + (trb ^ ((4 * m) << 3))), hi = ldtr(buf + SC_K + 48 * 256 + (trb ^ ((4 * m) << 3))); Ktf[m][1] = __builtin_shufflevector(lo, hi, 0, 1, 2, 3, 4, 5, 6, 7); } }
        SB();
        { bf16* Op = O + (size_t)(row0 + cn * 64 + (dir ? 63 - 4 * g : 4 * g)) * 512 + h * 128 + dv0 + n;
          const int sg = dir ? -512 : 512;
#pragma unroll
          for (int tt = 0; tt < 4; ++tt)
#pragma unroll
            for (int e = 0; e < 4; e += 2) { const unsigned pq = cvtpk(QS[tt][e], QS[tt][e + 1]);
                Op[sg * (16 * tt + e)] = (bf16)(pq & 0xffffu); Op[sg * (16 * tt + e + 1)] = (bf16)(pq >> 16); } }
        { const bf16x8v vs0 = pack44(VN[0] * edv[0], VN[1] * edv[1]), vs1 = pack44(VN[2] * edv[2], VN[3] * edv[3]);
#pragma unroll
          for (int m = 0; m < 8; ++m) { St[m] = St[m] * egl; St[m] = MFMA16(Ktf[m][0], vs0, St[m]); St[m] = MFMA16(Ktf[m][1], vs1, St[m]); } }
            SC_BAR();
        }
        if (isctx) { const int l2 = fresh_lane();
            float* sp = c.out + (size_t)NTOK * D + ((((size_t)seq * 4 + l) * 2 + dir) * 4 + h) * 16384 + dv0 + (l2 & 15) + (size_t)(4 * (l2 >> 4)) * 128;
#pragma unroll
            for (int m = 0; m < 8; ++m)
#pragma unroll
                for (int e = 0; e < 4; ++e) sp[(16 * m + e) * 128] = St[m][e]; }
    }
}

DI void phase_gdn_out(const Ctx& c, int l) {
    const bf16* OF = (const bf16*)(c.ws + WS_OF); const bf16* OB = (const bf16*)(c.ws + WS_OB);
    bf16* PROJ = (bf16*)(c.ws + WS_R1); const float* gn = c.in[13] + l * 128;
    const int gw = c.bid * NWAVES + c.wave, NGW = c.G * NWAVES;
    const int col = 8 * c.lane;
    const f32x4 gA = *(const f32x4*)(gn + (col & 127)), gB = *(const f32x4*)(gn + (col & 127) + 4);
#define GO_ROW(uf, ub, ug, r_) do { \
        const unsigned wf[4] = {uf.x, uf.y, uf.z, uf.w}, wb[4] = {ub.x, ub.y, ub.z, ub.w}, wg[4] = {ug.x, ug.y, ug.z, ug.w}; \
        f32x2 o[4]; f32x2 s2 = {0.f, 0.f}; \
        _Pragma("unroll") for (int q = 0; q < 4; ++q) { o[q] = (f32x2){__builtin_bit_cast(float, wf[q] << 16), __builtin_bit_cast(float, wf[q] & 0xffff0000u)} + (f32x2){__builtin_bit_cast(float, wb[q] << 16), __builtin_bit_cast(float, wb[q] & 0xffff0000u)}; \
            s2 = __builtin_elementwise_fma(o[q], o[q], s2); } \
        float ss = s2.x + s2.y; \
        ss += __builtin_bit_cast(float, __builtin_amdgcn_update_dpp(0, __builtin_bit_cast(int, ss), 0xB1, 0xF, 0xF, true)); \
        ss += __builtin_bit_cast(float, __builtin_amdgcn_update_dpp(0, __builtin_bit_cast(int, ss), 0x4E, 0xF, 0xF, true)); \
        ss += __builtin_bit_cast(float, __builtin_amdgcn_update_dpp(0, __builtin_bit_cast(int, ss), 0x141, 0xF, 0xF, true)); \
        ss += __builtin_bit_cast(float, __builtin_amdgcn_update_dpp(0, __builtin_bit_cast(int, ss), 0x140, 0xF, 0xF, true)); \
        const float rstd = rsqrtf(ss * (1.f / 128.f) + EPS); \
        unsigned ow[4]; \
        _Pragma("unroll") for (int q = 0; q < 4; ++q) { const float g0 = __builtin_bit_cast(float, wg[q] << 16), g1 = __builtin_bit_cast(float, wg[q] & 0xffff0000u); \
            const f32x2 sc = q < 2 ? (f32x2){gA[2 * q], gA[2 * q + 1]} : (f32x2){gB[2 * q - 4], gB[2 * q - 3]}; \
            const f32x2 r2 = (o[q] * rstd) * (sc * (f32x2){silu_f(g0), silu_f(g1)}); \
            ow[q] = cvtpk_hw(r2.x, r2.y); } \
        u32x4 ov; ov.x = ow[0]; ov.y = ow[1]; ov.z = ow[2]; ov.w = ow[3]; \
        *(u32x4*)(PROJ + (size_t)(r_) * NP + 2560 + col) = ov; } while (0)
    for (int r = gw; r < NTOK; r += 5 * NGW) {
        u32x4 fv[5], bv[5], gv[5];
#pragma unroll
        for (int q = 0; q < 5; ++q) { const int rq = (r + q * NGW < NTOK) ? r + q * NGW : r;
            fv[q] = NTL(u32x4, OF + (size_t)rq * 512 + col); bv[q] = NTL(u32x4, OB + (size_t)rq * 512 + col); gv[q] = NTL(u32x4, PROJ + (size_t)rq * NP + 1536 + col); }
#pragma unroll
        for (int q = 0; q < 5; ++q) if (r + q * NGW < NTOK) GO_ROW(fv[q], bv[q], gv[q], r + q * NGW);
    }
#undef GO_ROW
}

DI void phase_final(const Ctx& c) {
    const float* fg = c.in[26];
    const int gw = c.bid * NWAVES + c.wave, NGW = c.G * NWAVES;
    f32x4 g4[4];
#pragma unroll
    for (int j = 0; j < 4; ++j) g4[j] = *(const f32x4*)(fg + (c.lane + 64 * j) * 4);
    for (int r = gw; r < NTOK; r += 5 * NGW) {
        f32x4 v[5][4];
#pragma unroll
        for (int q = 0; q < 5; ++q) { const int rq = (r + q * NGW < NTOK) ? r + q * NGW : r;
            const u32x2* br = (const u32x2*)((const char*)(c.X + (size_t)rq * D) + D * 2);
#pragma unroll
            for (int j = 0; j < 4; ++j) { const u32x2 a = NTL(u32x2, br + c.lane + 64 * j);
                v[q][j] = (f32x4){__builtin_bit_cast(float, a.x << 16), __builtin_bit_cast(float, a.x & 0xffff0000u), __builtin_bit_cast(float, a.y << 16), __builtin_bit_cast(float, a.y & 0xffff0000u)}; } }
#pragma unroll
        for (int q = 0; q < 5; ++q) { if (r + q * NGW >= NTOK) break;
            float ss = 0.f;
#pragma unroll
            for (int j = 0; j < 4; ++j) ss += (v[q][j].x * v[q][j].x + v[q][j].y * v[q][j].y) + (v[q][j].z * v[q][j].z + v[q][j].w * v[q][j].w);
            ss = wave_sum(ss, c.lane); const float rstd = rsqrtf(ss * (1.f / D) + EPS);
            f32x4* xr = (f32x4*)(c.X + (size_t)(r + q * NGW) * D);
#pragma unroll
            for (int j = 0; j < 4; ++j) xr[c.lane + 64 * j] = v[q][j] * rstd * g4[j]; }
    }
}

#define XB_TMO      128
#define XB_XCNT(j)  (256  + 64 * (j))
#define XB_XSUB(j)  (1280 + 64 * (j))
#define XB_XGEN(j)  (2304 + 64 * (j))
#define XB_TOP      3328
#define XB_TOPGEN   3392
#define XCD_BAR_WORDS 3456
#define XB_SPIN_CAP (1u << 22)
DI unsigned xb_ld(unsigned* p) { return __hip_atomic_load(p, __ATOMIC_RELAXED, __HIP_MEMORY_SCOPE_AGENT); }
DI unsigned xb_add(unsigned* p, unsigned v) { return __hip_atomic_fetch_add(p, v, __ATOMIC_RELAXED, __HIP_MEMORY_SCOPE_AGENT); }
DI unsigned xb_xcc_id() { return (unsigned)__builtin_amdgcn_s_getreg((3 << 11) | 20) & 0xFu; }
#define XB_SPIN(cond, bar) do { unsigned _sp = 0; while (cond) { __builtin_amdgcn_s_sleep(1); \
    if ((++_sp & 255u) == 0u) { if (xb_ld(&(bar)[XB_TMO])) break; if (_sp > XB_SPIN_CAP) { atomicAdd(&(bar)[XB_TMO], 1u); break; } } } } while (0)
struct XcdBarrier { unsigned* bar; unsigned x; volatile LAS unsigned* st; };
DI XcdBarrier xcd_barrier_post(unsigned* bar, volatile LAS unsigned* st, int tid) {
    XcdBarrier b; b.bar = bar; b.x = xb_xcc_id(); b.st = st;
    if (tid == 0) (void)xb_add(&bar[XB_XCNT(b.x)], 1u);
    return b;
}
DI void xcd_barrier_complete(unsigned* bar, unsigned x, unsigned& nloc, unsigned& nx) {
    const unsigned G = gridDim.x * gridDim.y * gridDim.z;
    unsigned sum, cnt, mine, sp = 0u;
    for (;;) {
        sum = 0u; cnt = 0u; mine = 0u;
#pragma unroll
        for (unsigned j = 0; j < 16; ++j) { const unsigned cc = xb_ld(&bar[XB_XCNT(j)]); sum += cc; cnt += (cc > 0u) ? 1u : 0u; mine = (j == x) ? cc : mine; }
        if (sum == G) break;
        __builtin_amdgcn_s_sleep(1);
        if ((++sp & 255u) == 0u) { if (xb_ld(&bar[XB_TMO])) break; if (sp > XB_SPIN_CAP) { atomicAdd(&bar[XB_TMO], 1u); break; } }
    }
    nloc = mine > 0u ? mine : 1u; nx = cnt > 0u ? cnt : 1u;
}
DI void xcd_barrier(const XcdBarrier& b, int tid) {
    asm volatile("s_waitcnt vmcnt(0)" ::: "memory");
    __syncthreads();
    if (tid == 0) {
        unsigned* bar = b.bar;
        __builtin_amdgcn_s_waitcnt(0);
        unsigned nloc = b.st[0], nx = b.st[1];
        if (nloc == 0u) { xcd_barrier_complete(bar, b.x, nloc, nx); b.st[0] = nloc; b.st[1] = nx; }
        const unsigned old = xb_add(&bar[XB_XSUB(b.x)], 1u);
        const unsigned gen = old / nloc;
        if (old + 1u == (gen + 1u) * nloc) {
            __builtin_amdgcn_fence(__ATOMIC_RELEASE, "agent");
            asm volatile("s_waitcnt vmcnt(0)" ::: "memory");
            const unsigned og = xb_add(&bar[XB_TOP], 1u);
            const unsigned tg = og / nx;
            if (og + 1u == (tg + 1u) * nx) xb_add(&bar[XB_TOPGEN], 1u);
            else XB_SPIN(xb_ld(&bar[XB_TOPGEN]) == tg, bar);
            __builtin_amdgcn_fence(__ATOMIC_ACQUIRE, "agent");
            xb_add(&bar[XB_XGEN(b.x)], 1u);
            asm volatile("s_waitcnt vmcnt(0)" ::: "memory");
        } else {
            XB_SPIN(xb_ld(&bar[XB_XGEN(b.x)]) == gen, bar);
            __builtin_amdgcn_fence(__ATOMIC_ACQUIRE, "agent");
            asm volatile("s_waitcnt vmcnt(0)" ::: "memory");
        }
    }
    __syncthreads();
}

constexpr int MISC_OFF = 146944;
__global__ void __launch_bounds__(NTHR, 2) fwd_kernel(KP p) {
    extern __shared__ __attribute__((aligned(16))) unsigned char lds_raw[];
    LAS unsigned char* lds0 = (LAS unsigned char*)lds_raw;
    const int wave0 = __builtin_amdgcn_readfirstlane((int)(threadIdx.x >> 6));
#define CUR_TID() ({ unsigned z_ = 0u; asm volatile("" : "+s"(z_)); wave0 * 64 + (int)__builtin_amdgcn_mbcnt_hi(~0u, __builtin_amdgcn_mbcnt_lo(~0u, z_)); })
    { const int t0 = CUR_TID(); volatile LAS unsigned* M0 = (volatile LAS unsigned*)(lds0 + MISC_OFF); if (t0 < 32) M0[t0] = 0u; }
    __syncthreads();
    const bool multi = (p.ph_hi - p.ph_lo) < 2;
    if (!multi) { KPc kp0 = (KPc)__builtin_amdgcn_kernarg_segment_ptr(); (void)xcd_barrier_post((unsigned*)(kp0->ws + WS_CTL) + 4096, (volatile LAS unsigned*)(lds0 + MISC_OFF) + 8, CUR_TID()); }
    for (int ph = p.ph_lo; ph < p.ph_hi; ++ph) {
        for (int rep = 0; rep < 2; ++rep) {
        KPc kp = (KPc)__builtin_amdgcn_kernarg_segment_ptr(); asm volatile("" : "+s"(kp));
        int tid = CUR_TID(); asm volatile("" : "+v"(tid));
        int bid = blockIdx.x; asm volatile("" : "+s"(bid));
        Ctx c;
        c.in = kp->in; c.X = kp->out; c.out = kp->out; c.ws = kp->ws; c.lds = lds0;
        c.tid = tid; c.lane = tid & 63; c.wave = __builtin_amdgcn_readfirstlane(tid >> 6); c.bid = bid; c.G = gridDim.x;
        if (ph == 0) { if (rep == 0 || (DUP_MASK & 32)) phase_mod(c); }
        else if (ph == 1) { if (rep == 0 || (DUP_MASK & 32)) { phase_sw(c); phase_rowprep<1, true>(c, 0); phase_filters(c, 0); phase_wconv_in(c, 0); } }
        else if (ph == NPH - 1) { if (rep == 0) phase_final(c); }
        else {
            const int l = (ph - 2) / 7, sub = (ph - 2) % 7;
            if (rep == 1) break;
            switch (sub) {
                case 0: phase_gemm_fast<EPI_PROJ>(c, l); break;
                case 1: phase_prep_fast(c, l); break;
                case 2: phase_queue(c, l); break;
                case 3: phase_gdn_out(c, l); phase_hyena_out(c); break;
                case 4: phase_gemm_fast<EPI_RES1>(c, l);
                    __syncthreads();
                    if (c.bid >= 64) { const int nb = 512 + (l + 1 < DEPTH ? WC_BLK_IN : 0);
                        for (int bi = c.bid - 64; bi < nb; bi += 192) {
                            if (bi < 512) wconv_wave_item(c, l, 1, (64 + bi) * 8 + c.wave); else wconv_wave_item(c, l + 1, 0, (bi - 512) * 8 + c.wave); } }
                    break;
                case 5: phase_gemm_fast<EPI_H>(c, l); break;
                default: phase_g4_main(c, l);
                    {
                        unsigned* cnt = (unsigned*)(c.ws + WS_CTL) + 1024 + l * 64 + (c.bid >> 2);
                        asm volatile("s_waitcnt vmcnt(0)" ::: "memory");
                        __syncthreads();
                        if (c.tid == 0) { __builtin_amdgcn_fence(__ATOMIC_RELEASE, "agent"); asm volatile("s_waitcnt vmcnt(0)" ::: "memory");
                            (void)__hip_atomic_fetch_add(cnt, 1u, __ATOMIC_RELAXED, __HIP_MEMORY_SCOPE_AGENT);
                            unsigned spins = 0;
                            while (__hip_atomic_load(cnt, __ATOMIC_RELAXED, __HIP_MEMORY_SCOPE_AGENT) < 4u) { __builtin_amdgcn_s_sleep(4); if (++spins > (1u << 24)) break; }
                            __builtin_amdgcn_fence(__ATOMIC_ACQUIRE, "agent"); asm volatile("s_waitcnt vmcnt(0)" ::: "memory"); }
                        __syncthreads();
                    }
                    phase_g4_combine(c, l); break;
            }
        }
        if (DUP_MASK == 0) break;
        __syncthreads();
        }
        KPc kpb = (KPc)__builtin_amdgcn_kernarg_segment_ptr();
        if (DUP_MASK & 64) { XcdBarrier bar; bar.bar = (unsigned*)(kpb->ws + WS_CTL) + 4096; bar.x = xb_xcc_id(); bar.st = (volatile LAS unsigned*)(lds0 + MISC_OFF) + 8; xcd_barrier(bar, CUR_TID()); }
        if (ph + 1 < kpb->ph_hi) { XcdBarrier bar; bar.bar = (unsigned*)(kpb->ws + WS_CTL) + 4096; bar.x = xb_xcc_id(); bar.st = (volatile LAS unsigned*)(lds0 + MISC_OFF) + 8; xcd_barrier(bar, CUR_TID()); }
    }
}

extern "C" void kernel_launch(void* const* d_in, const int* in_sizes, int n_in, void* d_out, int out_size, void* d_ws, size_t ws_size, hipStream_t stream) {
    static int grid = 0;
    if (grid == 0) {
        if (n_in != 27 || out_size != NTOK * D + 16 * 4 * 2 * 4 * 128 * 128 || ws_size < WS_END) {
            fprintf(stderr, "kernel_launch: unexpected problem: n_in %d out %d ws %zu (need %zu)\n", n_in, out_size, ws_size, (size_t)WS_END); grid = -1; return; }
        int dev = 0, cus = 0;
        if (hipGetDevice(&dev) != hipSuccess || hipDeviceGetAttribute(&cus, hipDeviceAttributeMultiprocessorCount, dev) != hipSuccess) { grid = -1; return; }
        if (hipFuncSetAttribute((const void*)fwd_kernel, hipFuncAttributeMaxDynamicSharedMemorySize, LDS_BYTES) != hipSuccess) { fprintf(stderr, "kernel_launch: hipFuncSetAttribute failed\n"); grid = -1; return; }
        int per_cu = 0;
        if (hipOccupancyMaxActiveBlocksPerMultiprocessor(&per_cu, (const void*)fwd_kernel, NTHR, LDS_BYTES) != hipSuccess || per_cu < 1)
            fprintf(stderr, "kernel_launch: occupancy query says %d blocks per CU\n", per_cu);
        (void)hipGetLastError();
        grid = cus;
    }
    if (grid < 0) return;
    (void)hipMemsetAsync((char*)d_ws + WS_CTL, 0, CTL_ZERO_BYTES, stream);
    KP p{};
    for (int i = 0; i < 27; ++i) p.in[i] = (const float*)d_in[i];
    p.out = (float*)d_out; p.ws = (unsigned char*)d_ws;
#if MK_MULTI
    for (int ph = 0; ph < NPH; ++ph) { p.ph_lo = ph; p.ph_hi = ph + 1; hipLaunchKernelGGL(fwd_kernel, dim3(grid), dim3(NTHR), LDS_BYTES, stream, p); }
#else
    p.ph_lo = 0; p.ph_hi = NPH; hipLaunchKernelGGL(fwd_kernel, dim3(grid), dim3(NTHR), LDS_BYTES, stream, p);
#endif
}
```
